# Optimizing an MI355X kernel written in HIP

```python
import math
import jax, jax.numpy as jnp
from jax import lax
import numpy as np

D_MODEL = 1024
BATCH = 2
SEQ = 8192
DEPTH = 1

HEAD_DIM = 64
FOX_HEADS = 8
NSA_HEADS = 8
NSA_KV_HEADS = 2
CMP_BLOCK = 32
CMP_STRIDE = 16
CMP_HIDDEN = 256
SLC_BLOCK = 64
SLC_TOPK = 16
WINDOW = 512
Q_BLOCK = 128
N_GROUPS = 4
EXPERTS_PER_GROUP = 4
N_EXPERTS = N_GROUPS * EXPERTS_PER_GROUP
TOP_K_IN_GROUP = 2
D_EXPERT = 512
RMS_EPS = 1e-6
NEG_INF = -1e30
FORCE_SCORE = 1e4

FOX_W = FOX_HEADS * HEAD_DIM
NSA_W = NSA_HEADS * HEAD_DIM
NSA_KV_W = NSA_KV_HEADS * HEAD_DIM
IN_COLS = (FOX_W, FOX_W, FOX_W, FOX_HEADS,
           NSA_W, NSA_KV_W, NSA_KV_W, NSA_KV_W, NSA_KV_W, NSA_KV_W, NSA_KV_W, 3 * NSA_HEADS,
           D_MODEL, D_MODEL)
D_IN = sum(IN_COLS)

kernel_name = "hybrid_fox_nsa_hiermoe_block"


def rms_norm(x, g):
    xf = x.astype(jnp.float32)
    y = xf * lax.rsqrt(jnp.mean(xf * xf, axis=-1, keepdims=True) + RMS_EPS)
    return (y * g.astype(jnp.float32)).astype(x.dtype)


def split_cols(z):
    outs, off = [], 0
    for c in IN_COLS:
        outs.append(z[..., off:off + c])
        off += c
    return outs


def to_heads(t, n):
    B, S, _ = t.shape
    return t.reshape(B, S, n, HEAD_DIM).transpose(0, 2, 1, 3)


def from_heads(t):
    B, n, S, dh = t.shape
    return t.transpose(0, 2, 1, 3).reshape(B, S, n * dh)


def alibi_slopes(n):
    return jnp.asarray([2.0 ** (-8.0 * (h + 1) / n) for h in range(n)], jnp.float32)


def fox_attention(q, k, v, log_f):
    B, H, S, dh = q.shape
    cum = jnp.cumsum(log_f, axis=-1)
    scale = dh ** -0.5
    kpos = jnp.arange(S)

    def block(i):
        q0 = i * Q_BLOCK
        qpos = q0 + jnp.arange(Q_BLOCK)
        qb = lax.dynamic_slice_in_dim(q, q0, Q_BLOCK, axis=2)
        cb = lax.dynamic_slice_in_dim(cum, q0, Q_BLOCK, axis=2)
        s = jnp.einsum('bhqd,bhkd->bhqk', qb, k, preferred_element_type=jnp.float32) * scale
        s = s + cb[..., :, None] - cum[..., None, :]
        s = jnp.where(kpos[None, :] <= qpos[:, None], s, NEG_INF)
        p = jax.nn.softmax(s, axis=-1)
        return jnp.einsum('bhqk,bhkd->bhqd', p.astype(v.dtype), v)

    o = lax.map(block, jnp.arange(S // Q_BLOCK))
    return jnp.moveaxis(o, 0, 2).reshape(B, H, S, dh)


def compress_blocks(t, w1, w2, pos):
    B, S, G, dh = t.shape
    n_cmp = (S - CMP_BLOCK) // CMP_STRIDE + 1
    idx = jnp.arange(n_cmp)[:, None] * CMP_STRIDE + jnp.arange(CMP_BLOCK)[None, :]
    blk = t[:, idx] + pos[None, None, :, None, :]
    blk = jnp.moveaxis(blk, 3, 1).reshape(B, G, n_cmp, CMP_BLOCK * dh)
    return jax.nn.gelu(blk @ w1) @ w2


def nsa_attention(q, k_cmp, v_cmp, k_slc, v_slc, k_win, v_win, gates):
    B, H, S, dh = q.shape
    G = k_slc.shape[1]
    R = H // G
    n_cmp = k_cmp.shape[2]
    n_slc = S // SLC_BLOCK
    top_n = min(SLC_TOPK, n_slc)
    scale = dh ** -0.5
    slopes = alibi_slopes(H).reshape(G, R)[None, :, :, None, None]

    cmp_start = jnp.arange(n_cmp) * CMP_STRIDE
    cmp_end = cmp_start + CMP_BLOCK - 1
    slc_start = jnp.arange(n_slc) * SLC_BLOCK
    ov = jnp.minimum(cmp_start[:, None] + CMP_BLOCK, slc_start[None, :] + SLC_BLOCK) - \
        jnp.maximum(cmp_start[:, None], slc_start[None, :])
    overlap = jnp.clip(ov, 0, None).astype(jnp.float32) / CMP_BLOCK
    slc_ids = jnp.arange(n_slc)

    k_sb = k_slc.reshape(B, G, n_slc, SLC_BLOCK, dh)
    v_sb = v_slc.reshape(B, G, n_slc, SLC_BLOCK, dh)
    pad = ((0, 0), (0, 0), (WINDOW, 0), (0, 0))
    k_wp = jnp.pad(k_win, pad)
    v_wp = jnp.pad(v_win, pad)
    gather = jax.vmap(jax.vmap(lambda blocks, idx: blocks[idx]))

    def block(i):
        q0 = i * Q_BLOCK
        qpos = q0 + jnp.arange(Q_BLOCK)
        qb = lax.dynamic_slice_in_dim(q, q0, Q_BLOCK, axis=2).reshape(B, G, R, Q_BLOCK, dh)

        s = jnp.einsum('bgrqd,bgnd->bgrqn', qb, k_cmp, preferred_element_type=jnp.float32) * scale
        dist = (qpos[:, None] - cmp_end[None, :]).astype(jnp.float32)
        valid = dist >= 0
        s = jnp.where(valid, s - slopes * dist, NEG_INF)
        p_cmp = jax.nn.softmax(s, axis=-1) * jnp.any(valid, axis=-1)[:, None].astype(jnp.float32)
        o_cmp = jnp.einsum('bgrqn,bgnd->bgrqd', p_cmp.astype(v_cmp.dtype), v_cmp)

        imp = jnp.einsum('bgrqn,nj->bgqj', p_cmp, overlap)
        qblk = qpos // SLC_BLOCK
        forced = (slc_ids[None, :] == 0) | (slc_ids[None, :] == qblk[:, None]) | \
            (slc_ids[None, :] == qblk[:, None] - 1)
        future = slc_ids[None, :] * SLC_BLOCK > qpos[:, None]
        score = jnp.where(future, -1.0, jnp.where(forced, FORCE_SCORE, imp))
        _, idx = lax.top_k(score, top_n)
        n_tok = top_n * SLC_BLOCK
        ks_g = gather(k_sb, idx).reshape(B, G, Q_BLOCK, n_tok, dh)
        vs_g = gather(v_sb, idx).reshape(B, G, Q_BLOCK, n_tok, dh)
        spos = (idx[..., None] * SLC_BLOCK + jnp.arange(SLC_BLOCK)).reshape(B, G, Q_BLOCK, n_tok)
        dist = (qpos[:, None] - spos).astype(jnp.float32)[:, :, None]
        s = jnp.einsum('bgrqd,bgqkd->bgrqk', qb, ks_g, preferred_element_type=jnp.float32) * scale
        s = jnp.where(dist >= 0, s - slopes * dist, NEG_INF)
        o_slc = jnp.einsum('bgrqk,bgqkd->bgrqd', jax.nn.softmax(s, axis=-1).astype(vs_g.dtype), vs_g)

        kw_b = lax.dynamic_slice_in_dim(k_wp, q0, WINDOW + Q_BLOCK, axis=2)
        vw_b = lax.dynamic_slice_in_dim(v_wp, q0, WINDOW + Q_BLOCK, axis=2)
        wpos = q0 - WINDOW + jnp.arange(WINDOW + Q_BLOCK)
        dist = (qpos[:, None] - wpos[None, :]).astype(jnp.float32)
        valid = (dist >= 0) & (dist < WINDOW) & (wpos[None, :] >= 0)
        s = jnp.einsum('bgrqd,bgkd->bgrqk', qb, kw_b, preferred_element_type=jnp.float32) * scale
        s = jnp.where(valid, s - slopes * dist, NEG_INF)
        o_win = jnp.einsum('bgrqk,bgkd->bgrqd', jax.nn.softmax(s, axis=-1).astype(vw_b.dtype), vw_b)

        gb = lax.dynamic_slice_in_dim(gates, q0, Q_BLOCK, axis=2).reshape(B, G, R, Q_BLOCK, 3)
        o = gb[..., 0:1] * o_cmp + gb[..., 1:2] * o_slc + gb[..., 2:3] * o_win
        return o.reshape(B, H, Q_BLOCK, dh)

    o = lax.map(block, jnp.arange(S // Q_BLOCK))
    return jnp.moveaxis(o, 0, 2).reshape(B, H, S, dh)


def hierarchical_moe(x, w_group, b_group, w_router, b_router, w_gate, w_up, w_down):
    B, S, D = x.shape
    t = x.reshape(B * S, D)
    g_logits = (t @ w_group).astype(jnp.float32) + b_group.astype(jnp.float32)
    p_g, g_top = lax.top_k(jax.nn.softmax(g_logits, axis=-1), 1)
    e_logits = ((t @ w_router).astype(jnp.float32) + b_router.astype(jnp.float32)).reshape(-1, N_GROUPS, EXPERTS_PER_GROUP)
    e_in = jnp.take_along_axis(e_logits, g_top[:, :, None], axis=1)[:, 0]
    top_p, top_i = lax.top_k(jax.nn.softmax(e_in, axis=-1), TOP_K_IN_GROUP)
    w = top_p / jnp.sum(top_p, axis=-1, keepdims=True) * p_g
    expert_id = g_top * EXPERTS_PER_GROUP + top_i
    combine = jnp.sum(jax.nn.one_hot(expert_id, N_EXPERTS, dtype=jnp.float32) * w[..., None], axis=1)
    hid = jax.nn.silu(jnp.einsum('td,edf->etf', t, w_gate)) * jnp.einsum('td,edf->etf', t, w_up)
    hid = hid * combine.T.astype(hid.dtype)[:, :, None]
    y = jnp.einsum('etf,efd->td', hid, w_down)
    return y.reshape(B, S, D)


def setup_inputs(seed: int = 0) -> dict:
    key = jax.random.key(seed)
    ks = jax.random.split(key, 26)
    L = DEPTH

    def nrm(k, shape, scale):
        return jax.random.normal(k, shape, jnp.float32) * scale

    def gain(k, shape):
        return 1.0 + 0.02 * jax.random.normal(k, shape, jnp.float32)

    cmp_in = CMP_BLOCK * HEAD_DIM
    return {
        "x": nrm(ks[0], (BATCH, SEQ, D_MODEL), 1.0),
        "norm_mix_g": gain(ks[1], (L, D_MODEL)),
        "w_in": nrm(ks[2], (L, D_MODEL, D_IN), D_MODEL ** -0.5),
        "b_forget": jnp.linspace(1.0, 6.0, FOX_HEADS, dtype=jnp.float32)[None, :] + nrm(ks[3], (L, FOX_HEADS), 0.1),
        "fox_q_g": gain(ks[4], (L, HEAD_DIM)),
        "fox_k_g": gain(ks[5], (L, HEAD_DIM)),
        "nsa_q_g": gain(ks[6], (L, HEAD_DIM)),
        "nsa_k_g": gain(ks[7], (L, HEAD_DIM)),
        "cmp_k_w1": nrm(ks[8], (L, cmp_in, CMP_HIDDEN), cmp_in ** -0.5),
        "cmp_k_w2": nrm(ks[9], (L, CMP_HIDDEN, HEAD_DIM), CMP_HIDDEN ** -0.5),
        "cmp_k_pos": nrm(ks[10], (L, CMP_BLOCK, HEAD_DIM), 0.1),
        "cmp_v_w1": nrm(ks[11], (L, cmp_in, CMP_HIDDEN), cmp_in ** -0.5),
        "cmp_v_w2": nrm(ks[12], (L, CMP_HIDDEN, HEAD_DIM), CMP_HIDDEN ** -0.5),
        "cmp_v_pos": nrm(ks[13], (L, CMP_BLOCK, HEAD_DIM), 0.1),
        "w_fox_up": nrm(ks[14], (L, FOX_W, D_MODEL), FOX_W ** -0.5),
        "w_nsa_up": nrm(ks[15], (L, NSA_W, D_MODEL), NSA_W ** -0.5),
        "w_out": nrm(ks[16], (L, D_MODEL, D_MODEL), D_MODEL ** -0.5),
        "norm_ffn_g": gain(ks[17], (L, D_MODEL)),
        "w_group": nrm(ks[18], (L, D_MODEL, N_GROUPS), D_MODEL ** -0.5),
        "b_group": nrm(ks[19], (L, N_GROUPS), 0.01),
        "w_router": nrm(ks[20], (L, D_MODEL, N_EXPERTS), D_MODEL ** -0.5),
        "b_router": nrm(ks[21], (L, N_EXPERTS), 0.01),
        "w_gate": nrm(ks[22], (L, N_EXPERTS, D_MODEL, D_EXPERT), D_MODEL ** -0.5),
        "w_up": nrm(ks[23], (L, N_EXPERTS, D_MODEL, D_EXPERT), D_MODEL ** -0.5),
        "w_down": nrm(ks[24], (L, N_EXPERTS, D_EXPERT, D_MODEL), D_EXPERT ** -0.5),
    }


def reference(x, norm_mix_g, w_in, b_forget, fox_q_g, fox_k_g, nsa_q_g, nsa_k_g,
              cmp_k_w1, cmp_k_w2, cmp_k_pos, cmp_v_w1, cmp_v_w2, cmp_v_pos,
              w_fox_up, w_nsa_up, w_out, norm_ffn_g, w_group, b_group, w_router, b_router,
              w_gate, w_up, w_down):
    B, S, D = x.shape
    for l in range(DEPTH):
        h = rms_norm(x, norm_mix_g[l])
        (f_q, f_k, f_v, f_f, n_q, k_c, v_c, k_s, v_s, k_w, v_w, n_g, g_a, g_b) = split_cols(h @ w_in[l])

        qa = rms_norm(to_heads(f_q, FOX_HEADS), fox_q_g[l])
        ka = rms_norm(to_heads(f_k, FOX_HEADS), fox_k_g[l])
        va = to_heads(f_v, FOX_HEADS)
        log_f = jax.nn.log_sigmoid(f_f.astype(jnp.float32) + b_forget[l].astype(jnp.float32)).transpose(0, 2, 1)
        out_a = from_heads(fox_attention(qa, ka, va, log_f)) @ w_fox_up[l]

        qb = rms_norm(to_heads(n_q, NSA_HEADS), nsa_q_g[l])
        kc = compress_blocks(k_c.reshape(B, S, NSA_KV_HEADS, HEAD_DIM), cmp_k_w1[l], cmp_k_w2[l], cmp_k_pos[l])
        kc = rms_norm(kc, nsa_k_g[l])
        vc = compress_blocks(v_c.reshape(B, S, NSA_KV_HEADS, HEAD_DIM), cmp_v_w1[l], cmp_v_w2[l], cmp_v_pos[l])
        ks_ = rms_norm(to_heads(k_s, NSA_KV_HEADS), nsa_k_g[l])
        vs_ = to_heads(v_s, NSA_KV_HEADS)
        kw_ = rms_norm(to_heads(k_w, NSA_KV_HEADS), nsa_k_g[l])
        vw_ = to_heads(v_w, NSA_KV_HEADS)
        gates = jax.nn.sigmoid(n_g.reshape(B, S, NSA_HEADS, 3)).transpose(0, 2, 1, 3)
        out_b = from_heads(nsa_attention(qb, kc, vc, ks_, vs_, kw_, vw_, gates)) @ w_nsa_up[l]

        mix = jax.nn.sigmoid(g_a) * out_a + jax.nn.sigmoid(g_b) * out_b
        x = x + mix @ w_out[l]

        x = x + hierarchical_moe(rms_norm(x, norm_ffn_g[l]), w_group[l], b_group[l], w_router[l], b_router[l],
                                 w_gate[l], w_up[l], w_down[l])
    return x
```

```cpp
#ifndef CPU_EMU
#include <hip/hip_runtime.h>
#include <hip/hip_cooperative_groups.h>
#include <cstdio>
#include <cstdint>
namespace cg = cooperative_groups;
#define DEV __device__ __forceinline__
#else
#include <cstdio>
#include <cstdint>
#include <cstring>
#include <cmath>
#define DEV inline
struct uint4 { unsigned x, y, z, w; };
static inline float exp2f_(float x) { return exp2f(x); }
#endif

#ifndef CFG_NW
#define CFG_NW 4
#endif
#define CFG_NW_FOR_WS CFG_NW
#ifndef CFG_B
#define CFG_B 2
#define CFG_S 8192
#define CFG_D 1024
#define CFG_DE 512
#endif

constexpr int B_ = CFG_B, S_ = CFG_S, D_ = CFG_D, DE_ = CFG_DE, T_ = B_ * S_;
constexpr int HD = 64, FH = 8, NH = 8, NKV = 2, NR = 4;
constexpr int NCMP = (S_ - 32) / 16 + 1, NCMPP = ((NCMP + 31) / 32) * 32, NSLC = S_ / 64, TOPN = NSLC < 16 ? NSLC : 16;
constexpr int NE = 16;
constexpr float RMS_EPS = 1e-6f;
constexpr float LOG2E = 1.4426950408889634f;
constexpr float QSCALE = 0.125f * LOG2E;
constexpr int C_FQ = 0, C_FK = 512, C_FV = 1024, C_NQ = 1536, C_KC = 2048, C_VC = 2176, C_KS = 2304, C_VS = 2432, C_KW = 2560, C_VW = 2688,
              C_GA = 2816, C_GB = 2816 + D_, C_FF = 2816 + 2 * D_, C_NG = C_FF + 8, C_END = C_NG + 24, NP = ((C_END + 127) / 128) * 128;
constexpr int O_FQ = 0, O_FK = 512, O_FV = 1024, O_FF = 1536, O_NQ = 1544, O_KC = 2056, O_VC = 2184, O_KS = 2312, O_VS = 2440, O_KW = 2568, O_VW = 2696,
              O_NG = 2824, O_GA = 2848, O_GB = 2848 + D_, D_IN = 2848 + 2 * D_;

typedef unsigned short bf16;

constexpr size_t al256(size_t x) { return (x + 255) & ~(size_t)255; }
constexpr size_t OFF_CTL = 0, SZ_CTL = 1 << 20;
constexpr size_t OFF_WINT = OFF_CTL + SZ_CTL;
constexpr size_t OFF_WAT = OFF_WINT + al256((size_t)NP * D_ * 2);
constexpr size_t OFF_WBT = OFF_WAT + al256((size_t)D_ * 512 * 2);
constexpr size_t OFF_WOT = OFF_WBT + al256((size_t)D_ * 512 * 2);
constexpr size_t OFF_W1T = OFF_WOT + al256((size_t)D_ * D_ * 2);
constexpr size_t OFF_W2T = OFF_W1T + al256((size_t)2 * 256 * 2048 * 2);
constexpr size_t OFF_BIAS1 = OFF_W2T + al256((size_t)2 * 128 * 256 * 2);
constexpr size_t OFF_WGT = OFF_BIAS1 + al256((size_t)2 * 256 * 4);
constexpr size_t OFF_WUT = OFF_WGT + al256((size_t)NE * DE_ * D_ * 2);
constexpr size_t OFF_WDT = OFF_WUT + al256((size_t)NE * DE_ * D_ * 2);
constexpr size_t SZ_HEADS = al256((size_t)B_ * 8 * S_ * 64 * 2), SZ_KV = al256((size_t)B_ * 2 * S_ * 64 * 2);
constexpr size_t OFF_FQ = OFF_WDT + al256((size_t)NE * D_ * DE_ * 2);
constexpr size_t OFF_FK = OFF_FQ + SZ_HEADS, OFF_FV = OFF_FK + SZ_HEADS, OFF_NQ = OFF_FV + SZ_HEADS;
constexpr size_t OFF_KCR = OFF_NQ + SZ_HEADS, OFF_VCR = OFF_KCR + SZ_KV, OFF_KS = OFF_VCR + SZ_KV, OFF_VS = OFF_KS + SZ_KV, OFF_KW = OFF_VS + SZ_KV, OFF_VW = OFF_KW + SZ_KV;
constexpr size_t OFF_GA = OFF_VW + SZ_KV, OFF_GB = OFF_GA + al256((size_t)T_ * D_ * 2);
constexpr size_t OFF_LOGF = OFF_GB + al256((size_t)T_ * D_ * 2);
constexpr size_t OFF_CUM = OFF_LOGF + al256((size_t)B_ * 8 * S_ * 4);
constexpr size_t OFF_GATE = OFF_CUM + al256((size_t)B_ * 8 * S_ * 4);
constexpr size_t OFF_KCMP = OFF_GATE + al256((size_t)T_ * 24 * 4);
constexpr size_t OFF_VCMP = OFF_KCMP + al256((size_t)B_ * 2 * NCMPP * 64 * 2);
constexpr size_t OFF_CHID = OFF_VCMP + al256((size_t)B_ * 2 * NCMPP * 64 * 2);
#ifdef CPU_EMU
constexpr size_t OFF_IMP = OFF_CHID + al256((size_t)2 * B_ * 2 * NCMPP * 256 * 2);
constexpr size_t OFF_SEL = OFF_IMP + al256((size_t)B_ * 2 * S_ * NSLC * 4);
constexpr size_t OFF_ROUTE = OFF_SEL + al256((size_t)B_ * 2 * S_ * 16 * 4);
#else
constexpr size_t OFF_ROUTE = OFF_CHID + al256((size_t)2 * B_ * 2 * NCMPP * 256 * 2);
#endif
constexpr int NCLS = 24, MOE_BM = 32 * CFG_NW_FOR_WS, NSLOT = T_ + NCLS * MOE_BM;
constexpr size_t OFF_STOK = OFF_ROUTE + al256((size_t)T_ * 16);
constexpr size_t OFF_SW = OFF_STOK + al256((size_t)NCLS * T_ * 4);
constexpr int FX_ROWS = 32 * CFG_NW, FX_CH = 32, FX_NQB = S_ / FX_ROWS, FX_QQ = FX_NQB / 4, FX_PART_PER_BH = 9 * FX_QQ, FX_PART_BYTES = FX_ROWS * 64 * 2 + FX_ROWS * 8;
constexpr size_t FX_NPART = (size_t)B_ * 8 * FX_PART_PER_BH;
constexpr size_t FX_P1 = ((size_t)T_ * D_ * 4 - (size_t)T_ * 1024 * 2) / FX_PART_BYTES;
constexpr size_t OFF_FXINFO = OFF_SW + al256((size_t)NCLS * T_ * 8);
constexpr size_t OFF_FXPART = OFF_FXINFO + al256((size_t)B_ * 8 * FX_NQB * 4);
constexpr size_t OFF_SSP = OFF_FXPART + al256((FX_NPART > FX_P1 ? FX_NPART - FX_P1 : 0) * FX_PART_BYTES);
constexpr size_t OFF_CPART = OFF_SSP + al256((size_t)T_ * 16 * 4);
constexpr size_t OFF_BIAS1P = OFF_CPART + al256((size_t)2 * 2 * B_ * 2 * NCMPP * 256 * 4);
constexpr size_t WS_END = OFF_BIAS1P + al256((size_t)8 * 2 * 256 * 4);
static_assert(D_ / 64 <= 16, "one partial per 64-column slice");
static_assert(S_ != 8192 || (FX_NQB % 4 == 0 && FX_QQ * (FX_ROWS / 64) == FX_CH), "a quarter of the query blocks must span exactly FX_CH key tiles");
constexpr int CTL_BAR = 1024;
constexpr int CTL_HIDDONE = 7168, CTL_MDQ = 15360;
constexpr int CTL_CNT = 8192, CTL_CUR = 8192 + 24 * 64, CTL_FOXQ = 192, CTL_QKB = 256, CST = 64;
constexpr size_t OFF_MIX = OFF_FQ;
constexpr size_t OFF_TN = OFF_GA;
constexpr size_t OFF_PL = OFF_FV;
constexpr size_t OFF_HID = OFF_FQ;
constexpr size_t OFF_RS = OFF_CTL + (128 << 10), OFF_BW = OFF_CTL + (256 << 10);
static_assert((size_t)NSLOT * 2 * DE_ * 2 <= 3 * SZ_HEADS && (size_t)8 * T_ * 20 * 4 <= SZ_HEADS && OFF_BW + (size_t)D_ * 20 * 4 <= SZ_CTL, "overlays");
constexpr size_t DO_H = 0, DO_OA = 0, DO_OB = (size_t)T_ * 512 * 2, DO_OBF = (size_t)T_ * 1024 * 2;

struct Params {
    const float *x, *norm_mix_g, *w_in, *b_forget, *fox_q_g, *fox_k_g, *nsa_q_g, *nsa_k_g, *cmp_k_w1, *cmp_k_w2, *cmp_k_pos, *cmp_v_w1, *cmp_v_w2, *cmp_v_pos,
        *w_fox_up, *w_nsa_up, *w_out, *norm_ffn_g, *w_group, *b_group, *w_router, *b_router, *w_gate, *w_up, *w_down;
    float* out; unsigned char* ws;
};

#ifndef CPU_EMU
DEV float u2f(unsigned u) { return __uint_as_float(u); }
DEV unsigned f2u(float f) { return __float_as_uint(f); }
#else
DEV float u2f(unsigned u) { float f; memcpy(&f, &u, 4); return f; }
DEV unsigned f2u(float f) { unsigned u; memcpy(&u, &f, 4); return u; }
#endif
DEV float bf2f(bf16 v) { return u2f((unsigned)v << 16); }
DEV bf16 f2bf(float f) { unsigned u = f2u(f); return (bf16)((u + 0x7fffu + ((u >> 16) & 1u)) >> 16); }
#ifndef CPU_EMU
DEV float sigmoidf_(float v) { return __builtin_amdgcn_rcpf(1.0f + __builtin_amdgcn_exp2f(-1.4426950408889634f * v)); }
#else
DEV float sigmoidf_(float v) { return 1.0f / (1.0f + expf(-v)); }
#endif
DEV float alibi_slope2(int h) { return exp2f(-(float)(h + 1)) * LOG2E; }
DEV int orig_col(int c) {
    if (c < C_FF) { if (c < C_NQ) return c; if (c < C_GA) return c - C_NQ + O_NQ; return c - C_GA + O_GA; }
    if (c < C_NG) return c - C_FF + O_FF;
    if (c < C_END) return c - C_NG + O_NG;
    return -1;
}
DEV void unpack8(const uint4& v, float* f) {
    f[0] = u2f(v.x << 16); f[1] = u2f(v.x & 0xffff0000u); f[2] = u2f(v.y << 16); f[3] = u2f(v.y & 0xffff0000u);
    f[4] = u2f(v.z << 16); f[5] = u2f(v.z & 0xffff0000u); f[6] = u2f(v.w << 16); f[7] = u2f(v.w & 0xffff0000u);
}
DEV void dot64(const bf16* a, const bf16* bt, size_t ldb, int K, float (&acc)[64]) {
    for (int k0 = 0; k0 < K; k0 += 8) {
        float af[8]; unpack8(*(const uint4*)(a + k0), af);
#pragma unroll
        for (int j = 0; j < 64; ++j) {
            float bfv[8]; unpack8(*(const uint4*)(bt + (size_t)j * ldb + k0), bfv);
            acc[j] += ((af[0] * bfv[0] + af[1] * bfv[1]) + (af[2] * bfv[2] + af[3] * bfv[3])) + ((af[4] * bfv[4] + af[5] * bfv[5]) + (af[6] * bfv[6] + af[7] * bfv[7]));
        }
    }
}
DEV void load64(const bf16* p, float (&q)[64]) {
#pragma unroll
    for (int c = 0; c < 8; ++c) { float f[8]; unpack8(*(const uint4*)(p + 8 * c), f);
#pragma unroll
        for (int i = 0; i < 8; ++i) q[8 * c + i] = f[i]; }
}
DEV float dotq(const float (&q)[64], const bf16* k) {
    float s = 0.f;
#pragma unroll
    for (int c = 0; c < 8; ++c) { float f[8]; unpack8(*(const uint4*)(k + 8 * c), f);
#pragma unroll
        for (int i = 0; i < 8; ++i) s += q[8 * c + i] * f[i]; }
    return s;
}
DEV void axpy64(float (&o)[64], float p, const bf16* v) {
#pragma unroll
    for (int c = 0; c < 8; ++c) { float f[8]; unpack8(*(const uint4*)(v + 8 * c), f);
#pragma unroll
        for (int i = 0; i < 8; ++i) o[8 * c + i] += p * f[i]; }
}
DEV void store64_bf16(bf16* p, const float (&v)[64]) {
#pragma unroll
    for (int c = 0; c < 8; ++c) { uint4 o;
        o.x = (unsigned)f2bf(v[8 * c + 0]) | ((unsigned)f2bf(v[8 * c + 1]) << 16); o.y = (unsigned)f2bf(v[8 * c + 2]) | ((unsigned)f2bf(v[8 * c + 3]) << 16);
        o.z = (unsigned)f2bf(v[8 * c + 4]) | ((unsigned)f2bf(v[8 * c + 5]) << 16); o.w = (unsigned)f2bf(v[8 * c + 6]) | ((unsigned)f2bf(v[8 * c + 7]) << 16);
        *(uint4*)(p + 8 * c) = o; }
}
DEV void osm_step(float s, const bf16* vrow, float& m, float& l, float (&o)[64]) {
    if (s > m) { const float a = exp2f(m - s);
#pragma unroll
        for (int i = 0; i < 64; ++i) o[i] *= a;
        l *= a; m = s; }
    const float p = exp2f(s - m); l += p; axpy64(o, p, vrow);
}

DEV void transpose_item(const float* src, int K, int N, bf16* dst, size_t i) { const int n = (int)(i / K), k = (int)(i % K); dst[i] = f2bf(src[(size_t)k * N + n]); }
DEV void phase_prep(const Params& p, long gt, long nth) {
    unsigned char* ws = p.ws;
    { bf16* d = (bf16*)(ws + OFF_WINT); for (size_t i = gt; i < (size_t)NP * D_; i += nth) { const int c = (int)(i / D_), k = (int)(i % D_), oc = orig_col(c); d[i] = oc < 0 ? (bf16)0 : f2bf(p.w_in[(size_t)k * D_IN + oc]); } }
    { bf16* d = (bf16*)(ws + OFF_WAT); for (size_t i = gt; i < (size_t)D_ * 512; i += nth) transpose_item(p.w_fox_up, 512, D_, d, i); }
    { bf16* d = (bf16*)(ws + OFF_WBT); for (size_t i = gt; i < (size_t)D_ * 512; i += nth) transpose_item(p.w_nsa_up, 512, D_, d, i); }
    { bf16* d = (bf16*)(ws + OFF_WOT); for (size_t i = gt; i < (size_t)D_ * D_; i += nth) transpose_item(p.w_out, D_, D_, d, i); }
    for (int kv = 0; kv < 2; ++kv) {
        const float* w1 = kv ? p.cmp_v_w1 : p.cmp_k_w1; const float* w2 = kv ? p.cmp_v_w2 : p.cmp_k_w2; const float* pos = kv ? p.cmp_v_pos : p.cmp_k_pos;
        bf16* d1 = (bf16*)(ws + OFF_W1T) + (size_t)kv * 256 * 2048; bf16* d2 = (bf16*)(ws + OFF_W2T) + (size_t)kv * 64 * 256; float* b1 = (float*)(ws + OFF_BIAS1) + kv * 256;
        for (size_t i = gt; i < (size_t)256 * 2048; i += nth) transpose_item(w1, 2048, 256, d1, i);
        for (size_t i = gt; i < (size_t)64 * 256; i += nth) transpose_item(w2, 256, 64, d2, i);
        for (size_t j = gt; j < 256; j += nth) { float s = 0.f; for (int k = 0; k < 2048; ++k) s += pos[k] * w1[(size_t)k * 256 + j]; b1[j] = s; }
    }
#ifdef CPU_EMU
    for (int e = 0; e < NE; ++e) {
        bf16* dg = (bf16*)(ws + OFF_WGT) + (size_t)e * DE_ * D_; bf16* du = (bf16*)(ws + OFF_WUT) + (size_t)e * DE_ * D_; bf16* dd = (bf16*)(ws + OFF_WDT) + (size_t)e * D_ * DE_;
        for (size_t i = gt; i < (size_t)DE_ * D_; i += nth) { transpose_item(p.w_gate + (size_t)e * D_ * DE_, D_, DE_, dg, i); transpose_item(p.w_up + (size_t)e * D_ * DE_, D_, DE_, du, i); }
        for (size_t i = gt; i < (size_t)D_ * DE_; i += nth) transpose_item(p.w_down + (size_t)e * DE_ * D_, DE_, D_, dd, i);
    }
#else
    {
        bf16* d = (bf16*)(ws + OFF_WGT);
        for (size_t i = gt; i < (size_t)NE * 2 * DE_ * D_; i += nth) { const int k = (int)(i % D_); const size_t r = i / D_; const int row = (int)(r % (2 * DE_)), e = (int)(r / (2 * DE_));
            const int j = (row / 64) * 32 + (row % 32); const float* src = ((row % 64) < 32 ? p.w_gate : p.w_up) + (size_t)e * D_ * DE_; d[i] = f2bf(src[(size_t)k * DE_ + j]); }
        for (int e = 0; e < NE; ++e) { bf16* dd = (bf16*)(ws + OFF_WDT) + (size_t)e * D_ * DE_; for (size_t i = gt; i < (size_t)D_ * DE_; i += nth) transpose_item(p.w_down + (size_t)e * DE_ * D_, DE_, D_, dd, i); }
        int* st = (int*)(ws + OFF_STOK); for (size_t i = gt; i < (size_t)NSLOT; i += nth) st[i] = -1;
    }
#endif
    bf16* H = (bf16*)((unsigned char*)p.out + DO_H);
    for (size_t r = gt; r < (size_t)T_; r += nth) {
        const float* xr = p.x + r * D_; float ss = 0.f; for (int k = 0; k < D_; ++k) ss += xr[k] * xr[k];
        const float rs = 1.0f / sqrtf(ss / D_ + RMS_EPS);
        for (int k = 0; k < D_; ++k) H[r * D_ + k] = f2bf(xr[k] * rs * p.norm_mix_g[k]);
    }
}
DEV void phase_inproj(const Params& p, long gt, long nth) {
    unsigned char* ws = p.ws; const bf16* H = (const bf16*)((unsigned char*)p.out + DO_H); const bf16* WT = (const bf16*)(ws + OFF_WINT);
    constexpr int NGRP = NP / 64;
    for (size_t it = gt; it < (size_t)T_ * NGRP; it += nth) {
        const int grp = (int)(it % NGRP); const size_t row = it / NGRP; const int b = (int)(row / S_), s = (int)(row % S_); const int c0 = grp * 64;
        if (c0 >= C_END) continue;
        float acc[64];
#pragma unroll
        for (int j = 0; j < 64; ++j) acc[j] = 0.f;
        dot64(H + row * D_, WT + (size_t)c0 * D_, D_, D_, acc);
        if (c0 < C_KC) {
            const int which = c0 / 512, h = (c0 % 512) / 64;
            bf16* dst = (bf16*)(ws + (which == 0 ? OFF_FQ : which == 1 ? OFF_FK : which == 2 ? OFF_FV : OFF_NQ)) + (((size_t)b * 8 + h) * S_ + s) * 64;
            if (which != 2) {
                const float* g = which == 0 ? p.fox_q_g : which == 1 ? p.fox_k_g : p.nsa_q_g; float ss = 0.f;
#pragma unroll
                for (int j = 0; j < 64; ++j) ss += acc[j] * acc[j];
                const float rs = 1.0f / sqrtf(ss * (1.0f / 64) + RMS_EPS) * (which == 1 ? 1.0f : QSCALE);
#pragma unroll
                for (int j = 0; j < 64; ++j) acc[j] = acc[j] * rs * g[j];
            }
            store64_bf16(dst, acc);
        } else if (c0 < C_GA) {
            const int which = (c0 - C_KC) / 128, g2 = ((c0 - C_KC) % 128) / 64;
            bf16* dst = (bf16*)(ws + OFF_KCR + (size_t)which * SZ_KV) + (((size_t)b * 2 + g2) * S_ + s) * 64;
            if (which == 2 || which == 4) { float ss = 0.f;
#pragma unroll
                for (int j = 0; j < 64; ++j) ss += acc[j] * acc[j];
                const float rs = 1.0f / sqrtf(ss * (1.0f / 64) + RMS_EPS);
#pragma unroll
                for (int j = 0; j < 64; ++j) acc[j] = acc[j] * rs * p.nsa_k_g[j];
            }
            store64_bf16(dst, acc);
        } else if (c0 < C_FF) {
            const bool isb = c0 >= C_GB; const int cc = c0 - (isb ? C_GB : C_GA);
#pragma unroll
            for (int j = 0; j < 64; ++j) acc[j] = sigmoidf_(acc[j]);
            store64_bf16((bf16*)(ws + (isb ? OFF_GB : OFF_GA)) + row * D_ + cc, acc);
        } else {
            float* lf = (float*)(ws + OFF_LOGF); float* gt_ = (float*)(ws + OFF_GATE);
#pragma unroll
            for (int j = 0; j < 8; ++j) { const float v = acc[j] + p.b_forget[j]; lf[((size_t)b * 8 + j) * S_ + s] = fminf(v, 0.f) - log1pf(expf(-fabsf(v))); }
#pragma unroll
            for (int j = 0; j < 24; ++j) gt_[row * 24 + j] = sigmoidf_(acc[8 + j]);
        }
    }
}
DEV void phase_scan_cmp1(const Params& p, long gt, long nth) {
    unsigned char* ws = p.ws; const float* lf = (const float*)(ws + OFF_LOGF); float* cum = (float*)(ws + OFF_CUM);
    for (size_t it = gt; it < (size_t)B_ * 8; it += nth) { float c = 0.f; for (int s = 0; s < S_; ++s) { c += lf[it * S_ + s]; cum[it * S_ + s] = c * LOG2E; } }
    for (size_t it = gt; it < (size_t)2 * B_ * 2 * NCMP * 4; it += nth) {
        const int jg = (int)(it % 4); size_t r = it / 4; const int n = (int)(r % NCMP); r /= NCMP; const int bg = (int)(r % (B_ * 2)), kv = (int)(r / (B_ * 2));
        const bf16* raw = (const bf16*)(ws + (kv ? OFF_VCR : OFF_KCR)) + ((size_t)bg * S_ + 16 * n) * 64;
        const bf16* w1t = (const bf16*)(ws + OFF_W1T) + (size_t)kv * 256 * 2048 + (size_t)jg * 64 * 2048; const float* b1 = (const float*)(ws + OFF_BIAS1) + kv * 256 + jg * 64;
        float acc[64];
#pragma unroll
        for (int j = 0; j < 64; ++j) acc[j] = b1[j];
        dot64(raw, w1t, 2048, 2048, acc);
#pragma unroll
        for (int j = 0; j < 64; ++j) { const float v = acc[j]; acc[j] = 0.5f * v * (1.0f + tanhf(0.7978845608028654f * (v + 0.044715f * v * v * v))); }
        store64_bf16((bf16*)(ws + OFF_CHID) + (((size_t)kv * B_ * 2 + bg) * NCMPP + n) * 256 + jg * 64, acc);
    }
}
DEV void phase_cmp2(const Params& p, long gt, long nth) {
    unsigned char* ws = p.ws;
    for (size_t i = gt; i < (size_t)2 * B_ * 2 * (NCMPP - NCMP) * 64; i += nth) { const int d = (int)(i % 64); size_t r = i / 64; const int n = NCMP + (int)(r % (NCMPP - NCMP)); r /= (NCMPP - NCMP); const int bg = (int)(r % (B_ * 2)), kv = (int)(r / (B_ * 2));
        ((bf16*)(ws + (kv ? OFF_VCMP : OFF_KCMP)))[((size_t)bg * NCMPP + n) * 64 + d] = 0; }
    for (size_t it = gt; it < (size_t)2 * B_ * 2 * NCMP; it += nth) {
        const int n = (int)(it % NCMP); size_t r = it / NCMP; const int bg = (int)(r % (B_ * 2)), kv = (int)(r / (B_ * 2));
        const bf16* hid = (const bf16*)(ws + OFF_CHID) + (((size_t)kv * B_ * 2 + bg) * NCMPP + n) * 256; const bf16* w2t = (const bf16*)(ws + OFF_W2T) + (size_t)kv * 64 * 256;
        float acc[64];
#pragma unroll
        for (int j = 0; j < 64; ++j) acc[j] = 0.f;
        dot64(hid, w2t, 256, 256, acc);
        if (kv == 0) { float ss = 0.f;
#pragma unroll
            for (int j = 0; j < 64; ++j) ss += acc[j] * acc[j];
            const float rs = 1.0f / sqrtf(ss * (1.0f / 64) + RMS_EPS);
#pragma unroll
            for (int j = 0; j < 64; ++j) acc[j] = acc[j] * rs * p.nsa_k_g[j];
        }
        store64_bf16((bf16*)(ws + (kv ? OFF_VCMP : OFF_KCMP)) + ((size_t)bg * NCMPP + n) * 64, acc);
    }
}
DEV void phase_fox(const Params& p, long gt, long nth) {
    unsigned char* ws = p.ws; const float* cum = (const float*)(ws + OFF_CUM); bf16* OA = (bf16*)((unsigned char*)p.out + DO_OA);
    for (size_t it = gt; it < (size_t)B_ * 8 * S_; it += nth) {
        const size_t it2 = (size_t)B_ * 8 * S_ - 1 - it;
        const int t = (int)(it2 % S_); const size_t bh = it2 / S_; const int h = (int)(bh % 8), b = (int)(bh / 8);
        const bf16* K = (const bf16*)(ws + OFF_FK) + bh * S_ * 64; const bf16* V = (const bf16*)(ws + OFF_FV) + bh * S_ * 64;
        float q[64], o[64]; load64((const bf16*)(ws + OFF_FQ) + (bh * S_ + t) * 64, q);
#pragma unroll
        for (int i = 0; i < 64; ++i) o[i] = 0.f;
        float m = -INFINITY, l = 0.f; const float cq = cum[bh * S_ + t];
        for (int k = 0; k <= t; ++k) osm_step(dotq(q, K + (size_t)k * 64) + (cq - cum[bh * S_ + k]), V + (size_t)k * 64, m, l, o);
        const float il = 1.0f / l;
#pragma unroll
        for (int i = 0; i < 64; ++i) o[i] *= il;
        store64_bf16(OA + ((size_t)b * S_ + t) * 512 + h * 64, o);
    }
}
#ifdef CPU_EMU
DEV void phase_nsa_cmp(const Params& p, long gt, long nth) {
    unsigned char* ws = p.ws; float* IMP = (float*)(ws + OFF_IMP); float* OBF = (float*)((unsigned char*)p.out + DO_OBF); const float* GATE = (const float*)(ws + OFF_GATE);
    for (size_t it = gt; it < (size_t)B_ * 2 * S_; it += nth) {
        const int t = (int)(it % S_); const size_t bg = it / S_; const int g = (int)(bg % 2), b = (int)(bg / 2);
        const bf16* KC = (const bf16*)(ws + OFF_KCMP) + bg * NCMPP * 64; const bf16* VC = (const bf16*)(ws + OFF_VCMP) + bg * NCMPP * 64;
        float* imp = IMP + it * NSLC; for (int j = 0; j < NSLC; ++j) imp[j] = 0.f;
        const int nval = t >= 31 ? (t - 31) / 16 + 1 : 0;
        for (int r = 0; r < 4; ++r) {
            const int h = g * 4 + r; const float sl = alibi_slope2(h);
            float q[64], o[64]; load64((const bf16*)(ws + OFF_NQ) + (((size_t)b * 8 + h) * S_ + t) * 64, q);
#pragma unroll
            for (int i = 0; i < 64; ++i) o[i] = 0.f;
            float m = -INFINITY, l = 0.f;
            for (int n = 0; n < nval; ++n) { const float s = dotq(q, KC + (size_t)n * 64) - sl * (float)(t - (16 * n + 31)); if (s > m) { l *= exp2f(m - s); m = s; } l += exp2f(s - m); }
            const float il = nval ? 1.0f / l : 0.f;
            for (int n = 0; n < nval; ++n) {
                const float s = dotq(q, KC + (size_t)n * 64) - sl * (float)(t - (16 * n + 31)); const float pr = exp2f(s - m) * il;
                axpy64(o, pr, VC + (size_t)n * 64);
                const int j0 = n >> 2;
                if ((n & 3) == 3) { imp[j0] += 0.5f * pr; if (j0 + 1 < NSLC) imp[j0 + 1] += 0.5f * pr; } else imp[j0] += pr;
            }
            const float g0 = GATE[((size_t)b * S_ + t) * 24 + h * 3 + 0]; float* ob = OBF + ((size_t)b * S_ + t) * 512 + h * 64;
#pragma unroll
            for (int i = 0; i < 64; ++i) ob[i] = g0 * o[i];
        }
    }
}
DEV void phase_nsa_topk(const Params& p, long gt, long nth) {
    unsigned char* ws = p.ws; const float* IMP = (const float*)(ws + OFF_IMP); int* SEL = (int*)(ws + OFF_SEL);
    for (size_t it = gt; it < (size_t)B_ * 2 * S_; it += nth) {
        const int t = (int)(it % S_); const int qb = t / 64; const float* imp = IMP + it * NSLC; int* sel = SEL + it * 16;
        static_assert(NSLC <= 128, "selection mask is 128 bits");
        unsigned long long tk0 = 0ull, tk1 = 0ull;
        for (int k = 0; k < TOPN; ++k) {
            float best = -INFINITY; int bj = 0;
            for (int j = 0; j < NSLC; ++j) {
                if (((j < 64 ? tk0 : tk1) >> (j & 63)) & 1ull) continue;
                const float sc = (j * 64 > t) ? -1.0f : ((j == 0 || j == qb || j == qb - 1) ? 1e4f : imp[j]);
                if (sc > best) { best = sc; bj = j; }
            }
            if (bj < 64) tk0 |= 1ull << bj; else tk1 |= 1ull << (bj - 64);
            sel[k] = bj;
        }
        for (int k = TOPN; k < 16; ++k) sel[k] = -1;
    }
}
DEV void phase_nsa_slc_win(const Params& p, long gt, long nth) {
    unsigned char* ws = p.ws; const int* SEL = (const int*)(ws + OFF_SEL); float* OBF = (float*)((unsigned char*)p.out + DO_OBF); const float* GATE = (const float*)(ws + OFF_GATE);
    bf16* OB = (bf16*)((unsigned char*)p.out + DO_OB);
    for (size_t it = gt; it < (size_t)B_ * 8 * S_; it += nth) {
        const int t = (int)(it % S_); const size_t bh = it / S_; const int h = (int)(bh % 8), b = (int)(bh / 8), g = h / 4; const size_t bg = (size_t)b * 2 + g;
        const float sl = alibi_slope2(h);
        float q[64], o[64]; load64((const bf16*)(ws + OFF_NQ) + (bh * S_ + t) * 64, q);
        float* ob = OBF + ((size_t)b * S_ + t) * 512 + h * 64; const float g1 = GATE[((size_t)b * S_ + t) * 24 + h * 3 + 1], g2 = GATE[((size_t)b * S_ + t) * 24 + h * 3 + 2];
#pragma unroll
        for (int i = 0; i < 64; ++i) o[i] = 0.f;
        {
            const bf16* K = (const bf16*)(ws + OFF_KS) + bg * S_ * 64; const bf16* V = (const bf16*)(ws + OFF_VS) + bg * S_ * 64; const int* sel = SEL + (bg * S_ + t) * 16;
            float m = -INFINITY, l = 0.f;
            for (int k = 0; k < 16; ++k) { const int blk = sel[k]; if (blk < 0 || blk * 64 > t) continue;
                for (int i = 0; i < 64; ++i) { const int kp = blk * 64 + i; if (kp > t) break; osm_step(dotq(q, K + (size_t)kp * 64) - sl * (float)(t - kp), V + (size_t)kp * 64, m, l, o); } }
            const float il = g1 / l;
#pragma unroll
            for (int i = 0; i < 64; ++i) { ob[i] += il * o[i]; o[i] = 0.f; }
        }
        {
            const bf16* K = (const bf16*)(ws + OFF_KW) + bg * S_ * 64; const bf16* V = (const bf16*)(ws + OFF_VW) + bg * S_ * 64;
            float m = -INFINITY, l = 0.f; const int k0 = t - 511 > 0 ? t - 511 : 0;
            for (int kp = k0; kp <= t; ++kp) osm_step(dotq(q, K + (size_t)kp * 64) - sl * (float)(t - kp), V + (size_t)kp * 64, m, l, o);
            const float il = g2 / l;
#pragma unroll
            for (int i = 0; i < 64; ++i) o[i] = ob[i] + il * o[i];
        }
        store64_bf16(OB + ((size_t)b * S_ + t) * 512 + h * 64, o);
    }
}
#endif
DEV void phase_up(const Params& p, long gt, long nth) {
    unsigned char* ws = p.ws; const bf16* OA = (const bf16*)((unsigned char*)p.out + DO_OA); const bf16* OB = (const bf16*)((unsigned char*)p.out + DO_OB);
    const bf16* GA = (const bf16*)(ws + OFF_GA); const bf16* GB = (const bf16*)(ws + OFF_GB); bf16* MIX = (bf16*)(ws + OFF_MIX);
    constexpr int NGRP = D_ / 64;
    for (size_t it = gt; it < (size_t)T_ * NGRP; it += nth) {
        const int c0 = (int)(it % NGRP) * 64; const size_t row = it / NGRP;
        float a[64], bb[64], ga[64], gb[64];
#pragma unroll
        for (int j = 0; j < 64; ++j) { a[j] = 0.f; bb[j] = 0.f; }
        dot64(OA + row * 512, (const bf16*)(ws + OFF_WAT) + (size_t)c0 * 512, 512, 512, a);
        dot64(OB + row * 512, (const bf16*)(ws + OFF_WBT) + (size_t)c0 * 512, 512, 512, bb);
        load64(GA + row * D_ + c0, ga); load64(GB + row * D_ + c0, gb);
#pragma unroll
        for (int j = 0; j < 64; ++j) a[j] = ga[j] * a[j] + gb[j] * bb[j];
        store64_bf16(MIX + row * D_ + c0, a);
    }
}
DEV void phase_outproj(const Params& p, long gt, long nth) {
    unsigned char* ws = p.ws; const bf16* MIX = (const bf16*)(ws + OFF_MIX); constexpr int NGRP = D_ / 64;
    for (size_t it = gt; it < (size_t)T_ * NGRP; it += nth) {
        const int c0 = (int)(it % NGRP) * 64; const size_t row = it / NGRP;
        float a[64];
#pragma unroll
        for (int j = 0; j < 64; ++j) a[j] = 0.f;
        dot64(MIX + row * D_, (const bf16*)(ws + OFF_WOT) + (size_t)c0 * D_, D_, D_, a);
#pragma unroll
        for (int j = 0; j < 64; ++j) p.out[row * D_ + c0 + j] = p.x[row * D_ + c0 + j] + a[j];
    }
}
DEV void phase_route(const Params& p, long gt, long nth) {
    unsigned char* ws = p.ws; bf16* TN = (bf16*)(ws + OFF_TN); int* RT = (int*)(ws + OFF_ROUTE);
    for (size_t row = gt; row < (size_t)T_; row += nth) {
        const float* xr = p.out + row * D_; float ss = 0.f; for (int k = 0; k < D_; ++k) ss += xr[k] * xr[k];
        const float rs = 1.0f / sqrtf(ss / D_ + RMS_EPS);
        float gl[4], el[16];
        for (int j = 0; j < 4; ++j) gl[j] = 0.f;
        for (int j = 0; j < 16; ++j) el[j] = 0.f;
        for (int k = 0; k < D_; ++k) { const float tv = xr[k] * rs * p.norm_ffn_g[k]; TN[row * D_ + k] = f2bf(tv);
#pragma unroll
            for (int j = 0; j < 4; ++j) gl[j] += tv * p.w_group[(size_t)k * 4 + j];
#pragma unroll
            for (int j = 0; j < 16; ++j) el[j] += tv * p.w_router[(size_t)k * 16 + j]; }
        int gtop = 0; float gm = -INFINITY;
#pragma unroll
        for (int j = 0; j < 4; ++j) { gl[j] += p.b_group[j]; if (gl[j] > gm) { gm = gl[j]; gtop = j; } }
        float gs = 0.f;
#pragma unroll
        for (int j = 0; j < 4; ++j) gs += expf(gl[j] - gm);
        const float pg = 1.0f / gs;
        float e4[4]; float em = -INFINITY; int i0 = 0;
#pragma unroll
        for (int j = 0; j < 4; ++j) { float v = 0.f;
#pragma unroll
            for (int g = 0; g < 4; ++g) v = (g == gtop) ? el[g * 4 + j] + p.b_router[g * 4 + j] : v;
            e4[j] = v; }
#pragma unroll
        for (int j = 0; j < 4; ++j) if (e4[j] > em) { em = e4[j]; i0 = j; }
        float e2 = -INFINITY; int i1 = 0;
#pragma unroll
        for (int j = 0; j < 4; ++j) if (j != i0 && e4[j] > e2) { e2 = e4[j]; i1 = j; }
        const float p0 = 1.0f, p1 = expf(e2 - em);
        const float w0 = p0 / (p0 + p1) * pg, w1 = p1 / (p0 + p1) * pg;
        RT[row * 4 + 0] = gtop * 4 + i0; RT[row * 4 + 1] = gtop * 4 + i1; RT[row * 4 + 2] = (int)f2u(w0); RT[row * 4 + 3] = (int)f2u(w1);
    }
}
DEV void phase_moe_up(const Params& p, long gt, long nth) {
    unsigned char* ws = p.ws; const bf16* TN = (const bf16*)(ws + OFF_TN); const int* RT = (const int*)(ws + OFF_ROUTE); bf16* HID = (bf16*)(ws + OFF_HID);
    constexpr int NGRP = DE_ / 64;
    for (size_t it = gt; it < (size_t)T_ * 2 * NGRP; it += nth) {
        const int c0 = (int)(it % NGRP) * 64; size_t r = it / NGRP; const int k = (int)(r % 2); const size_t row = r / 2;
        const int e = RT[row * 4 + k]; const float w = u2f((unsigned)RT[row * 4 + 2 + k]);
        float a[64], u[64];
#pragma unroll
        for (int j = 0; j < 64; ++j) { a[j] = 0.f; u[j] = 0.f; }
        dot64(TN + row * D_, (const bf16*)(ws + OFF_WGT) + ((size_t)e * DE_ + c0) * D_, D_, D_, a);
        dot64(TN + row * D_, (const bf16*)(ws + OFF_WUT) + ((size_t)e * DE_ + c0) * D_, D_, D_, u);
#pragma unroll
        for (int j = 0; j < 64; ++j) a[j] = w * (a[j] * sigmoidf_(a[j])) * u[j];
        store64_bf16(HID + row * (2 * DE_) + k * DE_ + c0, a);
    }
}
DEV void phase_moe_down(const Params& p, long gt, long nth) {
    unsigned char* ws = p.ws; const int* RT = (const int*)(ws + OFF_ROUTE); const bf16* HID = (const bf16*)(ws + OFF_HID); constexpr int NGRP = D_ / 64;
    for (size_t it = gt; it < (size_t)T_ * NGRP; it += nth) {
        const int c0 = (int)(it % NGRP) * 64; const size_t row = it / NGRP;
        float a[64];
#pragma unroll
        for (int j = 0; j < 64; ++j) a[j] = 0.f;
        for (int k = 0; k < 2; ++k) { const int e = RT[row * 4 + k]; dot64(HID + row * (2 * DE_) + k * DE_, (const bf16*)(ws + OFF_WDT) + ((size_t)e * D_ + c0) * DE_, DE_, DE_, a); }
#pragma unroll
        for (int j = 0; j < 64; ++j) p.out[row * D_ + c0 + j] += a[j];
    }
}

#ifndef CPU_EMU
typedef short bf16x8 __attribute__((ext_vector_type(8)));
typedef float f32x4 __attribute__((ext_vector_type(4)));
typedef unsigned u32x4 __attribute__((ext_vector_type(4)));
typedef unsigned u32x2 __attribute__((ext_vector_type(2)));
#define LDS3 __attribute__((address_space(3)))
constexpr int NW = CFG_NW, NTHREADS = 64 * NW, BM = 32 * NW;
constexpr int GEMM_NST = NW >= 8 ? 3 : 2, GEMM_STAGE = (128 + BM) * 128;
constexpr int LDS_TILE_BYTES = NW >= 8 ? GEMM_NST * GEMM_STAGE : 69632;
constexpr int BWL_OFF = LDS_TILE_BYTES + 32, BWL_BYTES = 128 * 20 * 4;
constexpr int LDS_BYTES = LDS_TILE_BYTES + 64 + BWL_BYTES;
static_assert(2 * LDS_BYTES <= 160 * 1024, "two workgroups per CU");
struct GemmSrc { const bf16* X; size_t ldx; const int* xidx; const bf16* W0; const bf16* W1; int ksplit; size_t ldw; int K; };
typedef float f32x2v __attribute__((ext_vector_type(2)));
typedef __bf16 bf16x2v __attribute__((ext_vector_type(2)));
DEV unsigned pk_bf16(float lo, float hi) { return __builtin_bit_cast(unsigned, __builtin_convertvector((f32x2v){lo, hi}, bf16x2v)); }
DEV void zero_acc(f32x4 (&acc)[4][4]) {
#pragma unroll
    for (int i = 0; i < 4; ++i)
#pragma unroll
        for (int j = 0; j < 4; ++j) acc[i][j] = (f32x4){0.f, 0.f, 0.f, 0.f};
}
DEV void glds16g(const void* g, unsigned lds) { unsigned keep; lds = __builtin_amdgcn_readfirstlane(lds); asm volatile("s_mov_b32 %0, m0\n\ts_mov_b32 m0, %2\n\ts_nop 0\n\tglobal_load_lds_dwordx4 %1, off\n\ts_mov_b32 m0, %0" : "=&s"(keep) : "v"(g), "s"(lds) : "memory"); }
DEV void gemm_mainloop(f32x4 (&acc)[4][4], const GemmSrc& g, int m0, int n0, unsigned char* smem) {
    constexpr int WP = 16 / NW, XP = BM / 8 / NW, NVMG = WP + XP;
    const int t = threadIdx.x, lane = t & 63, w = __builtin_amdgcn_readfirstlane(t >> 6), wn = w / (NW / 2), wm = w % (NW / 2);
    const int lr = 8 * w + (lane >> 3);
    const int gch = ((lane & 7) ^ ((4 * w + (lane >> 4)) & 7)) * 8;
    int xr[XP];
#pragma unroll
    for (int i = 0; i < XP; ++i) { int r = m0 + lr + 8 * NW * i; if (g.xidx) { r = g.xidx[r]; r = (unsigned)r < (unsigned)T_ ? r : 0; } xr[i] = r; }
    if (g.xidx) {
#pragma unroll
        for (int i = 0; i < XP; ++i) asm volatile("" :: "v"(xr[i]));
    }
    const size_t wrow0 = (size_t)(n0 + lr) * g.ldw + gch;
    const unsigned sbase = (unsigned)(size_t)(LDS3 unsigned char*)smem;
    const int fsw = ((lane >> 4) ^ ((lane & 15) >> 1)) << 4;
    const int waddr = (64 * wn + (lane & 15)) * 128 + fsw, xaddr = 16384 + (64 * wm + (lane & 15)) * 128 + fsw;
    const int nk = g.K / 64;
    auto gissue = [&](int kt) {
        const int k = kt * 64; const bf16* wb = (k < g.ksplit ? g.W0 + k : g.W1 + (k - g.ksplit)) + wrow0; const unsigned lb = sbase + (unsigned)((kt % GEMM_NST) * GEMM_STAGE + w * 1024);
#pragma unroll
        for (int i = 0; i < WP; ++i) glds16g(wb + (size_t)(8 * NW * i) * g.ldw, lb + i * (NW * 1024));
#pragma unroll
        for (int i = 0; i < XP; ++i) glds16g(g.X + (size_t)xr[i] * g.ldx + (gch + k), lb + 16384 + i * (NW * 1024));
    };
#pragma unroll
    for (int j = 0; j < GEMM_NST - 1; ++j) if (j < nk) gissue(j);
    for (int kt = 0; kt < nk; ++kt) {
        const int ahead = nk - 1 - kt < GEMM_NST - 2 ? nk - 1 - kt : GEMM_NST - 2;
        if (ahead >= 2) asm volatile("s_waitcnt vmcnt(%0)" :: "n"(2 * NVMG) : "memory"); else if (ahead == 1) asm volatile("s_waitcnt vmcnt(%0)" :: "n"(NVMG) : "memory"); else asm volatile("s_waitcnt vmcnt(0)" ::: "memory");
        __builtin_amdgcn_s_barrier();
        asm volatile("" ::: "memory");
        if (kt + GEMM_NST - 1 < nk) gissue(kt + GEMM_NST - 1);
        const unsigned char* b = smem + (kt % GEMM_NST) * GEMM_STAGE;
#pragma unroll
        for (int kk = 0; kk < 2; ++kk) {
            bf16x8 wf[4], xf[4];
#pragma unroll
            for (int i = 0; i < 4; ++i) { wf[i] = *(const bf16x8*)(b + ((waddr ^ (kk << 6)) + i * 2048)); xf[i] = *(const bf16x8*)(b + ((xaddr ^ (kk << 6)) + i * 2048)); }
            __builtin_amdgcn_s_setprio(1);
#pragma unroll
            for (int i = 0; i < 4; ++i)
#pragma unroll
                for (int j = 0; j < 4; ++j) acc[i][j] = __builtin_amdgcn_mfma_f32_16x16x32_bf16(wf[i], xf[j], acc[i][j], 0, 0, 0);
            __builtin_amdgcn_s_setprio(0);
        }
    }
    asm volatile("s_waitcnt lgkmcnt(0)" ::: "memory");
    __builtin_amdgcn_s_barrier();
    asm volatile("" ::: "memory");
}
DEV int vblock() { const int G = gridDim.x, b = blockIdx.x; return (G % 8 == 0) ? (b % 8) * (G / 8) + b / 8 : b; }
DEV void tile_coords(int lin, int ntm, int ntn, int& pm, int& pn) { const int grp = lin / (8 * ntn), rem = lin % (8 * ntn), fm = grp * 8, gsz = (ntm - fm) < 8 ? (ntm - fm) : 8; pm = fm + rem % gsz; pn = rem / gsz; }
DEV float rsum16(float v) { v += __shfl_xor(v, 16); v += __shfl_xor(v, 32); return v; }

DEV void bphase_inproj(const Params& p, unsigned char* smem) {
    unsigned char* ws = p.ws; const int lane = threadIdx.x & 63, w = threadIdx.x >> 6, wn = w / (NW / 2), wm = w % (NW / 2), q = lane >> 4, c = lane & 15;
    constexpr int NTM = T_ / BM, NTN = NP / 128;
    GemmSrc g{(const bf16*)((unsigned char*)p.out + DO_H), (size_t)D_, nullptr, (const bf16*)(ws + OFF_WINT), (const bf16*)(ws + OFF_WINT), 1 << 30, (size_t)D_, D_};
    for (int lin = vblock(); lin < NTM * NTN; lin += gridDim.x) {
        int pm, pn; tile_coords(lin, NTM, NTN, pm, pn); const int m0 = pm * BM, n0 = pn * 128;
        f32x4 acc[4][4]; zero_acc(acc);
        gemm_mainloop(acc, g, m0, n0, smem);
        const int n0w = n0 + 64 * wn, m0w = m0 + 64 * wm, b = m0 / S_, s0 = m0w % S_;
        if (n0 < C_GA) {
            bf16* dst; const float* gain = nullptr; float mul = 1.f;
            if (n0 < C_KC) { const int which = n0 / 512, h = (n0w % 512) / 64;
                dst = (bf16*)(ws + (which == 0 ? OFF_FQ : which == 1 ? OFF_FK : which == 2 ? OFF_FV : OFF_NQ)) + ((size_t)b * 8 + h) * S_ * 64;
                if (which != 2) { gain = which == 0 ? p.fox_q_g : which == 1 ? p.fox_k_g : p.nsa_q_g; mul = which == 1 ? 1.f : QSCALE; } }
            else { const int which = (n0 - C_KC) / 128; dst = (bf16*)(ws + OFF_KCR + (size_t)which * SZ_KV) + ((size_t)b * 2 + wn) * S_ * 64; if (which == 2 || which == 4) gain = p.nsa_k_g; }
            f32x4 g4[4];
#pragma unroll
            for (int nf = 0; nf < 4; ++nf) g4[nf] = gain ? *(const f32x4*)(gain + 16 * nf + 4 * q) : (f32x4){1.f, 1.f, 1.f, 1.f};
#pragma unroll
            for (int mf = 0; mf < 4; ++mf) {
                float rs = 1.f;
                if (gain) { float ss = 0.f;
#pragma unroll
                    for (int nf = 0; nf < 4; ++nf) { const f32x4 v = acc[nf][mf]; ss += (v[0] * v[0] + v[1] * v[1]) + (v[2] * v[2] + v[3] * v[3]); }
                    rs = 1.0f / sqrtf(rsum16(ss) * (1.0f / 64) + RMS_EPS) * mul; }
                bf16* drow = dst + (size_t)(s0 + 16 * mf + c) * 64 + 4 * q;
#pragma unroll
                for (int nf = 0; nf < 4; ++nf) { const f32x4 v = acc[nf][mf] * rs * g4[nf]; *(u32x2*)(drow + 16 * nf) = (u32x2){pk_bf16(v[0], v[1]), pk_bf16(v[2], v[3])}; }
            }
        } else if (n0 < C_FF) {
            const bool isb = n0 >= C_GB; bf16* dst = (bf16*)(ws + (isb ? OFF_GB : OFF_GA)) + (n0w - (isb ? C_GB : C_GA)) + 4 * q;
#pragma unroll
            for (int mf = 0; mf < 4; ++mf) { bf16* drow = dst + (size_t)(m0w + 16 * mf + c) * D_;
#pragma unroll
                for (int nf = 0; nf < 4; ++nf) { const f32x4 v = acc[nf][mf]; *(u32x2*)(drow + 16 * nf) = (u32x2){pk_bf16(sigmoidf_(v[0]), sigmoidf_(v[1])), pk_bf16(sigmoidf_(v[2]), sigmoidf_(v[3]))}; } }
        } else if (wn == 0) {
            float* lf = (float*)(ws + OFF_LOGF); float* gt_ = (float*)(ws + OFF_GATE);
#pragma unroll
            for (int mf = 0; mf < 4; ++mf) { const int m = m0w + 16 * mf + c, s = m % S_;
#pragma unroll
                for (int r = 0; r < 4; ++r) { const int j = 4 * q + r; const float v0 = acc[0][mf][r];
                    if (j < 8) { const float v = v0 + p.b_forget[j]; lf[((size_t)b * 8 + j) * S_ + s] = fminf(v, 0.f) - log1pf(expf(-fabsf(v))); }
                    else gt_[(size_t)m * 24 + (j - 8)] = sigmoidf_(v0);
                    gt_[(size_t)m * 24 + 8 + j] = sigmoidf_(acc[1][mf][r]); } }
        }
    }
}
DEV void st_dev(void* ptr, u32x2 v) { __hip_atomic_store((unsigned long long*)ptr, __builtin_bit_cast(unsigned long long, v), __ATOMIC_RELAXED, __HIP_MEMORY_SCOPE_AGENT); }
DEV void st_dev(float* ptr, float v) { __hip_atomic_store(ptr, v, __ATOMIC_RELAXED, __HIP_MEMORY_SCOPE_AGENT); }
DEV f32x2v ld_dev(const float* ptr) { return __builtin_bit_cast(f32x2v, __hip_atomic_load((const unsigned long long*)ptr, __ATOMIC_RELAXED, __HIP_MEMORY_SCOPE_AGENT)); }
DEV bf16* ao_row(const Params& p, int which  , int b, int q) { return (bf16*)((unsigned char*)p.out + (size_t)(q / BM) * ((size_t)BM * D_ * 4) + (size_t)(which * 2 + b) * ((size_t)BM * 1024) + (size_t)(q % BM) * 1024); }
DEV void up_tile(const Params& p, unsigned char* smem, int pm, int pn) {
    unsigned char* ws = p.ws; asm volatile("" : "+v"(ws)); int t = threadIdx.x; asm volatile("" : "+v"(t)); const int lane = t & 63, w = t >> 6, wn = w / (NW / 2), wm = w % (NW / 2), q = lane >> 4, c = lane & 15;
    GemmSrc ga{ao_row(p, 0, pm / (S_ / BM), (pm % (S_ / BM)) * BM), 512, nullptr, (const bf16*)(ws + OFF_WAT), (const bf16*)(ws + OFF_WAT), 1 << 30, 512, 512};
    GemmSrc gb{ao_row(p, 1, pm / (S_ / BM), (pm % (S_ / BM)) * BM), 512, nullptr, (const bf16*)(ws + OFF_WBT), (const bf16*)(ws + OFF_WBT), 1 << 30, 512, 512};
    const bf16* GA = (const bf16*)(ws + OFF_GA); const bf16* GB = (const bf16*)(ws + OFF_GB); bf16* MIX = (bf16*)(ws + OFF_MIX);
    {
        const int m0 = pm * BM, n0 = pn * 128;
        f32x4 acc[4][4], acc2[4][4]; zero_acc(acc); zero_acc(acc2);
        gemm_mainloop(acc, ga, 0, n0, smem);
        gemm_mainloop(acc2, gb, 0, n0, smem);
        const int n0w = n0 + 64 * wn, m0w = m0 + 64 * wm;
        const unsigned eoff = (unsigned)(((size_t)(m0w + c) * D_ + n0w + 4 * q) * 2);
#pragma unroll
        for (int mf = 0; mf < 4; ++mf) {
#pragma unroll
            for (int nf = 0; nf < 4; ++nf) { const unsigned off = eoff + (unsigned)(mf * 16 * D_ * 2 + nf * 32); const u32x2 gv = *(const u32x2*)((const unsigned char*)GA + off), hv = *(const u32x2*)((const unsigned char*)GB + off);
                const f32x4 v = acc[nf][mf] * (f32x4){u2f(gv.x << 16), u2f(gv.x & 0xffff0000u), u2f(gv.y << 16), u2f(gv.y & 0xffff0000u)} + acc2[nf][mf] * (f32x4){u2f(hv.x << 16), u2f(hv.x & 0xffff0000u), u2f(hv.y << 16), u2f(hv.y & 0xffff0000u)};
                __hip_atomic_store((unsigned long long*)((unsigned char*)MIX + off), __builtin_bit_cast(unsigned long long, (u32x2){pk_bf16(v[0], v[1]), pk_bf16(v[2], v[3])}), __ATOMIC_RELAXED, __HIP_MEMORY_SCOPE_AGENT); }
            asm volatile("" ::: "memory"); }
    }
}
DEV void out_tile(const Params& p, unsigned char* smem, int pm, int pn) {
    unsigned char* ws = p.ws; asm volatile("" : "+v"(ws)); int t = threadIdx.x; asm volatile("" : "+v"(t)); const int lane = t & 63, w = t >> 6, wn = w / (NW / 2), wm = w % (NW / 2), q = lane >> 4, c = lane & 15;
    GemmSrc g{(const bf16*)(ws + OFF_MIX), (size_t)D_, nullptr, (const bf16*)(ws + OFF_WOT), (const bf16*)(ws + OFF_WOT), 1 << 30, (size_t)D_, D_};
    {
        const int m0 = pm * BM, n0 = pn * 128;
        f32x4 acc[4][4]; zero_acc(acc);
        const int n0w = n0 + 64 * wn, m0w = m0 + 64 * wm; float* ssp = (float*)(ws + OFF_SSP);
        {
            const unsigned lb = (unsigned)(size_t)(LDS3 unsigned char*)smem + BWL_OFF; const unsigned char* src = ws + OFF_BW + (size_t)n0 * 80 + lane * 16;
            const int w1 = __builtin_amdgcn_readfirstlane(w);
            for (int ch = w1; ch < BWL_BYTES / 1024; ch += NW) glds16g(src + ch * 1024, lb + ch * 1024);
        }
        f32x4 xv[4][4];
#pragma unroll
        for (int mf = 0; mf < 4; ++mf)
#pragma unroll
            for (int nf = 0; nf < 4; ++nf) xv[mf][nf] = *(const f32x4*)(p.x + (size_t)(m0w + 16 * mf + c) * D_ + n0w + 16 * nf + 4 * q);
        gemm_mainloop(acc, g, m0, n0, smem);
        const float* bwl = (const float*)(smem + BWL_OFF) + (64 * wn + 4 * q) * 20 + c; bf16* TN = (bf16*)(ws + OFF_TN);
        f32x4 gf[4];
#pragma unroll
        for (int nf = 0; nf < 4; ++nf) gf[nf] = *(const f32x4*)(p.norm_ffn_g + n0w + 16 * nf + 4 * q);
        float* red = (float*)smem;
#pragma unroll
        for (int mf = 0; mf < 4; ++mf) { float ss = 0.f; f32x4 a0 = {0.f, 0.f, 0.f, 0.f}, a1 = {0.f, 0.f, 0.f, 0.f};
#pragma unroll
            for (int nf = 0; nf < 4; ++nf) { const size_t off = (size_t)(m0w + 16 * mf + c) * D_ + n0w + 16 * nf + 4 * q; const f32x4 v = xv[mf][nf] + acc[nf][mf]; *(f32x4*)(p.out + off) = v; ss += (v[0] * v[0] + v[1] * v[1]) + (v[2] * v[2] + v[3] * v[3]);
                const f32x4 tv = v * gf[nf]; *(u32x2*)(TN + off) = (u32x2){pk_bf16(tv[0], tv[1]), pk_bf16(tv[2], tv[3])};
#pragma unroll
                for (int i = 0; i < 4; ++i) { const float b0 = bwl[(16 * nf + i) * 20], b1 = c < 4 ? bwl[(16 * nf + i) * 20 + 16] : 0.f; a0 = __builtin_amdgcn_mfma_f32_16x16x4f32(v[i], b0, a0, 0, 0, 0); a1 = __builtin_amdgcn_mfma_f32_16x16x4f32(v[i], b1, a1, 0, 0, 0); } }
            ss = rsum16(ss); if (q == 0) red[(wn * BM + 64 * wm + 16 * mf + c) * 24 + 20] = ss;
            float* rr = red + (wn * BM + 64 * wm + 16 * mf + 4 * q) * 24 + c;
#pragma unroll
            for (int r = 0; r < 4; ++r) { rr[r * 24] = a0[r]; if (c < 4) rr[r * 24 + 16] = a1[r]; } }
        __syncthreads();
        float* plt = (float*)(ws + OFF_PL) + ((size_t)pn * T_ + m0) * 20;
        for (int idx = t; idx < BM * 5; idx += NTHREADS) { const int row = idx / 5, k = idx % 5; const f32x4 v = *(const f32x4*)(red + row * 24 + 4 * k) + *(const f32x4*)(red + (BM + row) * 24 + 4 * k);
            st_dev(plt + 4 * idx, (u32x2){f2u(v[0]), f2u(v[1])}); st_dev(plt + 4 * idx + 2, (u32x2){f2u(v[2]), f2u(v[3])}); }
        if (t < BM) st_dev(ssp + (size_t)pn * T_ + m0 + t, red[t * 24 + 20] + red[(BM + t) * 24 + 20]);
    }
}

struct TrJob { const float* src; int ldsrc; bf16* dst; int lddst; int kind; int e; };
DEV void transpose_tile(const TrJob& j, int r0, int k0) {
    const int lane = threadIdx.x & 63;
    const float* colp; bool valid = true;
    if (j.kind == 0) colp = j.src + (r0 + lane);
    else if (j.kind == 1) { const int oc = orig_col(r0 + lane); valid = oc >= 0; colp = j.src + (valid ? oc : 0); }
    else { const int jj = (r0 / 64) * 32 + (lane & 31); colp = j.src + jj; }
    colp += (size_t)k0 * j.ldsrc;
    bf16* drow = j.dst + (size_t)(r0 + lane) * j.lddst + k0;
#pragma unroll
    for (int h = 0; h < 2; ++h) {
        float v[32];
#pragma unroll
        for (int kk = 0; kk < 32; ++kk) v[kk] = valid ? colp[(size_t)(32 * h + kk) * j.ldsrc] : 0.f;
#pragma unroll
        for (int c8 = 0; c8 < 4; ++c8) *(u32x4*)(drow + 32 * h + 8 * c8) = (u32x4){pk_bf16(v[8 * c8], v[8 * c8 + 1]), pk_bf16(v[8 * c8 + 2], v[8 * c8 + 3]), pk_bf16(v[8 * c8 + 4], v[8 * c8 + 5]), pk_bf16(v[8 * c8 + 6], v[8 * c8 + 7])};
    }
}
constexpr int T_WIN = (NP / 64) * (D_ / 64), T_WA = (D_ / 64) * (512 / 64), T_WO = (D_ / 64) * (D_ / 64), T_W1 = (256 / 64) * (2048 / 64), T_W2 = (64 / 64) * (256 / 64),
              T_GU = (2 * DE_ / 64) * (D_ / 64), T_WD = (D_ / 64) * (DE_ / 64);
constexpr int NJOB0 = T_WIN + 2 * T_W1 + 2 * T_W2, NJOB1 = 2 * T_WA + T_WO, NJOB2 = NE * (T_GU + T_WD);
DEV void prep_job(const Params& p, int stage, int r) {
    unsigned char* ws = p.ws; asm volatile("" : "+v"(ws)); const int lane = threadIdx.x & 63; TrJob j; int K = D_;
    if (stage == 0) {
        if (r < T_WIN) { j = TrJob{p.w_in, D_IN, (bf16*)(ws + OFF_WINT), D_, 1, 0}; K = D_; }
        else if ((r -= T_WIN) < 2 * T_W1) { const int kv = r / T_W1; r %= T_W1; j = TrJob{kv ? p.cmp_v_w1 : p.cmp_k_w1, 256, (bf16*)(ws + OFF_W1T) + (size_t)kv * 256 * 2048, 2048, 0, 0}; K = 2048; }
        else { r -= 2 * T_W1; const int kv = r / T_W2; r %= T_W2; j = TrJob{kv ? p.cmp_v_w2 : p.cmp_k_w2, 64, (bf16*)(ws + OFF_W2T) + (size_t)kv * 128 * 256, 256, 0, 0}; K = 256; }
    } else if (stage == 1) {
        if (r < T_WA) { j = TrJob{p.w_fox_up, D_, (bf16*)(ws + OFF_WAT), 512, 0, 0}; K = 512; }
        else if ((r -= T_WA) < T_WA) { j = TrJob{p.w_nsa_up, D_, (bf16*)(ws + OFF_WBT), 512, 0, 0}; K = 512; }
        else { r -= T_WA; j = TrJob{p.w_out, D_, (bf16*)(ws + OFF_WOT), D_, 0, 0}; K = D_; }
    } else {
        if (r < NE * T_GU) { const int e = r / T_GU; r %= T_GU; j = TrJob{nullptr, DE_, (bf16*)(ws + OFF_WGT) + (size_t)e * 2 * DE_ * D_, D_, 2, e}; K = D_; }
        else { r -= NE * T_GU; const int e = r / T_WD; r %= T_WD; j = TrJob{p.w_down + (size_t)e * DE_ * D_, D_, (bf16*)(ws + OFF_WDT) + (size_t)e * D_ * DE_, DE_, 0, 0}; K = DE_; }
    }
    const int nkt = K / 64, r0 = (r / nkt) * 64, k0 = (r % nkt) * 64;
    if (j.kind == 2) j.src = ((lane < 32) ? p.w_gate : p.w_up) + (size_t)j.e * D_ * DE_;
    transpose_tile(j, r0, k0);
}
DEV void route_item(const Params& p, unsigned char* smem, int R) {
    unsigned char* ws = p.ws; asm volatile("" : "+v"(ws)); int t = threadIdx.x; asm volatile("" : "+v"(t));
    unsigned* cnt = (unsigned*)(ws + OFF_CTL) + CTL_CNT; const size_t stoff = OFF_STOK, swoff = OFF_SW;
    static_assert(NTHREADS == 2 * BM, "two threads per token");
    const int half = t & 1; const size_t row = (size_t)R * BM + (t >> 1); float* l = (float*)smem + (t >> 1) * 21;
    f32x2v acc[10]; float ss = 0.f;
#pragma unroll
    for (int j = 0; j < 10; ++j) acc[j] = (f32x2v){0.f, 0.f};
#pragma unroll
    for (int pp = 0; pp < 4; ++pp) { const int part = 4 * half + pp; const float* pl = (const float*)(ws + OFF_PL) + ((size_t)part * T_ + row) * 20;
#pragma unroll
        for (int j = 0; j < 10; ++j) acc[j] += ld_dev(pl + 2 * j);
        ss += __hip_atomic_load((const float*)(ws + OFF_SSP) + (size_t)part * T_ + row, __ATOMIC_RELAXED, __HIP_MEMORY_SCOPE_AGENT); }
#pragma unroll
    for (int j = 0; j < 10; ++j) { acc[j][0] += __shfl_xor(acc[j][0], 1); acc[j][1] += __shfl_xor(acc[j][1], 1); }
    ss += __shfl_xor(ss, 1);
    if (half == 0) {
        const float rsr = 1.0f / sqrtf(ss / D_ + RMS_EPS);
        ((float*)(ws + OFF_RS))[row] = rsr;
#pragma unroll
        for (int j = 0; j < 10; ++j) { l[2 * j] = acc[j][0]; l[2 * j + 1] = acc[j][1]; }
        float gl[4]; int gtop = 0; float gm = -INFINITY;
#pragma unroll
        for (int j = 0; j < 4; ++j) { gl[j] = l[16 + j] * rsr + p.b_group[j]; if (gl[j] > gm) { gm = gl[j]; gtop = j; } }
        float gs = 0.f;
#pragma unroll
        for (int j = 0; j < 4; ++j) gs += expf(gl[j] - gm);
        const float pg = 1.0f / gs;
        float e4[4]; float em = -INFINITY; int i0 = 0;
#pragma unroll
        for (int j = 0; j < 4; ++j) { e4[j] = l[gtop * 4 + j] * rsr + p.b_router[gtop * 4 + j]; if (e4[j] > em) { em = e4[j]; i0 = j; } }
        float e2 = -INFINITY; int i1 = 0;
#pragma unroll
        for (int j = 0; j < 4; ++j) if (j != i0 && e4[j] > e2) { e2 = e4[j]; i1 = j; }
        const float p1 = expf(e2 - em); const float w0 = 1.0f / (1.0f + p1) * pg, w1 = p1 / (1.0f + p1) * pg;
        const int lo = i0 < i1 ? i0 : i1, hi = i0 < i1 ? i1 : i0; const int pidx = lo == 0 ? hi - 1 : (lo == 1 ? hi + 1 : 5);
        const int cls = gtop * 6 + pidx;
        const unsigned rank = atomicAdd(cnt + cls * CST, 1u);
        ((int*)(ws + stoff))[(size_t)cls * T_ + rank] = (int)row; float* swp = (float*)(ws + swoff) + ((size_t)cls * T_ + rank) * 2; swp[0] = i0 < i1 ? w0 : w1; swp[1] = i0 < i1 ? w1 : w0;
    }
}
DEV void class_experts(int cls, int& elo, int& ehi) { const int g = cls / 6, pi = cls % 6; const int lo = pi < 3 ? 0 : (pi < 5 ? 1 : 2); const int hi = pi < 3 ? pi + 1 : (pi < 5 ? pi - 1 : 3); elo = g * 4 + lo; ehi = g * 4 + hi; }
DEV int moe_find_class(const unsigned* cnt, int mtile_lin, int& tile0, int& ntc) {
    int t0 = 0;
    for (int k = 0; k < NCLS; ++k) { const int n = (int)((cnt[k * CST] + (unsigned)(BM - 1)) / (unsigned)BM); if (mtile_lin < t0 + n) { tile0 = t0; ntc = n; return k; } t0 += n; }
    return -1;
}
DEV int moe_total_tiles(const unsigned* cnt) { int t0 = 0; for (int k = 0; k < NCLS; ++k) t0 += (int)((cnt[k * CST] + (unsigned)(BM - 1)) / (unsigned)BM); return t0; }
DEV void dep_post(unsigned* ctr, bool wb);
DEV void dep_wait(unsigned* ctr, unsigned target, unsigned* bar, bool acq);
DEV unsigned xb_xcc_id();
DEV void bphase_moe_up(const Params& p, unsigned char* smem) {
    unsigned char* ws = p.ws; const int lane = threadIdx.x & 63, w = threadIdx.x >> 6, wn = w / (NW / 2), wm = w % (NW / 2), q = lane >> 4, c = lane & 15;
    const unsigned* cnt = (const unsigned*)(ws + OFF_CTL) + CTL_CNT; bf16* HID = (bf16*)(ws + OFF_HID);
    constexpr int NTN = (2 * 2 * DE_) / 128, NTE = NTN / 2;
    const int tot = moe_total_tiles(cnt);
    for (int lin = vblock(); lin < tot * NTN; lin += gridDim.x) {
        int cls = -1, t0 = 0, ntc = 0, acc_t = 0;
        for (int k = 0; k < NCLS; ++k) { const int n = (int)((cnt[k * CST] + (unsigned)(BM - 1)) / (unsigned)BM); if (cls < 0 && lin < (acc_t + n) * NTN) { cls = k; t0 = acc_t; ntc = n; } acc_t += n; }
        const int idin = lin - t0 * NTN, nt = idin / ntc, mt = idin % ntc; const int slot0 = (t0 + mt) * BM;
        int elo, ehi; class_experts(cls, elo, ehi); const int half = nt / NTE, e = half ? ehi : elo; const int n0 = (nt % NTE) * 128;
        const bf16* wb = (const bf16*)(ws + OFF_WGT) + (size_t)e * (2 * DE_) * D_;
        const int* st = (const int*)(ws + OFF_STOK) + (size_t)cls * T_; const float* sw = (const float*)(ws + OFF_SW) + (size_t)cls * T_ * 2;
        GemmSrc g{(const bf16*)(ws + OFF_TN), (size_t)D_, st, wb, wb, 1 << 30, (size_t)D_, D_};
        f32x4 acc[4][4]; zero_acc(acc);
        float wt4[4], rs4[4];
        { const unsigned ncl = cnt[cls * CST];
#pragma unroll
          for (int mf = 0; mf < 4; ++mf) { const int rk = mt * BM + 64 * wm + 16 * mf + c; const bool vr = (unsigned)rk < ncl; const int tok = vr ? st[rk] : 0; wt4[mf] = vr ? sw[2 * rk + half] : 0.f; rs4[mf] = vr ? ((const float*)(ws + OFF_RS))[tok] : 0.f; } }
        gemm_mainloop(acc, g, mt * BM, n0, smem);
        const int j0 = ((n0 + 64 * wn) / 64) * 32;
#pragma unroll
        for (int mf = 0; mf < 4; ++mf) { const int slot = slot0 + 64 * wm + 16 * mf + c; const float wt = wt4[mf], rsr = rs4[mf]; bf16* drow = HID + (size_t)slot * (2 * DE_) + half * DE_ + j0 + 4 * q;
#pragma unroll
            for (int nf = 0; nf < 2; ++nf) { const f32x4 gv = acc[nf][mf], uv = acc[nf + 2][mf]; f32x4 h;
#pragma unroll
                for (int r = 0; r < 4; ++r) { const float gs = gv[r] * rsr; h[r] = wt * (gs * sigmoidf_(gs)) * (uv[r] * rsr); }
                st_dev(drow + 16 * nf, (u32x2){pk_bf16(h[0], h[1]), pk_bf16(h[2], h[3])}); } }
        dep_post((unsigned*)(ws + OFF_CTL) + CTL_HIDDONE + 4 * (t0 + mt), false);
    }
}
DEV void bphase_moe_down(const Params& p, unsigned char* smem) {
    unsigned char* ws = p.ws; const int lane = threadIdx.x & 63, w = threadIdx.x >> 6, wn = w / (NW / 2), wm = w % (NW / 2), q = lane >> 4, c = lane & 15;
    const unsigned* cnt = (const unsigned*)(ws + OFF_CTL) + CTL_CNT;
    constexpr int NTN = D_ / 128;
    const int tot = moe_total_tiles(cnt);
    unsigned* ctl = (unsigned*)(ws + OFF_CTL); int* slot = (int*)(smem + LDS_BYTES - 16); const unsigned x = xb_xcc_id() & 7u;
    for (unsigned s8 = 0; s8 < 8; ++s8) { const unsigned xq = (x + s8) & 7u;
      for (;;) {
        if (threadIdx.x == 0) slot[0] = (int)atomicAdd(ctl + CTL_MDQ + 64 * xq, 1u);
        __syncthreads();
        const int nq = slot[0];
        __syncthreads();
        const int lin = ((nq >> 6) * 8 + (int)xq) * 64 + (nq & 63);
        if ((lin & ~63) >= tot * NTN) break;
        if (lin >= tot * NTN) continue;
        int cls = -1, t0 = 0, ntc = 0, acc_t = 0;
        for (int k = 0; k < NCLS; ++k) { const int n = (int)((cnt[k * CST] + (unsigned)(BM - 1)) / (unsigned)BM); if (cls < 0 && lin < (acc_t + n) * NTN) { cls = k; t0 = acc_t; ntc = n; } acc_t += n; }
        const int idin = lin - t0 * NTN, nt = idin / ntc, mt = idin % ntc; const int slot0 = (t0 + mt) * BM, n0 = nt * 128;
        dep_wait(ctl + CTL_HIDDONE + 4 * (t0 + mt), 16u, ctl + CTL_BAR, false);
        int elo, ehi; class_experts(cls, elo, ehi);
        GemmSrc g{(const bf16*)(ws + OFF_HID), (size_t)(2 * DE_), nullptr, (const bf16*)(ws + OFF_WDT) + (size_t)elo * D_ * DE_, (const bf16*)(ws + OFF_WDT) + (size_t)ehi * D_ * DE_, DE_, (size_t)DE_, 2 * DE_};
        f32x4 acc[4][4]; zero_acc(acc);
        const int n0w = n0 + 64 * wn; const unsigned ncl = cnt[cls * CST];
        f32x4 xv[4][4]; int tk[4];
#pragma unroll
        for (int mf = 0; mf < 4; ++mf) { const int rk = mt * BM + 64 * wm + 16 * mf + c; tk[mf] = (unsigned)rk < ncl ? ((const int*)(ws + OFF_STOK))[(size_t)cls * T_ + rk] : -1; }
#pragma unroll
        for (int mf = 0; mf < 4; ++mf) { const float* orow = p.out + (size_t)(tk[mf] < 0 ? 0 : tk[mf]) * D_ + n0w + 4 * q;
#pragma unroll
            for (int nf = 0; nf < 4; ++nf) xv[mf][nf] = *(const f32x4*)(orow + 16 * nf); }
        gemm_mainloop(acc, g, slot0, n0, smem);
#pragma unroll
        for (int mf = 0; mf < 4; ++mf) { if (tk[mf] < 0) continue; float* orow = p.out + (size_t)tk[mf] * D_ + n0w + 4 * q;
#pragma unroll
            for (int nf = 0; nf < 4; ++nf) *(f32x4*)(orow + 16 * nf) = xv[mf][nf] + acc[nf][mf]; }
      }
    }
}

typedef float f32x16 __attribute__((ext_vector_type(16)));
typedef short s16x4 __attribute__((ext_vector_type(4)));
constexpr int AT_K = 0, AT_V = 8192, AT_B = 16384, AT_STAGE = 16384 + (NW > 4 ? NW : 4) * 256;
constexpr float NEG_BIG = -INFINITY;
constexpr float SM_THR = 8.0f;
DEV float xhalf_max(float v) { auto rr = __builtin_amdgcn_permlane32_swap(f2u(v), f2u(v), false, false); return fmaxf(u2f(rr[0]), u2f(rr[1])); }
DEV float xhalf_sum(float v) { auto rr = __builtin_amdgcn_permlane32_swap(f2u(v), f2u(v), false, false); return u2f(rr[0]) + u2f(rr[1]); }
DEV bf16x8 pack8(const f32x16& p, int b) {
    u32x4 w = {pk_bf16(p[b + 0], p[b + 1]), pk_bf16(p[b + 2], p[b + 3]), pk_bf16(p[b + 4], p[b + 5]), pk_bf16(p[b + 6], p[b + 7])};
    return __builtin_bit_cast(bf16x8, w);
}
struct AttnLane {
    int kofs[4];
    int vofs;
};
DEV AttnLane attn_lane_setup(int lane) {
    AttnLane a; const int r = lane & 31, hh = lane >> 5, sw = (r >> 1) & 7;
#pragma unroll
    for (int s = 0; s < 4; ++s) a.kofs[s] = r * 128 + (((2 * s + hh) ^ sw) << 4);
    const int qq = (lane & 15) >> 2, pp = lane & 3, blk = (lane >> 4) & 1; const int cb = (2 * blk + (pp >> 1)) ^ (((qq >> 1) & 1) << 2);
    a.vofs = (4 * hh + qq) * 128 + (cb << 4) + 8 * (pp & 1);
    return a;
}
DEV void attn_qk(f32x16& sA, f32x16& sB, const unsigned char* kt, const AttnLane& a, const bf16x8 (&qf)[4]) {
#pragma unroll
    for (int s = 0; s < 4; ++s) { const bf16x8 ka = *(const bf16x8*)(kt + a.kofs[s]); const bf16x8 kb = *(const bf16x8*)(kt + 4096 + a.kofs[s]);
        sA = __builtin_amdgcn_mfma_f32_32x32x16_bf16(ka, qf[s], sA, 0, 0, 0); sB = __builtin_amdgcn_mfma_f32_32x32x16_bf16(kb, qf[s], sB, 0, 0, 0); }
}
DEV void attn_bias_init(f32x16& sA, f32x16& sB, const float* bl, int hh) {
#pragma unroll
    for (int g = 0; g < 4; ++g) { const f32x4 va = *(const f32x4*)(bl + 8 * g + 4 * hh); const f32x4 vb = *(const f32x4*)(bl + 32 + 8 * g + 4 * hh);
#pragma unroll
        for (int r = 0; r < 4; ++r) { sA[4 * g + r] = va[r]; sB[4 * g + r] = vb[r]; } }
}
DEV void attn_softmax(f32x16& sA, f32x16& sB, float& m, float& l, f32x16& o0, f32x16& o1, bf16x8 (&pa)[4]) {
    float mx = sA[0];
#pragma unroll
    for (int i = 1; i < 16; ++i) mx = fmaxf(mx, sA[i]);
#pragma unroll
    for (int i = 0; i < 16; ++i) mx = fmaxf(mx, sB[i]);
    mx = xhalf_max(mx);
    float ms = m == NEG_BIG ? 0.f : m, alpha = 1.0f;
    if (__builtin_amdgcn_ballot_w64(mx > m + SM_THR)) {
        const float mn = fmaxf(m, mx); ms = mn == NEG_BIG ? 0.f : mn;
        alpha = __builtin_amdgcn_exp2f(m - ms); m = mn;
        o0 = o0 * alpha; o1 = o1 * alpha;
    }
    float ps = 0.f;
#pragma unroll
    for (int i = 0; i < 16; ++i) { sA[i] = __builtin_amdgcn_exp2f(sA[i] - ms); ps += sA[i]; }
#pragma unroll
    for (int i = 0; i < 16; ++i) { sB[i] = __builtin_amdgcn_exp2f(sB[i] - ms); ps += sB[i]; }
    l = l * alpha + ps;
    pa[0] = pack8(sA, 0); pa[1] = pack8(sA, 8); pa[2] = pack8(sB, 0); pa[3] = pack8(sB, 8);
}
template <int OFF> DEV s16x4 tr_read(unsigned addr) { s16x4 r; asm volatile("ds_read_b64_tr_b16 %0, %1 offset:%2" : "=&v"(r) : "v"(addr), "i"(OFF) : "memory"); return r; }
DEV void attn_pv(f32x16& o0, f32x16& o1, const unsigned char* vt, const AttnLane& a, const bf16x8 (&pa)[4]) {
    const unsigned vb = (unsigned)(size_t)(LDS3 const unsigned char*)vt + (unsigned)a.vofs;
#pragma unroll
    for (int dt = 0; dt < 2; ++dt) {
        const unsigned vd = vb ^ (unsigned)(dt << 6);
        const s16x4 l0 = tr_read<0>(vd), h0 = tr_read<1024>(vd), l1 = tr_read<2048>(vd), h1 = tr_read<3072>(vd), l2 = tr_read<4096>(vd), h2 = tr_read<5120>(vd), l3 = tr_read<6144>(vd), h3 = tr_read<7168>(vd);
        asm volatile("s_waitcnt lgkmcnt(0)" ::: "memory"); __builtin_amdgcn_sched_barrier(0);
#define PKV(L, H) (bf16x8){L[0], L[1], L[2], L[3], H[0], H[1], H[2], H[3]}
        f32x16& o = dt ? o1 : o0;
        o = __builtin_amdgcn_mfma_f32_32x32x16_bf16(PKV(l0, h0), pa[0], o, 0, 0, 0);
        o = __builtin_amdgcn_mfma_f32_32x32x16_bf16(PKV(l1, h1), pa[1], o, 0, 0, 0);
        o = __builtin_amdgcn_mfma_f32_32x32x16_bf16(PKV(l2, h2), pa[2], o, 0, 0, 0);
        o = __builtin_amdgcn_mfma_f32_32x32x16_bf16(PKV(l3, h3), pa[3], o, 0, 0, 0);
    }
}
DEV void attn_softmax_pv(f32x16& sA, f32x16& sB, float& m, float& l, f32x16& o0, f32x16& o1, const unsigned char* vt, const AttnLane& a) {
    float mx = sA[0];
#pragma unroll
    for (int i = 1; i < 16; ++i) mx = fmaxf(mx, sA[i]);
#pragma unroll
    for (int i = 0; i < 16; ++i) mx = fmaxf(mx, sB[i]);
    mx = xhalf_max(mx);
    float ms = m == NEG_BIG ? 0.f : m, alpha = 1.0f;
    if (__builtin_amdgcn_ballot_w64(mx > m + SM_THR)) {
        const float mn = fmaxf(m, mx); ms = mn == NEG_BIG ? 0.f : mn;
        alpha = __builtin_amdgcn_exp2f(m - ms); m = mn;
        o0 = o0 * alpha; o1 = o1 * alpha;
    }
    __builtin_amdgcn_sched_barrier(0);
    const unsigned vb = (unsigned)(size_t)(LDS3 const unsigned char*)vt + (unsigned)a.vofs, vd1 = vb ^ 64u;
    const s16x4 l0 = tr_read<0>(vb), h0 = tr_read<1024>(vb), l1 = tr_read<2048>(vb), h1 = tr_read<3072>(vb), l2 = tr_read<4096>(vb), h2 = tr_read<5120>(vb), l3 = tr_read<6144>(vb), h3 = tr_read<7168>(vb);
    __builtin_amdgcn_sched_barrier(0);
    float ps = 0.f;
#pragma unroll
    for (int i = 0; i < 16; ++i) { sA[i] = __builtin_amdgcn_exp2f(sA[i] - ms); ps += sA[i]; }
#pragma unroll
    for (int i = 0; i < 16; ++i) { sB[i] = __builtin_amdgcn_exp2f(sB[i] - ms); ps += sB[i]; }
    l = l * alpha + ps;
    const bf16x8 pa0 = pack8(sA, 0), pa1 = pack8(sA, 8), pa2 = pack8(sB, 0), pa3 = pack8(sB, 8);
    asm volatile("s_waitcnt lgkmcnt(0)" ::: "memory"); __builtin_amdgcn_sched_barrier(0);
    o0 = __builtin_amdgcn_mfma_f32_32x32x16_bf16(PKV(l0, h0), pa0, o0, 0, 0, 0);
    o0 = __builtin_amdgcn_mfma_f32_32x32x16_bf16(PKV(l1, h1), pa1, o0, 0, 0, 0);
    o0 = __builtin_amdgcn_mfma_f32_32x32x16_bf16(PKV(l2, h2), pa2, o0, 0, 0, 0);
    o0 = __builtin_amdgcn_mfma_f32_32x32x16_bf16(PKV(l3, h3), pa3, o0, 0, 0, 0);
    __builtin_amdgcn_sched_barrier(0);
    const s16x4 m0 = tr_read<0>(vd1), n0 = tr_read<1024>(vd1), m1 = tr_read<2048>(vd1), n1 = tr_read<3072>(vd1), m2 = tr_read<4096>(vd1), n2 = tr_read<5120>(vd1), m3 = tr_read<6144>(vd1), n3 = tr_read<7168>(vd1);
    asm volatile("s_waitcnt lgkmcnt(0)" ::: "memory"); __builtin_amdgcn_sched_barrier(0);
    o1 = __builtin_amdgcn_mfma_f32_32x32x16_bf16(PKV(m0, n0), pa0, o1, 0, 0, 0);
    o1 = __builtin_amdgcn_mfma_f32_32x32x16_bf16(PKV(m1, n1), pa1, o1, 0, 0, 0);
    o1 = __builtin_amdgcn_mfma_f32_32x32x16_bf16(PKV(m2, n2), pa2, o1, 0, 0, 0);
    o1 = __builtin_amdgcn_mfma_f32_32x32x16_bf16(PKV(m3, n3), pa3, o1, 0, 0, 0);
#undef PKV
}
DEV void glds16(const void* g, unsigned lds) { unsigned keep; lds = __builtin_amdgcn_readfirstlane(lds); asm volatile("s_mov_b32 %0, m0\n\ts_mov_b32 m0, %2\n\ts_nop 0\n\tglobal_load_lds_dwordx4 %1, off\n\ts_mov_b32 m0, %0" : "=&s"(keep) : "v"(g), "s"(lds) : "memory"); }
DEV void glds4(const void* g, unsigned lds) { unsigned keep; lds = __builtin_amdgcn_readfirstlane(lds); asm volatile("s_mov_b32 %0, m0\n\ts_mov_b32 m0, %2\n\ts_nop 0\n\tglobal_load_lds_dword %1, off\n\ts_mov_b32 m0, %0" : "=&s"(keep) : "v"(g), "s"(lds) : "memory"); }
DEV void kv_issue(const bf16* Kg, const bf16* Vg, int key0, unsigned sb  ) {
    const int t = threadIdx.x, lane = t & 63, w = __builtin_amdgcn_readfirstlane(t >> 6), row = 8 * w + (lane >> 3), p = lane & 7;
    const int ck = (p ^ ((row >> 1) & 7)) * 8, cv = (p ^ (((row >> 1) & 1) << 2)) * 8;
#pragma unroll
    for (int i = 0; i < 8 / NW + (8 % NW != 0); ++i) { if (NW > 8 && w >= 8) break; const size_t ro = (size_t)(key0 + row + 8 * NW * i) * 64;
        glds16(Kg + ro + ck, sb + AT_K + (w + NW * i) * 1024);
        glds16(Vg + ro + cv, sb + AT_V + (w + NW * i) * 1024); }
}
constexpr int KV_NVM = 2 * (8 / NW);
static_assert(8 % NW == 0, "K/V staging assumes the wave count divides 8");
template <int GB  , class KeyF, class BiasF, class NeedF, class ConsF>
DEV void stream_tiles(unsigned char* smem, const bf16* Kg, const bf16* Vg, const float* gbias, int ntiles, KeyF key0_of, BiasF bias_of, int brow, const AttnLane& al, const bf16x8 (&qf)[4], int hh, NeedF need, ConsF cons) {
    if (ntiles <= 0) return;
    const int t = threadIdx.x, lane = t & 63, w = __builtin_amdgcn_readfirstlane(t >> 6);
    auto issue = [&](int i) {
        const int k0 = key0_of(i); unsigned char* sb = smem + (i % 3) * AT_STAGE; const unsigned sba = (unsigned)(size_t)(LDS3 unsigned char*)smem + (unsigned)((i % 3) * AT_STAGE);
        kv_issue(Kg, Vg, k0, sba);
        if (GB) glds4(gbias + k0 + lane, sba + AT_B + w * 256);
        else if (t < 256) ((float*)(sb + AT_B))[t] = bias_of(k0, t);
    };
    auto qk = [&](int i, f32x16& sA, f32x16& sB) {
        if (need(i)) { const unsigned char* sb = smem + (i % 3) * AT_STAGE; attn_bias_init(sA, sB, (const float*)(sb + AT_B) + brow, hh); attn_qk(sA, sB, sb + AT_K, al, qf); }
        __builtin_amdgcn_sched_barrier(0);
    };
    auto sync_next = [&](int i) {
        asm volatile("s_waitcnt vmcnt(0)" ::: "memory"); asm volatile("s_waitcnt lgkmcnt(0)" ::: "memory");
        __builtin_amdgcn_s_barrier(); asm volatile("" ::: "memory");
        if (i + 2 < ntiles) issue(i + 2);
    };
    issue(0); if (ntiles > 1) issue(1);
    if (ntiles > 1) asm volatile("s_waitcnt vmcnt(%0)" :: "n"(KV_NVM + GB) : "memory"); else asm volatile("s_waitcnt vmcnt(0)" ::: "memory");
    asm volatile("s_waitcnt lgkmcnt(0)" ::: "memory");
    __builtin_amdgcn_s_barrier(); asm volatile("" ::: "memory");
    f32x16 a0, b0, a1, b1;
    qk(0, a0, b0);
    for (int i = 0; i < ntiles; i += 2) {
        if (i + 1 < ntiles) { sync_next(i); qk(i + 1, a1, b1); }
        if (need(i)) cons(i, smem + (i % 3) * AT_STAGE, a0, b0);
        if (i + 1 < ntiles) {
            if (i + 2 < ntiles) { sync_next(i + 1); qk(i + 2, a0, b0); }
            if (need(i + 1)) cons(i + 1, smem + ((i + 1) % 3) * AT_STAGE, a1, b1);
        }
    }
    asm volatile("s_waitcnt lgkmcnt(0)" ::: "memory");
    __builtin_amdgcn_s_barrier();
    asm volatile("" ::: "memory");
}
DEV int fx_nch(int qb) { return ((FX_ROWS / 64) * (qb + 1) + FX_CH - 1) / FX_CH; }
DEV int fx_part_index(int bh, int qb, int c) {
    const int off = qb < 2 * FX_QQ ? (qb - FX_QQ) * 2 : (qb < 3 * FX_QQ ? 2 * FX_QQ + (qb - 2 * FX_QQ) * 3 : 5 * FX_QQ + (qb - 3 * FX_QQ) * 4);
    return bh * FX_PART_PER_BH + off + c;
}
DEV unsigned char* fx_part_ptr(const Params& p, int pi) { return (size_t)pi < FX_P1 ? (unsigned char*)p.out + (size_t)T_ * 1024 * 2 + (size_t)pi * FX_PART_BYTES : p.ws + OFF_FXPART + ((size_t)pi - FX_P1) * FX_PART_BYTES; }
DEV void fox_unit(const Params& p, unsigned char* smem, int bh, int qb, int c) {
    unsigned char* ws = p.ws; int t = threadIdx.x; asm volatile("" : "+v"(t)); asm volatile("" : "+v"(ws));
    const int lane = t & 63, w = t >> 6, r = lane & 31, hh = lane >> 5;
    const bf16* Kg = (const bf16*)(ws + OFF_FK) + (size_t)bh * S_ * 64; const bf16* Vg = (const bf16*)(ws + OFF_FV) + (size_t)bh * S_ * 64; const float* cum = (const float*)(ws + OFF_CUM) + (size_t)bh * S_;
    const int q0 = qb * FX_ROWS, qw0 = q0 + 32 * w, q = qw0 + r;
    const int ntiles = (q0 + FX_ROWS) / 64;
    int* kts = (int*)(smem + LDS_TILE_BYTES + 16);
    if (t == 0) kts[0] = ntiles - 1;
    __syncthreads();
    { const float cref = cum[q0], thr = -(160.0f + 2.0f * ((const float*)(ws + OFF_CTL))[CTL_QKB]); if (t < ntiles && cum[t * 64 + 63] - cref >= thr) atomicMin(kts, t); }
    __syncthreads();
    const int kt0 = kts[0], cfirst = kt0 / FX_CH, nch = fx_nch(qb);
    const int lo = c * FX_CH > kt0 ? c * FX_CH : kt0, hi = (c + 1) * FX_CH < ntiles ? (c + 1) * FX_CH : ntiles;
    if (c == nch - 1 && t == 0) st_dev((float*)(ws + OFF_FXINFO) + bh * FX_NQB + qb, __builtin_bit_cast(float, cfirst));
    if (lo >= hi) return;
    const AttnLane al = attn_lane_setup(lane);
    bf16x8 qf[4]; { const bf16* qrow = (const bf16*)(ws + OFF_FQ) + ((size_t)bh * S_ + q) * 64 + 8 * hh;
#pragma unroll
        for (int s = 0; s < 4; ++s) qf[s] = *(const bf16x8*)(qrow + 16 * s); }
    asm volatile("" :: "v"(qf[0]), "v"(qf[1]), "v"(qf[2]), "v"(qf[3]));
    f32x16 o0, o1;
#pragma unroll
    for (int i = 0; i < 16; ++i) { o0[i] = 0.f; o1[i] = 0.f; }
    float m = NEG_BIG, l = 0.f;
    stream_tiles<1>(smem, Kg, Vg, cum, hi - lo, [&](int i) { return (lo + i) * 64; }, [&](int k0, int tt) { return 0.f; }, w * 64, al, qf, hh,
        [&](int i) { return (lo + i) * 64 <= qw0 + 31; },
        [&](int i, const unsigned char* sb, f32x16& sA, f32x16& sB) {
            const int kt = lo + i;
            if (kt * 64 + 63 > qw0) {
#pragma unroll
                for (int e = 0; e < 16; ++e) { const int key = kt * 64 + (e & 3) + 8 * (e >> 2) + 4 * hh; if (key > q) sA[e] = NEG_BIG; if (key + 32 > q) sB[e] = NEG_BIG; }
            }
            attn_softmax_pv(sA, sB, m, l, o0, o1, sb + AT_V, al);
        });
    const float lt = xhalf_sum(l);
    if (nch - cfirst == 1) {
        const float il = 1.0f / lt;
        bf16* orow = ao_row(p, 0, bh / 8, q) + (bh % 8) * 64 + 4 * hh;
#pragma unroll
        for (int g = 0; g < 4; ++g) {
            st_dev(orow + 8 * g, (u32x2){pk_bf16(o0[4 * g] * il, o0[4 * g + 1] * il), pk_bf16(o0[4 * g + 2] * il, o0[4 * g + 3] * il)});
            st_dev(orow + 32 + 8 * g, (u32x2){pk_bf16(o1[4 * g] * il, o1[4 * g + 1] * il), pk_bf16(o1[4 * g + 2] * il, o1[4 * g + 3] * il)}); }
    } else {
        unsigned char* pp = fx_part_ptr(p, fx_part_index(bh, qb, c)); bf16* orow = (bf16*)pp + (size_t)(32 * w + r) * 64 + 4 * hh;
#pragma unroll
        for (int g = 0; g < 4; ++g) {
            st_dev(orow + 8 * g, (u32x2){pk_bf16(o0[4 * g], o0[4 * g + 1]), pk_bf16(o0[4 * g + 2], o0[4 * g + 3])});
            st_dev(orow + 32 + 8 * g, (u32x2){pk_bf16(o1[4 * g], o1[4 * g + 1]), pk_bf16(o1[4 * g + 2], o1[4 * g + 3])}); }
        if (hh == 0) { float* ml = (float*)(pp + FX_ROWS * 64 * 2); st_dev(ml + 32 * w + r, m); st_dev(ml + FX_ROWS + 32 * w + r, lt); }
    }
}
DEV void fox_merge(const Params& p, int bh, int qb) {
    unsigned char* ws = p.ws; asm volatile("" : "+v"(ws)); const int t = threadIdx.x, row = t >> 1, half = t & 1;
    const int cfirst = ((const int*)(ws + OFF_FXINFO))[bh * FX_NQB + qb], nch = fx_nch(qb);
    if (nch - cfirst < 2) return;
    float mt = NEG_BIG;
    for (int c = cfirst; c < nch; ++c) mt = fmaxf(mt, ((const float*)(fx_part_ptr(p, fx_part_index(bh, qb, c)) + FX_ROWS * 64 * 2))[row]);
    float acc[32], lt = 0.f;
#pragma unroll
    for (int i = 0; i < 32; ++i) acc[i] = 0.f;
    for (int c = cfirst; c < nch; ++c) {
        const unsigned char* pp = fx_part_ptr(p, fx_part_index(bh, qb, c)); const float* ml = (const float*)(pp + FX_ROWS * 64 * 2);
        const float mc = ml[row]; if (mc == NEG_BIG) continue;
        const float sc = __builtin_amdgcn_exp2f(mc - mt); lt += sc * ml[FX_ROWS + row];
        const u32x4* src = (const u32x4*)((const bf16*)pp + (size_t)row * 64 + 32 * half);
#pragma unroll
        for (int k = 0; k < 4; ++k) { const u32x4 v = src[k];
            acc[8 * k + 0] += sc * u2f(v.x << 16); acc[8 * k + 1] += sc * u2f(v.x & 0xffff0000u); acc[8 * k + 2] += sc * u2f(v.y << 16); acc[8 * k + 3] += sc * u2f(v.y & 0xffff0000u);
            acc[8 * k + 4] += sc * u2f(v.z << 16); acc[8 * k + 5] += sc * u2f(v.z & 0xffff0000u); acc[8 * k + 6] += sc * u2f(v.w << 16); acc[8 * k + 7] += sc * u2f(v.w & 0xffff0000u); }
    }
    const float il = 1.0f / lt;
    bf16* orow = ao_row(p, 0, bh / 8, qb * FX_ROWS + row) + (bh % 8) * 64 + 32 * half;
#pragma unroll
    for (int k = 0; k < 4; ++k) { st_dev(orow + 8 * k, (u32x2){pk_bf16(acc[8 * k] * il, acc[8 * k + 1] * il), pk_bf16(acc[8 * k + 2] * il, acc[8 * k + 3] * il)}); st_dev(orow + 8 * k + 4, (u32x2){pk_bf16(acc[8 * k + 4] * il, acc[8 * k + 5] * il), pk_bf16(acc[8 * k + 6] * il, acc[8 * k + 7] * il)}); }
}
constexpr int NSQ = 8 * NW;
constexpr int NS_IMP = 3 * AT_STAGE, NS_SEL = NS_IMP + NSQ * 128 * 4, NS_UNI = NS_SEL + NSQ * 16, NS_WUNI = NS_UNI + 16, NS_CNT = NS_WUNI + NW * 16, NS_LIST = NS_CNT + 16, NS_END = NS_LIST + 128;
static_assert(NS_END <= LDS_TILE_BYTES && NSLC <= 128, "NSA LDS map");
DEV void nsa_item(const Params& p, unsigned char* smem, int bg, int qb) {
    unsigned char* ws = p.ws; int t = threadIdx.x; asm volatile("" : "+v"(t)); asm volatile("" : "+v"(ws));
    const int lane = t & 63, w = t >> 6, r = lane & 31, hh = lane >> 5;
    const int b = bg / 2, g = bg % 2, q0 = qb * NSQ, hl = r >> 3, head = g * 4 + hl, qi = 8 * w + (r & 7), qpos = q0 + qi, qblk = qpos >> 6;
    const AttnLane al = attn_lane_setup(lane);
    bf16x8 qf[4]; { const bf16* qrow = (const bf16*)(ws + OFF_NQ) + (((size_t)b * 8 + head) * S_ + qpos) * 64 + 8 * hh;
#pragma unroll
        for (int s = 0; s < 4; ++s) qf[s] = *(const bf16x8*)(qrow + 16 * s); }
    asm volatile("" :: "v"(qf[0]), "v"(qf[1]), "v"(qf[2]), "v"(qf[3]));
    float* imp = (float*)(smem + NS_IMP); unsigned* selw = (unsigned*)(smem + NS_SEL); unsigned* uni = (unsigned*)(smem + NS_UNI); unsigned* wuni = (unsigned*)(smem + NS_WUNI);
    int* lcnt = (int*)(smem + NS_CNT); unsigned char* blist = smem + NS_LIST;
    for (int i = t; i < NSQ * 128; i += NTHREADS) imp[i] = 0.f;
    if (t < 4) uni[t] = 0u; if (t < 4 * NW) wuni[t] = 0u;
    __syncthreads();
    float gate[3]; { const float* gp = (const float*)(ws + OFF_GATE) + ((size_t)b * S_ + qpos) * 24 + head * 3; gate[0] = gp[0]; gate[1] = gp[1]; gate[2] = gp[2]; }
    asm volatile("" :: "v"(gate[0]), "v"(gate[1]), "v"(gate[2]));
    const float sl_t = alibi_slope2(g * 4 + ((t >> 6) & 3));
    int dead_dist; { const float dd = (160.0f + 2.0f * ((const float*)(ws + OFF_CTL))[CTL_QKB + 1]) / alibi_slope2(g * 4 + 3); dead_dist = dd < (float)S_ ? (int)dd + 1 : S_; }
    f32x16 tot0, tot1, o0, o1;
#pragma unroll
    for (int i = 0; i < 16; ++i) { tot0[i] = 0.f; tot1[i] = 0.f; o0[i] = 0.f; o1[i] = 0.f; }
    {
        const bf16* Kg = (const bf16*)(ws + OFF_KCMP) + (size_t)bg * NCMPP * 64; const bf16* Vg = (const bf16*)(ws + OFF_VCMP) + (size_t)bg * NCMPP * 64;
        const int ncmp = (q0 + NSQ - 32) / 16 + 1, ntl_all = (ncmp + 63) / 64;
        const int tc0 = dead_dist >= S_ ? 0 : (((q0 - 31 - dead_dist - 16) / 16 + 1) > 0 ? ((q0 - 31 - dead_dist - 16) / 16 + 1) / 64 : 0);
        const int ntl = ntl_all - tc0;
        auto key0_of = [&](int i) { return (tc0 + i) * 64; };
        auto bias_of = [&](int k0, int tt) { return sl_t * (float)(16 * (k0 + (tt & 63)) + 31 - q0); };
        float m = NEG_BIG, l = 0.f;
        auto cmask = [&](int i, f32x16& sA, f32x16& sB) {
#pragma unroll
            for (int e = 0; e < 16; ++e) { const int n = (tc0 + i) * 64 + (e & 3) + 8 * (e >> 2) + 4 * hh; if (16 * n + 31 > qpos) sA[e] = NEG_BIG; if (16 * (n + 32) + 31 > qpos) sB[e] = NEG_BIG; }
        };
        auto always = [&](int) { return true; };
        stream_tiles<0>(smem, Kg, Vg, nullptr, ntl, key0_of, bias_of, hl * 64, al, qf, hh, always, [&](int i, const unsigned char* sb, f32x16& sA, f32x16& sB) {
            cmask(i, sA, sB);
            float mx = sA[0];
#pragma unroll
            for (int e = 1; e < 16; ++e) mx = fmaxf(mx, sA[e]);
#pragma unroll
            for (int e = 0; e < 16; ++e) mx = fmaxf(mx, sB[e]);
            mx = xhalf_max(mx);
            const float mn = fmaxf(m, mx), ms = mn == NEG_BIG ? 0.f : mn; float ps = 0.f;
#pragma unroll
            for (int e = 0; e < 16; ++e) ps += __builtin_amdgcn_exp2f(sA[e] - ms) + __builtin_amdgcn_exp2f(sB[e] - ms);
            l = l * __builtin_amdgcn_exp2f(m - ms) + ps; m = mn;
        });
        const float lt = xhalf_sum(l), il = lt > 0.f ? 1.0f / lt : 0.f, ms = m == NEG_BIG ? 0.f : m;
        stream_tiles<0>(smem, Kg, Vg, nullptr, ntl, key0_of, bias_of, hl * 64, al, qf, hh, always, [&](int i, const unsigned char* sb, f32x16& sA, f32x16& sB) {
            cmask(i, sA, sB);
#pragma unroll
            for (int e = 0; e < 16; ++e) { sA[e] = __builtin_amdgcn_exp2f(sA[e] - ms) * il; sB[e] = __builtin_amdgcn_exp2f(sB[e] - ms) * il; }
            bf16x8 pa[4] = {pack8(sA, 0), pack8(sA, 8), pack8(sB, 0), pack8(sB, 8)};
            __builtin_amdgcn_sched_barrier(0);
            attn_pv(o0, o1, sb + AT_V, al, pa);
            __builtin_amdgcn_sched_barrier(0);
#pragma unroll
            for (int blk = 0; blk < 2; ++blk)
#pragma unroll
                for (int gq = 0; gq < 4; ++gq) {
                    const f32x16& sp = blk ? sB : sA;
                    float sp3 = 0.5f * sp[4 * gq + 3], mainv = (sp[4 * gq] + sp[4 * gq + 1]) + (sp[4 * gq + 2] + sp3);
                    mainv += __shfl_xor(mainv, 8); mainv += __shfl_xor(mainv, 16); sp3 += __shfl_xor(sp3, 8); sp3 += __shfl_xor(sp3, 16);
                    const int j = (tc0 + i) * 16 + 8 * blk + 2 * gq + hh;
                    if (hl == 0 && j < NSLC) { atomicAdd(imp + qi * 128 + j, mainv); if (j + 1 < NSLC) atomicAdd(imp + qi * 128 + j + 1, sp3); }
                }
        });
        const float g0 = gate[0];
        tot0 = o0 * g0; tot1 = o1 * g0;
    }
    {
        const int part = lane & 7, ql = lane >> 3, qp = q0 + 8 * w + ql, qb64 = qp >> 6; const float* irow = imp + (8 * w + ql) * 128 + part * 16;
        float v[16];
#pragma unroll
        for (int e = 0; e < 16; ++e) { const int j = part * 16 + e; v[e] = (j >= NSLC || j > qb64) ? -1.0f : ((j == 0 || j == qb64 || j == qb64 - 1) ? 1e4f : irow[e]); }
        unsigned mk[4] = {0u, 0u, 0u, 0u};
        if (__builtin_amdgcn_ballot_w64(qb64 >= TOPN)) {
            for (int it = 0; it < TOPN; ++it) {
                float bv = v[0]; int bj = part * 16;
#pragma unroll
                for (int e = 1; e < 16; ++e) if (v[e] > bv) { bv = v[e]; bj = part * 16 + e; }
#pragma unroll
                for (int off = 1; off < 8; off <<= 1) { const float ov = __shfl_xor(bv, off); const int oj = __shfl_xor(bj, off); if (ov > bv || (ov == bv && oj < bj)) { bv = ov; bj = oj; } }
#pragma unroll
                for (int e = 0; e < 16; ++e) if (part * 16 + e == bj) v[e] = -2.0f;
                if (bj <= qb64) {
#pragma unroll
                    for (int k = 0; k < 4; ++k) mk[k] |= (bj >> 5) == k ? (1u << (bj & 31)) : 0u; }
            }
        } else {
#pragma unroll
            for (int k = 0; k < 4; ++k) { const int hi = qb64 - 32 * k; mk[k] = hi >= 31 ? 0xffffffffu : (hi < 0 ? 0u : ((2u << hi) - 1u)); }
        }
        if (part == 0) {
#pragma unroll
            for (int k = 0; k < 4; ++k) { selw[(8 * w + ql) * 4 + k] = mk[k]; atomicOr(uni + k, mk[k]); atomicOr(wuni + w * 4 + k, mk[k]); } }
    }
    unsigned char* park = smem + NS_IMP + w * 4096 + r * 128 + 8 * hh;
#pragma unroll
    for (int gq = 0; gq < 4; ++gq) {
        *(u32x2*)(park + 16 * gq) = (u32x2){pk_bf16(tot0[4 * gq], tot0[4 * gq + 1]), pk_bf16(tot0[4 * gq + 2], tot0[4 * gq + 3])};
        *(u32x2*)(park + 64 + 16 * gq) = (u32x2){pk_bf16(tot1[4 * gq], tot1[4 * gq + 1]), pk_bf16(tot1[4 * gq + 2], tot1[4 * gq + 3])}; }
    __syncthreads();
    {
        bool on = false; int below = 0; int* wcnt = lcnt + 1;
        if (t < 128) {
            const bool live = q0 - (64 * t + 63) <= dead_dist;
            on = t < NSLC && live && ((uni[t >> 5] >> (t & 31)) & 1u); const unsigned long long bal = __builtin_amdgcn_ballot_w64(on);
            below = __builtin_popcountll(bal & ((1ull << lane) - 1ull)); if (lane == 0) wcnt[t >> 6] = __builtin_popcountll(bal);
        }
        __syncthreads();
        if (on) blist[(t >= 64 ? wcnt[0] : 0) + below] = (unsigned char)t;
        if (t == 0) lcnt[0] = wcnt[0] + wcnt[1];
    }
    __syncthreads();
    {
        const bf16* Kg = (const bf16*)(ws + OFF_KS) + (size_t)bg * S_ * 64; const bf16* Vg = (const bf16*)(ws + OFF_VS) + (size_t)bg * S_ * 64;
        const int ntl = lcnt[0];
#pragma unroll
        for (int i = 0; i < 16; ++i) { o0[i] = 0.f; o1[i] = 0.f; }
        float m = NEG_BIG, l = 0.f;
        stream_tiles<0>(smem, Kg, Vg, nullptr, ntl, [&](int i) { return (int)blist[i] * 64; }, [&](int k0, int tt) { return sl_t * (float)(k0 + (tt & 63) - q0); }, hl * 64, al, qf, hh,
            [&](int i) { const int jb = blist[i]; return (bool)((wuni[w * 4 + (jb >> 5)] >> (jb & 31)) & 1u); },
            [&](int i, const unsigned char* sb, f32x16& sA, f32x16& sB) {
                const int jb = blist[i];
                const bool mine = (selw[qi * 4 + (jb >> 5)] >> (jb & 31)) & 1u;
#pragma unroll
                for (int e = 0; e < 16; ++e) { const int kp = jb * 64 + (e & 3) + 8 * (e >> 2) + 4 * hh; if (!mine || kp > qpos) sA[e] = NEG_BIG; if (!mine || kp + 32 > qpos) sB[e] = NEG_BIG; }
                attn_softmax_pv(sA, sB, m, l, o0, o1, sb + AT_V, al);
            });
        const float gl = gate[1] / xhalf_sum(l);
#pragma unroll
        for (int gq = 0; gq < 4; ++gq) {
            const u32x2 a = *(const u32x2*)(park + 16 * gq), bq = *(const u32x2*)(park + 64 + 16 * gq);
            *(u32x2*)(park + 16 * gq) = (u32x2){pk_bf16(u2f(a.x << 16) + o0[4 * gq] * gl, u2f(a.x & 0xffff0000u) + o0[4 * gq + 1] * gl), pk_bf16(u2f(a.y << 16) + o0[4 * gq + 2] * gl, u2f(a.y & 0xffff0000u) + o0[4 * gq + 3] * gl)};
            *(u32x2*)(park + 64 + 16 * gq) = (u32x2){pk_bf16(u2f(bq.x << 16) + o1[4 * gq] * gl, u2f(bq.x & 0xffff0000u) + o1[4 * gq + 1] * gl), pk_bf16(u2f(bq.y << 16) + o1[4 * gq + 2] * gl, u2f(bq.y & 0xffff0000u) + o1[4 * gq + 3] * gl)}; }
    }
    {
        const bf16* Kg = (const bf16*)(ws + OFF_KW) + (size_t)bg * S_ * 64; const bf16* Vg = (const bf16*)(ws + OFF_VW) + (size_t)bg * S_ * 64;
        const int klo = q0 - 511 > 0 ? q0 - 511 : 0, t_lo = klo / 64, t_hi = (q0 + NSQ - 1) / 64;
#pragma unroll
        for (int i = 0; i < 16; ++i) { o0[i] = 0.f; o1[i] = 0.f; }
        float m = NEG_BIG, l = 0.f;
        stream_tiles<0>(smem, Kg, Vg, nullptr, t_hi - t_lo + 1, [&](int i) { return (t_lo + i) * 64; }, [&](int k0, int tt) { return sl_t * (float)(k0 + (tt & 63) - q0); }, hl * 64, al, qf, hh,
            [&](int) { return true; },
            [&](int i, const unsigned char* sb, f32x16& sA, f32x16& sB) {
                const int k0 = (t_lo + i) * 64;
                if (k0 + 63 > q0 + 8 * w || k0 < q0 + 8 * w + 7 - 511) {
#pragma unroll
                    for (int e = 0; e < 16; ++e) { const int kp = k0 + (e & 3) + 8 * (e >> 2) + 4 * hh; if (kp > qpos || kp < qpos - 511) sA[e] = NEG_BIG; if (kp + 32 > qpos || kp + 32 < qpos - 511) sB[e] = NEG_BIG; }
                }
                attn_softmax_pv(sA, sB, m, l, o0, o1, sb + AT_V, al);
            });
        const float gl = gate[2] / xhalf_sum(l);
        int qpos2 = qpos; asm volatile("" : "+v"(qpos2));
        bf16* orow = ao_row(p, 1, b, qpos2) + head * 64 + 4 * hh;
#pragma unroll
        for (int gq = 0; gq < 4; ++gq) {
            const u32x2 a = *(const u32x2*)(park + 16 * gq), bq = *(const u32x2*)(park + 64 + 16 * gq);
            st_dev(orow + 8 * gq, (u32x2){pk_bf16(u2f(a.x << 16) + o0[4 * gq] * gl, u2f(a.x & 0xffff0000u) + o0[4 * gq + 1] * gl), pk_bf16(u2f(a.y << 16) + o0[4 * gq + 2] * gl, u2f(a.y & 0xffff0000u) + o0[4 * gq + 3] * gl)});
            st_dev(orow + 32 + 8 * gq, (u32x2){pk_bf16(u2f(bq.x << 16) + o1[4 * gq] * gl, u2f(bq.x & 0xffff0000u) + o1[4 * gq + 1] * gl), pk_bf16(u2f(bq.y << 16) + o1[4 * gq + 2] * gl, u2f(bq.y & 0xffff0000u) + o1[4 * gq + 3] * gl)}); }
    }
}
#define XB_TMO      128
#define XB_XCNT(j)  (256  + 64 * (j))
#define XB_XSUB(j)  (1280 + 64 * (j))
#define XB_XGEN(j)  (2304 + 64 * (j))
#define XB_TOP      3328
#define XB_TOPGEN   3392
#define XB_SPIN_CAP (1u << 20)
DEV unsigned xb_ld(unsigned* p) { return __hip_atomic_load(p, __ATOMIC_RELAXED, __HIP_MEMORY_SCOPE_AGENT); }
DEV unsigned xb_add(unsigned* p, unsigned v) { return __hip_atomic_fetch_add(p, v, __ATOMIC_RELAXED, __HIP_MEMORY_SCOPE_AGENT); }
DEV unsigned xb_xcc_id() { return (unsigned)__builtin_amdgcn_s_getreg((3 << 11) | 20) & 0xFu; }
#define XB_SPIN(cond, bar) do { unsigned _sp = 0; while (cond) { __builtin_amdgcn_s_sleep(1); \
    if ((++_sp & 255u) == 0u) { if (xb_ld(&(bar)[XB_TMO])) break; if (_sp > XB_SPIN_CAP) { atomicAdd(&(bar)[XB_TMO], 1u); break; } } } } while (0)
struct XcdBarrier { unsigned* bar; unsigned x; volatile unsigned* st; };
DEV XcdBarrier xcd_barrier_post(unsigned* bar, volatile unsigned* st) { XcdBarrier b; b.bar = bar; b.x = xb_xcc_id(); b.st = st; if (threadIdx.x == 0) (void)xb_add(&bar[XB_XCNT(b.x)], 1u); return b; }
DEV void xcd_barrier_complete(unsigned* bar, unsigned x, unsigned& nloc, unsigned& nx) {
    const unsigned G = gridDim.x; unsigned sum, cnt, mine, sp = 0u;
    for (;;) {
        sum = 0u; cnt = 0u; mine = 0u;
#pragma unroll
        for (unsigned j = 0; j < 16; ++j) { const unsigned c = xb_ld(&bar[XB_XCNT(j)]); sum += c; cnt += (c > 0u) ? 1u : 0u; mine = (j == x) ? c : mine; }
        if (sum == G) break;
        __builtin_amdgcn_s_sleep(1);
        if ((++sp & 255u) == 0u) { if (xb_ld(&bar[XB_TMO])) break; if (sp > XB_SPIN_CAP) { atomicAdd(&bar[XB_TMO], 1u); break; } }
    }
    nloc = mine > 0u ? mine : 1u; nx = cnt > 0u ? cnt : 1u;
}
DEV void xcd_barrier(const XcdBarrier& b) {
    asm volatile("s_waitcnt vmcnt(0)" ::: "memory");
    __syncthreads();
    if (threadIdx.x == 0) {
        unsigned* bar = b.bar;
        __builtin_amdgcn_s_waitcnt(0);
        unsigned nloc = b.st[0], nx = b.st[1];
        if (nloc == 0u) { xcd_barrier_complete(bar, b.x, nloc, nx); b.st[0] = nloc; b.st[1] = nx; }
        const unsigned old = xb_add(&bar[XB_XSUB(b.x)], 1u);
        const unsigned gen = old / nloc;
        if (old + 1u == (gen + 1u) * nloc) {
            __builtin_amdgcn_fence(__ATOMIC_RELEASE, "agent");
            asm volatile("s_waitcnt vmcnt(0)" ::: "memory");
            const unsigned og = xb_add(&bar[XB_TOP], 1u);
            const unsigned tg = og / nx;
            if (og + 1u == (tg + 1u) * nx) xb_add(&bar[XB_TOPGEN], 1u);
            else XB_SPIN(xb_ld(&bar[XB_TOPGEN]) == tg, bar);
            __builtin_amdgcn_fence(__ATOMIC_ACQUIRE, "agent");
            xb_add(&bar[XB_XGEN(b.x)], 1u);
            asm volatile("s_waitcnt vmcnt(0)" ::: "memory");
        } else {
            XB_SPIN(xb_ld(&bar[XB_XGEN(b.x)]) == gen, bar);
            __builtin_amdgcn_fence(__ATOMIC_ACQUIRE, "agent");
            asm volatile("s_waitcnt vmcnt(0)" ::: "memory");
        }
    }
    __syncthreads();
}

constexpr int CTL_DEP = 320;
DEV void dep_post(unsigned* ctr, bool wb) {
    asm volatile("s_waitcnt vmcnt(0)" ::: "memory"); __syncthreads();
    if (threadIdx.x == 0) { if (wb) { __builtin_amdgcn_fence(__ATOMIC_RELEASE, "agent"); asm volatile("s_waitcnt vmcnt(0)" ::: "memory"); } (void)xb_add(ctr, 1u); }
}
DEV bool dep_post_last(unsigned* ctr, unsigned target, int* slot) {
    asm volatile("s_waitcnt vmcnt(0)" ::: "memory"); __syncthreads();
    if (threadIdx.x == 0) slot[1] = (xb_add(ctr, 1u) + 1u == target) ? 1 : 0;
    __syncthreads();
    return slot[1] != 0;
}
DEV void dep_wait(unsigned* ctr, unsigned target, unsigned* bar, bool acq) {
    if (threadIdx.x == 0) { XB_SPIN(xb_ld(ctr) < target, bar); if (acq) __builtin_amdgcn_fence(__ATOMIC_ACQUIRE, "agent"); asm volatile("s_waitcnt vmcnt(0)" ::: "memory"); }
    __syncthreads();
}
DEV void bphase_prep(const Params& p, unsigned char* smem, int stage, int skip) {
    unsigned char* ws = p.ws; const int t = threadIdx.x, lane = t & 63, w = t >> 6;
    const int G = gridDim.x, nj = stage ? NJOB1 : NJOB0, first = stage ? (vblock() + G - (skip % G)) % G : (int)blockIdx.x;
    for (int it = first * NW + w; it < nj; it += G * NW) prep_job(p, stage, __builtin_amdgcn_readfirstlane(it));
    if (stage) return;
    for (int i = blockIdx.x * NTHREADS + t; i < D_ * 20; i += gridDim.x * NTHREADS) { const int k = i / 20, j = i % 20; ((float*)(ws + OFF_BW))[i] = p.norm_ffn_g[k] * (j < 16 ? p.w_router[(size_t)k * 16 + j] : p.w_group[(size_t)k * 4 + (j - 16)]); }
    for (int i = blockIdx.x * NTHREADS + t; i < 2 * 64 * 256 / 8; i += gridDim.x * NTHREADS) { const int kv = i / (64 * 256 / 8), rr = i % (64 * 256 / 8); *(u32x4*)((bf16*)(ws + OFF_W2T) + (size_t)kv * 128 * 256 + 64 * 256 + rr * 8) = (u32x4){0u, 0u, 0u, 0u}; }
    if (blockIdx.x == 8 && t < 2) {
        const float* gq = t ? p.nsa_q_g : p.fox_q_g; const float* gk = t ? p.nsa_k_g : p.fox_k_g; float a = 0.f, bq = 0.f;
        for (int i = 0; i < 64; ++i) { a = fmaxf(a, fabsf(gq[i])); bq = fmaxf(bq, fabsf(gk[i])); }
        ((float*)(ws + OFF_CTL))[CTL_QKB + t] = 64.0f * a * bq * QSCALE * 1.01f; }
    bf16* H = (bf16*)((unsigned char*)p.out + DO_H);
    {
        constexpr int NV = D_ / 256; const int rstep = gridDim.x * NW; int row = blockIdx.x * NW + w;
        f32x4 v[NV], vn[NV];
        if (row < T_) {
#pragma unroll
            for (int i = 0; i < NV; ++i) v[i] = *(const f32x4*)(p.x + (size_t)row * D_ + 256 * i + 4 * lane); }
        for (; row < T_; row += rstep) {
            const int nrow = row + rstep;
            if (nrow < T_) {
#pragma unroll
                for (int i = 0; i < NV; ++i) vn[i] = *(const f32x4*)(p.x + (size_t)nrow * D_ + 256 * i + 4 * lane); }
            float ss = 0.f;
#pragma unroll
            for (int i = 0; i < NV; ++i) ss += (v[i][0] * v[i][0] + v[i][1] * v[i][1]) + (v[i][2] * v[i][2] + v[i][3] * v[i][3]);
#pragma unroll
            for (int o = 1; o < 64; o <<= 1) ss += __shfl_xor(ss, o);
            const float rs = 1.0f / sqrtf(ss / D_ + RMS_EPS);
#pragma unroll
            for (int i = 0; i < NV; ++i) { const f32x4 gv = *(const f32x4*)(p.norm_mix_g + 256 * i + 4 * lane); const f32x4 tv = v[i] * gv * rs;
                *(u32x2*)(H + (size_t)row * D_ + 256 * i + 4 * lane) = (u32x2){pk_bf16(tv[0], tv[1]), pk_bf16(tv[2], tv[3])}; }
#pragma unroll
            for (int i = 0; i < NV; ++i) v[i] = vn[i];
        }
    }
}
constexpr int PRE_NTILE = 2 * 2 * B_ * 2 * (NCMPP / BM) * 2, PRE_NSEQ = B_ * 8, PRE_NBIAS = 2 * 4 * 8;
DEV void pre_item(const Params& p, unsigned char* smem, int it) {
    unsigned char* ws = p.ws; asm volatile("" : "+v"(ws)); int t = threadIdx.x; asm volatile("" : "+v"(t)); const int lane = t & 63, w = t >> 6, wn = w / (NW / 2), wm = w % (NW / 2), q = lane >> 4, c = lane & 15;
    constexpr int MT = NCMPP / BM, NTILE = PRE_NTILE, NSEQ = PRE_NSEQ;
    {
        if (it >= NTILE + NSEQ) {
            const int r = it - NTILE - NSEQ, ks = r & 7, jg = (r >> 3) & 3, kv = r >> 5, jq = t >> 6; constexpr int KS = 256 / NW;
            const float* w1 = (kv ? p.cmp_v_w1 : p.cmp_k_w1) + jg * 64 + lane; const float* pos = kv ? p.cmp_v_pos : p.cmp_k_pos;
            float sacc = 0.f;
#pragma unroll 16
            for (int k = ks * 256 + jq * KS; k < ks * 256 + (jq + 1) * KS; ++k) sacc += pos[k] * w1[(size_t)k * 256];
            float* red = (float*)smem; red[t] = sacc; __syncthreads();
            if (t < 64) { float tot = 0.f; for (int k2 = 0; k2 < NW; ++k2) tot += red[64 * k2 + t]; ((float*)(ws + OFF_BIAS1P))[(ks * 2 + kv) * 256 + jg * 64 + t] = tot; }
            __syncthreads();
            return;
        }
        if (it < NTILE) {
            const int kh = it & 1, nt = (it >> 1) & 1; int r = it >> 2; const int mt = r % MT; r /= MT; const int bg = r % (B_ * 2), kv = r / (B_ * 2);
            const bf16* Wb = (const bf16*)(ws + OFF_W1T) + (size_t)kv * 256 * 2048 + kh * 1024;
            GemmSrc g{(const bf16*)(ws + (kv ? OFF_VCR : OFF_KCR)) + (size_t)bg * S_ * 64 + kh * 1024, 1024, nullptr, Wb, Wb, 1 << 30, 2048, 1024};
            f32x4 acc[4][4]; zero_acc(acc);
            gemm_mainloop(acc, g, mt * BM, nt * 128, smem);
            const int n0w = nt * 128 + 64 * wn, m0w = mt * BM + 64 * wm;
            float* dst = (float*)(ws + OFF_CPART) + (((size_t)(kh * 2 + kv) * B_ * 2 + bg) * NCMPP + m0w + c) * 256 + n0w + 4 * q;
#pragma unroll
            for (int nf = 0; nf < 4; ++nf)
#pragma unroll
                for (int mf = 0; mf < 4; ++mf) *(f32x4*)(dst + (size_t)(16 * mf) * 256 + 16 * nf) = acc[nf][mf];
        } else {
            const int seq = it - NTILE; constexpr int PER = S_ / NTHREADS; const float* lf = (const float*)(ws + OFF_LOGF) + (size_t)seq * S_ + t * PER; float* cum = (float*)(ws + OFF_CUM) + (size_t)seq * S_ + t * PER;
            float v[PER]; float run = 0.f;
#pragma unroll
            for (int i = 0; i < PER; ++i) { run += lf[i]; v[i] = run; }
            float inc = run;
#pragma unroll
            for (int o = 1; o < 64; o <<= 1) { const float u = __shfl_up(inc, o); if (lane >= o) inc += u; }
            float* wt = (float*)smem; if (lane == 63) wt[w] = inc;
            __syncthreads();
            float base = inc - run; for (int k = 0; k < w; ++k) base += wt[k];
#pragma unroll
            for (int i = 0; i < PER; i += 2) st_dev(cum + i, (u32x2){f2u(-(v[i] + base) * LOG2E), f2u(-(v[i + 1] + base) * LOG2E)});
            __syncthreads();
        }
    }
}
constexpr int CMP2_NT = 2 * (B_ * 2 * NCMPP) / BM;
DEV void cmp2_item(const Params& p, unsigned char* smem, int it) {
    unsigned char* ws = p.ws; asm volatile("" : "+v"(ws)); int t_ = threadIdx.x; asm volatile("" : "+v"(t_)); const int lane = t_ & 63, w = t_ >> 6, wn = w / (NW / 2), wm = w % (NW / 2), q = lane >> 4, c = lane & 15;
    constexpr int MT = (B_ * 2 * NCMPP) / BM;
    {
        const int kv = it / MT, mt = it % MT; const bf16* Wb = (const bf16*)(ws + OFF_W2T) + (size_t)kv * 128 * 256;
        {
            const float* p0 = (const float*)(ws + OFF_CPART) + ((size_t)(0 * 2 + kv) * B_ * 2 * NCMPP + (size_t)mt * BM) * 256; const float* p1 = p0 + (size_t)2 * B_ * 2 * NCMPP * 256;
            bf16* hd = (bf16*)(ws + OFF_CHID) + ((size_t)kv * B_ * 2 * NCMPP + (size_t)mt * BM) * 256; f32x4 bv = {0.f, 0.f, 0.f, 0.f}; static_assert((4 * NTHREADS) % 256 == 0, "a thread keeps its 4 columns");
            for (int ks = 0; ks < 8; ++ks) bv = bv + *(const f32x4*)((const float*)(ws + OFF_BIAS1P) + (ks * 2 + kv) * 256 + (4 * threadIdx.x) % 256);
            for (int i = threadIdx.x; i < BM * 256 / 4; i += NTHREADS) { f32x4 v = *(const f32x4*)(p0 + 4 * (size_t)i) + *(const f32x4*)(p1 + 4 * (size_t)i) + bv;
#pragma unroll
                for (int r2 = 0; r2 < 4; ++r2) { const float u = v[r2]; v[r2] = u * sigmoidf_(1.5957691216057308f * (u + 0.044715f * u * u * u)); }
                *(u32x2*)(hd + 4 * (size_t)i) = (u32x2){pk_bf16(v[0], v[1]), pk_bf16(v[2], v[3])}; }
            asm volatile("s_waitcnt vmcnt(0)" ::: "memory"); __syncthreads();
        }
        GemmSrc g{(const bf16*)(ws + OFF_CHID) + (size_t)kv * B_ * 2 * NCMPP * 256, 256, nullptr, Wb, Wb, 1 << 30, 256, 256};
        f32x4 acc[4][4]; zero_acc(acc);
        gemm_mainloop(acc, g, mt * BM, 0, smem);
        if (wn == 0) {
            f32x4 g4[4];
#pragma unroll
            for (int nf = 0; nf < 4; ++nf) g4[nf] = kv == 0 ? *(const f32x4*)(p.nsa_k_g + 16 * nf + 4 * q) : (f32x4){1.f, 1.f, 1.f, 1.f};
#pragma unroll
            for (int mf = 0; mf < 4; ++mf) { const int row = mt * BM + 64 * wm + 16 * mf + c; float rs = 1.f;
                if (kv == 0) { float ss = 0.f;
#pragma unroll
                    for (int nf = 0; nf < 4; ++nf) { const f32x4 v = acc[nf][mf]; ss += (v[0] * v[0] + v[1] * v[1]) + (v[2] * v[2] + v[3] * v[3]); }
                    rs = 1.0f / sqrtf(rsum16(ss) * (1.0f / 64) + RMS_EPS); }
                if ((row % NCMPP) >= NCMP) rs = 0.f;
                bf16* drow = (bf16*)(ws + (kv ? OFF_VCMP : OFF_KCMP)) + (size_t)row * 64 + 4 * q;
#pragma unroll
                for (int nf = 0; nf < 4; ++nf) { const f32x4 v = acc[nf][mf] * rs * g4[nf]; st_dev(drow + 16 * nf, (u32x2){pk_bf16(v[0], v[1]), pk_bf16(v[2], v[3])}); } }
        }
    }
}
constexpr int CTL_UPQ = 4608, CTL_ROWDONE = 11264, CTL_UPDONE = 13312, CTL_OUTDONE = 5120, RDST = 16, NCPI = (NJOB2 + NW - 1) / NW;
DEV void bphase_attn(const Params& p, unsigned char* smem) {
    constexpr int NBH = B_ * 8, QQ = FX_QQ, NU = NBH * QQ * (4 + 3 + 2 + 1), NQB = S_ / (8 * NW), NITEM = B_ * 2 * NQB, NMERGE = B_ * 8 * (FX_NQB - FX_QQ), NH1 = NITEM / 2;
    static_assert(NSQ * 4 == BM && B_ == 2 && (S_ / BM) * B_ == 128, "row-block bookkeeping");
    unsigned* ctl = (unsigned*)(p.ws + OFF_CTL); unsigned* head = ctl + CTL_FOXQ; int* slot = (int*)(smem + LDS_BYTES - 16);
    constexpr int NJ1I = (NJOB1 + NW - 1) / NW;
    constexpr int S1 = PRE_NSEQ, S2 = S1 + PRE_NTILE, S3 = S2 + PRE_NBIAS, S4 = S3 + NJ1I, S5 = S4, NF1 = 512, S6 = S5 + NU + CMP2_NT, S7 = S6, S8 = S7 + NH1, S9 = S8 + NMERGE, S10 = S9 + NCPI, SEND = S10 + (NITEM - NH1);
    int stage = 0; bool pre_ok = false;
    for (;;) {
        if (threadIdx.x == 0) slot[0] = (int)atomicAdd(head, 1u);
        __syncthreads();
        const int idx = slot[0];
        __syncthreads();
        if (idx >= S5 && stage == 0) { dep_post(ctl + CTL_DEP + 256, true); dep_wait(ctl + CTL_DEP + 192, PRE_NSEQ, ctl + CTL_BAR, true); stage = 1; }
        if (idx >= S7 && stage == 1) { dep_post(ctl + CTL_DEP + 64, false); dep_wait(ctl + CTL_DEP, CMP2_NT, ctl + CTL_BAR, true); stage = 2; }
        if (idx >= SEND) break;
        if (idx < S1) { pre_item(p, smem, PRE_NTILE + idx); dep_post(ctl + CTL_DEP + 192, false); }
        else if (idx < S2) pre_item(p, smem, idx - S1);
        else if (idx < S3) pre_item(p, smem, PRE_NTILE + PRE_NSEQ + (idx - S2));
        else if (idx < S4) { const int jj = (idx - S3) * NW + (int)(threadIdx.x >> 6); if (jj < NJOB1) prep_job(p, 1, __builtin_amdgcn_readfirstlane(jj)); }
        else if (idx >= S5 + NF1 && idx < S5 + NF1 + CMP2_NT) {
            if (!pre_ok) { dep_wait(ctl + CTL_DEP + 256, gridDim.x, ctl + CTL_BAR, true); pre_ok = true; }
            cmp2_item(p, smem, idx - S5 - NF1); dep_post(ctl + CTL_DEP, false);
        } else if (idx < S6) {
            int u = idx - S5 - (idx >= S5 + NF1 ? CMP2_NT : 0), grp = 0; while (u >= NBH * QQ * (4 - grp)) { u -= NBH * QQ * (4 - grp); ++grp; }
            const int nc = 4 - grp, per = NBH * nc, qb = (3 - grp) * QQ + QQ - 1 - u / per, rr = u % per, c = rr / NBH, j = rr % NBH, h = 7 - j / B_, b = j % B_;
            fox_unit(p, smem, b * 8 + h, qb, c);
        } else if (idx >= S8 && idx < S9) {
            if (stage == 2) { dep_wait(ctl + CTL_DEP + 64, gridDim.x, ctl + CTL_BAR, true); stage = 3; }
            const int im = idx - S8;
            fox_merge(p, im % (B_ * 8), FX_QQ + im / (B_ * 8));
            dep_post(ctl + CTL_DEP + 128, false);
        } else if (idx >= S9 && idx < S10) {
            const int jj = (idx - S9) * NW + (int)(threadIdx.x >> 6); if (jj < NJOB2) prep_job(p, 2, __builtin_amdgcn_readfirstlane(jj));
        } else {
            const int it = idx < S8 ? idx - S7 : idx - S10 + NH1, bg = it % (B_ * 2), qb = NQB - 1 - it / (B_ * 2);
            nsa_item(p, smem, bg, qb);
            dep_post(ctl + CTL_ROWDONE + RDST * ((bg / 2) * (S_ / BM) + qb / 4), false);
        }
    }
    const unsigned x = xb_xcc_id() & 7u; bool first = true, first2 = true;
    for (unsigned s8 = 0; s8 < 8; ++s8) {
        const unsigned xq = (x + s8) & 7u; unsigned* qh = ctl + CTL_UPQ + 64 * xq;
        for (;;) {
            if (threadIdx.x == 0) slot[0] = (int)atomicAdd(qh, 1u);
            __syncthreads();
            const int n = slot[0];
            __syncthreads();
            if (n >= 256) break;
            const int j = ((n & 127) >> 3) * 8 + (int)xq, R = (j & 1) * (S_ / BM) + (S_ / BM - 1 - (j >> 1));
            if (n < 128) {
                if (first) { dep_wait(ctl + CTL_DEP + 256, gridDim.x, ctl + CTL_BAR, false); dep_wait(ctl + CTL_DEP + 64, gridDim.x, ctl + CTL_BAR, false); dep_wait(ctl + CTL_DEP + 128, NMERGE, ctl + CTL_BAR, false); }
                dep_wait(ctl + CTL_ROWDONE + RDST * R, 8, ctl + CTL_BAR, first); first = false;
                up_tile(p, smem, R, n & 7);
                dep_post(ctl + CTL_UPDONE + RDST * R, false);
            } else {
                if (R < S_ / BM) dep_wait(ctl + CTL_UPDONE + RDST * (R + S_ / BM), 8, ctl + CTL_BAR, false);
                dep_wait(ctl + CTL_UPDONE + RDST * R, 8, ctl + CTL_BAR, first2); first2 = false;
                out_tile(p, smem, R, n & 7);
                if (dep_post_last(ctl + CTL_OUTDONE + RDST * R, 8u, slot)) route_item(p, smem, R);
            }
        }
    }
}

#endif

#ifndef CPU_EMU
__global__ void __launch_bounds__(NTHREADS, 2) fwd_megakernel(Params p) {
    __shared__ __attribute__((aligned(16))) unsigned char smem[LDS_BYTES];
    cg::grid_group grid = cg::this_grid();
    volatile unsigned* bst = (volatile unsigned*)(smem + LDS_BYTES - 32);
    if (threadIdx.x < 2) bst[threadIdx.x] = 0u;
    __syncthreads();
    XcdBarrier bar = xcd_barrier_post((unsigned*)(p.ws + OFF_CTL) + CTL_BAR, bst);
    bphase_prep(p, smem, 0, 0);      xcd_barrier(bar);
    if (p.ws == nullptr) grid.sync();
    bphase_inproj(p, smem);          xcd_barrier(bar);
    bphase_attn(p, smem);            xcd_barrier(bar);
    bphase_moe_up(p, smem);
    bphase_moe_down(p, smem);
}

extern "C" void kernel_launch(void* const* d_in, const int* in_sizes, int n_in, void* d_out, int out_size, void* d_ws, size_t ws_size, hipStream_t stream) {
    static int grid_blocks = 0;
    if (!grid_blocks) {
        if (n_in != 25 || out_size != T_ * D_ || ws_size < WS_END) { fprintf(stderr, "kernel_launch: unexpected shapes (n_in %d out %d ws %zu need %zu)\n", n_in, out_size, ws_size, (size_t)WS_END); grid_blocks = -1; return; }
        int dev = 0, cus = 0, per_cu = 0;
        hipGetDevice(&dev); hipDeviceGetAttribute(&cus, hipDeviceAttributeMultiprocessorCount, dev);
        hipOccupancyMaxActiveBlocksPerMultiprocessor(&per_cu, fwd_megakernel, NTHREADS, 0);
        if (per_cu < 1) { fprintf(stderr, "kernel_launch: occupancy query says %d blocks per CU\n", per_cu); grid_blocks = -1; return; }
        if (per_cu > 2) per_cu = 2;
        if (NW >= 8) per_cu = 1;
        grid_blocks = cus * per_cu;
    }
    if (grid_blocks < 0) return;
    Params p{};
    const float** f = (const float**)&p;
    for (int i = 0; i < 25; ++i) f[i] = (const float*)d_in[i];
    p.out = (float*)d_out; p.ws = (unsigned char*)d_ws;
    void* args[] = {&p};
    if (hipMemsetAsync((char*)d_ws + OFF_CTL, 0, 65536, stream) != hipSuccess) { fprintf(stderr, "kernel_launch: memset of the control words failed\n"); return; }
    hipError_t e = hipLaunchCooperativeKernel((void*)fwd_megakernel, dim3(grid_blocks), dim3(NTHREADS), args, 0, stream);
    if (e != hipSuccess) fprintf(stderr, "cooperative launch failed: %s (grid %d)\n", hipGetErrorString(e), grid_blocks);
}
#endif
```

```cpp
#ifndef CPU_EMU
#include <hip/hip_runtime.h>
#include <hip/hip_cooperative_groups.h>
#include <cstdio>
#include <cstdint>
namespace cg = cooperative_groups;
#define DEV __device__ __forceinline__
#else
#include <cstdio>
#include <cstdint>
#include <cstring>
#include <cmath>
#define DEV inline
struct uint4 { unsigned x, y, z, w; };
static inline float exp2f_(float x) { return exp2f(x); }
#endif

#ifndef CFG_NW
#define CFG_NW 4
#endif
#define CFG_NW_FOR_WS CFG_NW
#ifndef CFG_B
#define CFG_B 2
#define CFG_S 8192
#define CFG_D 1024
#define CFG_DE 512
#endif

constexpr int B_ = CFG_B, S_ = CFG_S, D_ = CFG_D, DE_ = CFG_DE, T_ = B_ * S_;
constexpr int HD = 64, FH = 8, NH = 8, NKV = 2, NR = 4;
constexpr int NCMP = (S_ - 32) / 16 + 1, NCMPP = ((NCMP + 31) / 32) * 32, NSLC = S_ / 64, TOPN = NSLC < 16 ? NSLC : 16;
constexpr int NE = 16;
constexpr float RMS_EPS = 1e-6f;
constexpr float LOG2E = 1.4426950408889634f;
constexpr float QSCALE = 0.125f * LOG2E;
constexpr int C_FQ = 0, C_FK = 512, C_FV = 1024, C_NQ = 1536, C_KC = 2048, C_VC = 2176, C_KS = 2304, C_VS = 2432, C_KW = 2560, C_VW = 2688,
              C_GA = 2816, C_GB = 2816 + D_, C_FF = 2816 + 2 * D_, C_NG = C_FF + 8, C_END = C_NG + 24, NP = ((C_END + 127) / 128) * 128;
constexpr int O_FQ = 0, O_FK = 512, O_FV = 1024, O_FF = 1536, O_NQ = 1544, O_KC = 2056, O_VC = 2184, O_KS = 2312, O_VS = 2440, O_KW = 2568, O_VW = 2696,
              O_NG = 2824, O_GA = 2848, O_GB = 2848 + D_, D_IN = 2848 + 2 * D_;

typedef unsigned short bf16;

constexpr size_t al256(size_t x) { return (x + 255) & ~(size_t)255; }
constexpr size_t OFF_CTL = 0, SZ_CTL = 1 << 20;
constexpr size_t OFF_WINT = OFF_CTL + SZ_CTL;
constexpr size_t OFF_WAT = OFF_WINT + al256((size_t)NP * D_ * 2);
constexpr size_t OFF_WBT = OFF_WAT + al256((size_t)D_ * 512 * 2);
constexpr size_t OFF_WOT = OFF_WBT + al256((size_t)D_ * 512 * 2);
constexpr size_t OFF_W1T = OFF_WOT + al256((size_t)D_ * D_ * 2);
constexpr size_t OFF_W2T = OFF_W1T + al256((size_t)2 * 256 * 2048 * 2);
constexpr size_t OFF_BIAS1 = OFF_W2T + al256((size_t)2 * 128 * 256 * 2);
constexpr size_t OFF_WGT = OFF_BIAS1 + al256((size_t)2 * 256 * 4);
constexpr size_t OFF_WUT = OFF_WGT + al256((size_t)NE * DE_ * D_ * 2);
constexpr size_t OFF_WDT = OFF_WUT + al256((size_t)NE * DE_ * D_ * 2);
constexpr size_t SZ_HEADS = al256((size_t)B_ * 8 * S_ * 64 * 2), SZ_KV = al256((size_t)B_ * 2 * S_ * 64 * 2);
constexpr size_t OFF_FQ = OFF_WDT + al256((size_t)NE * D_ * DE_ * 2);
constexpr size_t OFF_FK = OFF_FQ + SZ_HEADS, OFF_FV = OFF_FK + SZ_HEADS, OFF_NQ = OFF_FV + SZ_HEADS;
constexpr size_t OFF_KCR = OFF_NQ + SZ_HEADS, OFF_VCR = OFF_KCR + SZ_KV, OFF_KS = OFF_VCR + SZ_KV, OFF_VS = OFF_KS + SZ_KV, OFF_KW = OFF_VS + SZ_KV, OFF_VW = OFF_KW + SZ_KV;
constexpr size_t OFF_GA = OFF_VW + SZ_KV, OFF_GB = OFF_GA + al256((size_t)T_ * D_ * 2);
constexpr size_t OFF_LOGF = OFF_GB + al256((size_t)T_ * D_ * 2);
constexpr size_t OFF_CUM = OFF_LOGF + al256((size_t)B_ * 8 * S_ * 4);
constexpr size_t OFF_GATE = OFF_CUM + al256((size_t)B_ * 8 * S_ * 4);
constexpr size_t OFF_KCMP = OFF_GATE + al256((size_t)T_ * 24 * 4);
constexpr size_t OFF_VCMP = OFF_KCMP + al256((size_t)B_ * 2 * NCMPP * 64 * 2);
constexpr size_t OFF_CHID = OFF_VCMP + al256((size_t)B_ * 2 * NCMPP * 64 * 2);
#ifdef CPU_EMU
constexpr size_t OFF_IMP = OFF_CHID + al256((size_t)2 * B_ * 2 * NCMPP * 256 * 2);
constexpr size_t OFF_SEL = OFF_IMP + al256((size_t)B_ * 2 * S_ * NSLC * 4);
constexpr size_t OFF_ROUTE = OFF_SEL + al256((size_t)B_ * 2 * S_ * 16 * 4);
#else
constexpr size_t OFF_ROUTE = OFF_CHID + al256((size_t)2 * B_ * 2 * NCMPP * 256 * 2);
#endif
constexpr int NCLS = 24, MOE_BM = 32 * CFG_NW_FOR_WS, NSLOT = T_ + NCLS * MOE_BM;
constexpr size_t OFF_STOK = OFF_ROUTE + al256((size_t)T_ * 16);
constexpr size_t OFF_SW = OFF_STOK + al256((size_t)NCLS * T_ * 4);
constexpr int FX_ROWS = 32 * CFG_NW, FX_CH = 32, FX_NQB = S_ / FX_ROWS, FX_QQ = FX_NQB / 4, FX_PART_PER_BH = 9 * FX_QQ, FX_PART_BYTES = FX_ROWS * 64 * 2 + FX_ROWS * 8;
constexpr size_t FX_NPART = (size_t)B_ * 8 * FX_PART_PER_BH;
constexpr size_t FX_P1 = ((size_t)T_ * D_ * 4 - (size_t)T_ * 1024 * 2) / FX_PART_BYTES;
constexpr size_t OFF_FXINFO = OFF_SW + al256((size_t)NCLS * T_ * 8);
constexpr size_t OFF_FXPART = OFF_FXINFO + al256((size_t)B_ * 8 * FX_NQB * 4);
constexpr size_t OFF_SSP = OFF_FXPART + al256((FX_NPART > FX_P1 ? FX_NPART - FX_P1 : 0) * FX_PART_BYTES);
constexpr size_t OFF_CPART = OFF_SSP + al256((size_t)T_ * 16 * 4);
constexpr size_t OFF_BIAS1P = OFF_CPART + al256((size_t)2 * 2 * B_ * 2 * NCMPP * 256 * 4);
constexpr size_t WS_END = OFF_BIAS1P + al256((size_t)8 * 2 * 256 * 4);
static_assert(D_ / 64 <= 16, "one partial per 64-column slice");
static_assert(S_ != 8192 || (FX_NQB % 4 == 0 && FX_QQ * (FX_ROWS / 64) == FX_CH), "a quarter of the query blocks must span exactly FX_CH key tiles");
constexpr int CTL_BAR = 1024;
constexpr int CTL_HIDDONE = 7168, CTL_MDQ = 15360;
constexpr int CTL_CNT = 8192, CTL_CUR = 8192 + 24 * 64, CTL_FOXQ = 192, CTL_QKB = 256, CST = 64;
constexpr size_t OFF_MIX = OFF_FQ;
constexpr size_t OFF_TN = OFF_GA;
constexpr size_t OFF_PL = OFF_FV;
constexpr size_t OFF_HID = OFF_FQ;
constexpr size_t OFF_RS = OFF_CTL + (128 << 10), OFF_BW = OFF_CTL + (256 << 10);
static_assert((size_t)NSLOT * 2 * DE_ * 2 <= 3 * SZ_HEADS && (size_t)8 * T_ * 20 * 4 <= SZ_HEADS && OFF_BW + (size_t)D_ * 20 * 4 <= SZ_CTL, "overlays");
constexpr size_t DO_H = 0, DO_OA = 0, DO_OB = (size_t)T_ * 512 * 2, DO_OBF = (size_t)T_ * 1024 * 2;

struct Params {
    const float *x, *norm_mix_g, *w_in, *b_forget, *fox_q_g, *fox_k_g, *nsa_q_g, *nsa_k_g, *cmp_k_w1, *cmp_k_w2, *cmp_k_pos, *cmp_v_w1, *cmp_v_w2, *cmp_v_pos,
        *w_fox_up, *w_nsa_up, *w_out, *norm_ffn_g, *w_group, *b_group, *w_router, *b_router, *w_gate, *w_up, *w_down;
    float* out; unsigned char* ws;
};

#ifndef CPU_EMU
DEV float u2f(unsigned u) { return __uint_as_float(u); }
DEV unsigned f2u(float f) { return __float_as_uint(f); }
#else
DEV float u2f(unsigned u) { float f; memcpy(&f, &u, 4); return f; }
DEV unsigned f2u(float f) { unsigned u; memcpy(&u, &f, 4); return u; }
#endif
DEV float bf2f(bf16 v) { return u2f((unsigned)v << 16); }
DEV bf16 f2bf(float f) { unsigned u = f2u(f); return (bf16)((u + 0x7fffu + ((u >> 16) & 1u)) >> 16); }
#ifndef CPU_EMU
DEV float sigmoidf_(float v) { return __builtin_amdgcn_rcpf(1.0f + __builtin_amdgcn_exp2f(-1.4426950408889634f * v)); }
#else
DEV float sigmoidf_(float v) { return 1.0f / (1.0f + expf(-v)); }
#endif
DEV float alibi_slope2(int h) { return exp2f(-(float)(h + 1)) * LOG2E; }
DEV int orig_col(int c) {
    if (c < C_FF) { if (c < C_NQ) return c; if (c < C_GA) return c - C_NQ + O_NQ; return c - C_GA + O_GA; }
    if (c < C_NG) return c - C_FF + O_FF;
    if (c < C_END) return c - C_NG + O_NG;
    return -1;
}
DEV void unpack8(const uint4& v, float* f) {
    f[0] = u2f(v.x << 16); f[1] = u2f(v.x & 0xffff0000u); f[2] = u2f(v.y << 16); f[3] = u2f(v.y & 0xffff0000u);
    f[4] = u2f(v.z << 16); f[5] = u2f(v.z & 0xffff0000u); f[6] = u2f(v.w << 16); f[7] = u2f(v.w & 0xffff0000u);
}
DEV void dot64(const bf16* a, const bf16* bt, size_t ldb, int K, float (&acc)[64]) {
    for (int k0 = 0; k0 < K; k0 += 8) {
        float af[8]; unpack8(*(const uint4*)(a + k0), af);
#pragma unroll
        for (int j = 0; j < 64; ++j) {
            float bfv[8]; unpack8(*(const uint4*)(bt + (size_t)j * ldb + k0), bfv);
            acc[j] += ((af[0] * bfv[0] + af[1] * bfv[1]) + (af[2] * bfv[2] + af[3] * bfv[3])) + ((af[4] * bfv[4] + af[5] * bfv[5]) + (af[6] * bfv[6] + af[7] * bfv[7]));
        }
    }
}
DEV void load64(const bf16* p, float (&q)[64]) {
#pragma unroll
    for (int c = 0; c < 8; ++c) { float f[8]; unpack8(*(const uint4*)(p + 8 * c), f);
#pragma unroll
        for (int i = 0; i < 8; ++i) q[8 * c + i] = f[i]; }
}
DEV float dotq(const float (&q)[64], const bf16* k) {
    float s = 0.f;
#pragma unroll
    for (int c = 0; c < 8; ++c) { float f[8]; unpack8(*(const uint4*)(k + 8 * c), f);
#pragma unroll
        for (int i = 0; i < 8; ++i) s += q[8 * c + i] * f[i]; }
    return s;
}
DEV void axpy64(float (&o)[64], float p, const bf16* v) {
#pragma unroll
    for (int c = 0; c < 8; ++c) { float f[8]; unpack8(*(const uint4*)(v + 8 * c), f);
#pragma unroll
        for (int i = 0; i < 8; ++i) o[8 * c + i] += p * f[i]; }
}
DEV void store64_bf16(bf16* p, const float (&v)[64]) {
#pragma unroll
    for (int c = 0; c < 8; ++c) { uint4 o;
        o.x = (unsigned)f2bf(v[8 * c + 0]) | ((unsigned)f2bf(v[8 * c + 1]) << 16); o.y = (unsigned)f2bf(v[8 * c + 2]) | ((unsigned)f2bf(v[8 * c + 3]) << 16);
        o.z = (unsigned)f2bf(v[8 * c + 4]) | ((unsigned)f2bf(v[8 * c + 5]) << 16); o.w = (unsigned)f2bf(v[8 * c + 6]) | ((unsigned)f2bf(v[8 * c + 7]) << 16);
        *(uint4*)(p + 8 * c) = o; }
}
DEV void osm_step(float s, const bf16* vrow, float& m, float& l, float (&o)[64]) {
    if (s > m) { const float a = exp2f(m - s);
#pragma unroll
        for (int i = 0; i < 64; ++i) o[i] *= a;
        l *= a; m = s; }
    const float p = exp2f(s - m); l += p; axpy64(o, p, vrow);
}

DEV void transpose_item(const float* src, int K, int N, bf16* dst, size_t i) { const int n = (int)(i / K), k = (int)(i % K); dst[i] = f2bf(src[(size_t)k * N + n]); }
DEV void phase_prep(const Params& p, long gt, long nth) {
    unsigned char* ws = p.ws;
    { bf16* d = (bf16*)(ws + OFF_WINT); for (size_t i = gt; i < (size_t)NP * D_; i += nth) { const int c = (int)(i / D_), k = (int)(i % D_), oc = orig_col(c); d[i] = oc < 0 ? (bf16)0 : f2bf(p.w_in[(size_t)k * D_IN + oc]); } }
    { bf16* d = (bf16*)(ws + OFF_WAT); for (size_t i = gt; i < (size_t)D_ * 512; i += nth) transpose_item(p.w_fox_up, 512, D_, d, i); }
    { bf16* d = (bf16*)(ws + OFF_WBT); for (size_t i = gt; i < (size_t)D_ * 512; i += nth) transpose_item(p.w_nsa_up, 512, D_, d, i); }
    { bf16* d = (bf16*)(ws + OFF_WOT); for (size_t i = gt; i < (size_t)D_ * D_; i += nth) transpose_item(p.w_out, D_, D_, d, i); }
    for (int kv = 0; kv < 2; ++kv) {
        const float* w1 = kv ? p.cmp_v_w1 : p.cmp_k_w1; const float* w2 = kv ? p.cmp_v_w2 : p.cmp_k_w2; const float* pos = kv ? p.cmp_v_pos : p.cmp_k_pos;
        bf16* d1 = (bf16*)(ws + OFF_W1T) + (size_t)kv * 256 * 2048; bf16* d2 = (bf16*)(ws + OFF_W2T) + (size_t)kv * 64 * 256; float* b1 = (float*)(ws + OFF_BIAS1) + kv * 256;
        for (size_t i = gt; i < (size_t)256 * 2048; i += nth) transpose_item(w1, 2048, 256, d1, i);
        for (size_t i = gt; i < (size_t)64 * 256; i += nth) transpose_item(w2, 256, 64, d2, i);
        for (size_t j = gt; j < 256; j += nth) { float s = 0.f; for (int k = 0; k < 2048; ++k) s += pos[k] * w1[(size_t)k * 256 + j]; b1[j] = s; }
    }
#ifdef CPU_EMU
    for (int e = 0; e < NE; ++e) {
        bf16* dg = (bf16*)(ws + OFF_WGT) + (size_t)e * DE_ * D_; bf16* du = (bf16*)(ws + OFF_WUT) + (size_t)e * DE_ * D_; bf16* dd = (bf16*)(ws + OFF_WDT) + (size_t)e * D_ * DE_;
        for (size_t i = gt; i < (size_t)DE_ * D_; i += nth) { transpose_item(p.w_gate + (size_t)e * D_ * DE_, D_, DE_, dg, i); transpose_item(p.w_up + (size_t)e * D_ * DE_, D_, DE_, du, i); }
        for (size_t i = gt; i < (size_t)D_ * DE_; i += nth) transpose_item(p.w_down + (size_t)e * DE_ * D_, DE_, D_, dd, i);
    }
#else
    {
        bf16* d = (bf16*)(ws + OFF_WGT);
        for (size_t i = gt; i < (size_t)NE * 2 * DE_ * D_; i += nth) { const int k = (int)(i % D_); const size_t r = i / D_; const int row = (int)(r % (2 * DE_)), e = (int)(r / (2 * DE_));
            const int j = (row / 64) * 32 + (row % 32); const float* src = ((row % 64) < 32 ? p.w_gate : p.w_up) + (size_t)e * D_ * DE_; d[i] = f2bf(src[(size_t)k * DE_ + j]); }
        for (int e = 0; e < NE; ++e) { bf16* dd = (bf16*)(ws + OFF_WDT) + (size_t)e * D_ * DE_; for (size_t i = gt; i < (size_t)D_ * DE_; i += nth) transpose_item(p.w_down + (size_t)e * DE_ * D_, DE_, D_, dd, i); }
        int* st = (int*)(ws + OFF_STOK); for (size_t i = gt; i < (size_t)NSLOT; i += nth) st[i] = -1;
    }
#endif
    bf16* H = (bf16*)((unsigned char*)p.out + DO_H);
    for (size_t r = gt; r < (size_t)T_; r += nth) {
        const float* xr = p.x + r * D_; float ss = 0.f; for (int k = 0; k < D_; ++k) ss += xr[k] * xr[k];
        const float rs = 1.0f / sqrtf(ss / D_ + RMS_EPS);
        for (int k = 0; k < D_; ++k) H[r * D_ + k] = f2bf(xr[k] * rs * p.norm_mix_g[k]);
    }
}
DEV void phase_inproj(const Params& p, long gt, long nth) {
    unsigned char* ws = p.ws; const bf16* H = (const bf16*)((unsigned char*)p.out + DO_H); const bf16* WT = (const bf16*)(ws + OFF_WINT);
    constexpr int NGRP = NP / 64;
    for (size_t it = gt; it < (size_t)T_ * NGRP; it += nth) {
        const int grp = (int)(it % NGRP); const size_t row = it / NGRP; const int b = (int)(row / S_), s = (int)(row % S_); const int c0 = grp * 64;
        if (c0 >= C_END) continue;
        float acc[64];
#pragma unroll
        for (int j = 0; j < 64; ++j) acc[j] = 0.f;
        dot64(H + row * D_, WT + (size_t)c0 * D_, D_, D_, acc);
        if (c0 < C_KC) {
            const int which = c0 / 512, h = (c0 % 512) / 64;
            bf16* dst = (bf16*)(ws + (which == 0 ? OFF_FQ : which == 1 ? OFF_FK : which == 2 ? OFF_FV : OFF_NQ)) + (((size_t)b * 8 + h) * S_ + s) * 64;
            if (which != 2) {
                const float* g = which == 0 ? p.fox_q_g : which == 1 ? p.fox_k_g : p.nsa_q_g; float ss = 0.f;
#pragma unroll
                for (int j = 0; j < 64; ++j) ss += acc[j] * acc[j];
                const float rs = 1.0f / sqrtf(ss * (1.0f / 64) + RMS_EPS) * (which == 1 ? 1.0f : QSCALE);
#pragma unroll
                for (int j = 0; j < 64; ++j) acc[j] = acc[j] * rs * g[j];
            }
            store64_bf16(dst, acc);
        } else if (c0 < C_GA) {
            const int which = (c0 - C_KC) / 128, g2 = ((c0 - C_KC) % 128) / 64;
            bf16* dst = (bf16*)(ws + OFF_KCR + (size_t)which * SZ_KV) + (((size_t)b * 2 + g2) * S_ + s) * 64;
            if (which == 2 || which == 4) { float ss = 0.f;
#pragma unroll
                for (int j = 0; j < 64; ++j) ss += acc[j] * acc[j];
                const float rs = 1.0f / sqrtf(ss * (1.0f / 64) + RMS_EPS);
#pragma unroll
                for (int j = 0; j < 64; ++j) acc[j] = acc[j] * rs * p.nsa_k_g[j];
            }
            store64_bf16(dst, acc);
        } else if (c0 < C_FF) {
            const bool isb = c0 >= C_GB; const int cc = c0 - (isb ? C_GB : C_GA);
#pragma unroll
            for (int j = 0; j < 64; ++j) acc[j] = sigmoidf_(acc[j]);
            store64_bf16((bf16*)(ws + (isb ? OFF_GB : OFF_GA)) + row * D_ + cc, acc);
        } else {
            float* lf = (float*)(ws + OFF_LOGF); float* gt_ = (float*)(ws + OFF_GATE);
#pragma unroll
            for (int j = 0; j < 8; ++j) { const float v = acc[j] + p.b_forget[j]; lf[((size_t)b * 8 + j) * S_ + s] = fminf(v, 0.f) - log1pf(expf(-fabsf(v))); }
#pragma unroll
            for (int j = 0; j < 24; ++j) gt_[row * 24 + j] = sigmoidf_(acc[8 + j]);
        }
    }
}
DEV void phase_scan_cmp1(const Params& p, long gt, long nth) {
    unsigned char* ws = p.ws; const float* lf = (const float*)(ws + OFF_LOGF); float* cum = (float*)(ws + OFF_CUM);
    for (size_t it = gt; it < (size_t)B_ * 8; it += nth) { float c = 0.f; for (int s = 0; s < S_; ++s) { c += lf[it * S_ + s]; cum[it * S_ + s] = c * LOG2E; } }
    for (size_t it = gt; it < (size_t)2 * B_ * 2 * NCMP * 4; it += nth) {
        const int jg = (int)(it % 4); size_t r = it / 4; const int n = (int)(r % NCMP); r /= NCMP; const int bg = (int)(r % (B_ * 2)), kv = (int)(r / (B_ * 2));
        const bf16* raw = (const bf16*)(ws + (kv ? OFF_VCR : OFF_KCR)) + ((size_t)bg * S_ + 16 * n) * 64;
        const bf16* w1t = (const bf16*)(ws + OFF_W1T) + (size_t)kv * 256 * 2048 + (size_t)jg * 64 * 2048; const float* b1 = (const float*)(ws + OFF_BIAS1) + kv * 256 + jg * 64;
        float acc[64];
#pragma unroll
        for (int j = 0; j < 64; ++j) acc[j] = b1[j];
        dot64(raw, w1t, 2048, 2048, acc);
#pragma unroll
        for (int j = 0; j < 64; ++j) { const float v = acc[j]; acc[j] = 0.5f * v * (1.0f + tanhf(0.7978845608028654f * (v + 0.044715f * v * v * v))); }
        store64_bf16((bf16*)(ws + OFF_CHID) + (((size_t)kv * B_ * 2 + bg) * NCMPP + n) * 256 + jg * 64, acc);
    }
}
DEV void phase_cmp2(const Params& p, long gt, long nth) {
    unsigned char* ws = p.ws;
    for (size_t i = gt; i < (size_t)2 * B_ * 2 * (NCMPP - NCMP) * 64; i += nth) { const int d = (int)(i % 64); size_t r = i / 64; const int n = NCMP + (int)(r % (NCMPP - NCMP)); r /= (NCMPP - NCMP); const int bg = (int)(r % (B_ * 2)), kv = (int)(r / (B_ * 2));
        ((bf16*)(ws + (kv ? OFF_VCMP : OFF_KCMP)))[((size_t)bg * NCMPP + n) * 64 + d] = 0; }
    for (size_t it = gt; it < (size_t)2 * B_ * 2 * NCMP; it += nth) {
        const int n = (int)(it % NCMP); size_t r = it / NCMP; const int bg = (int)(r % (B_ * 2)), kv = (int)(r / (B_ * 2));
        const bf16* hid = (const bf16*)(ws + OFF_CHID) + (((size_t)kv * B_ * 2 + bg) * NCMPP + n) * 256; const bf16* w2t = (const bf16*)(ws + OFF_W2T) + (size_t)kv * 64 * 256;
        float acc[64];
#pragma unroll
        for (int j = 0; j < 64; ++j) acc[j] = 0.f;
        dot64(hid, w2t, 256, 256, acc);
        if (kv == 0) { float ss = 0.f;
#pragma unroll
            for (int j = 0; j < 64; ++j) ss += acc[j] * acc[j];
            const float rs = 1.0f / sqrtf(ss * (1.0f / 64) + RMS_EPS);
#pragma unroll
            for (int j = 0; j < 64; ++j) acc[j] = acc[j] * rs * p.nsa_k_g[j];
        }
        store64_bf16((bf16*)(ws + (kv ? OFF_VCMP : OFF_KCMP)) + ((size_t)bg * NCMPP + n) * 64, acc);
    }
}
DEV void phase_fox(const Params& p, long gt, long nth) {
    unsigned char* ws = p.ws; const float* cum = (const float*)(ws + OFF_CUM); bf16* OA = (bf16*)((unsigned char*)p.out + DO_OA);
    for (size_t it = gt; it < (size_t)B_ * 8 * S_; it += nth) {
        const size_t it2 = (size_t)B_ * 8 * S_ - 1 - it;
        const int t = (int)(it2 % S_); const size_t bh = it2 / S_; const int h = (int)(bh % 8), b = (int)(bh / 8);
        const bf16* K = (const bf16*)(ws + OFF_FK) + bh * S_ * 64; const bf16* V = (const bf16*)(ws + OFF_FV) + bh * S_ * 64;
        float q[64], o[64]; load64((const bf16*)(ws + OFF_FQ) + (bh * S_ + t) * 64, q);
#pragma unroll
        for (int i = 0; i < 64; ++i) o[i] = 0.f;
        float m = -INFINITY, l = 0.f; const float cq = cum[bh * S_ + t];
        for (int k = 0; k <= t; ++k) osm_step(dotq(q, K + (size_t)k * 64) + (cq - cum[bh * S_ + k]), V + (size_t)k * 64, m, l, o);
        const float il = 1.0f / l;
#pragma unroll
        for (int i = 0; i < 64; ++i) o[i] *= il;
        store64_bf16(OA + ((size_t)b * S_ + t) * 512 + h * 64, o);
    }
}
#ifdef CPU_EMU
DEV void phase_nsa_cmp(const Params& p, long gt, long nth) {
    unsigned char* ws = p.ws; float* IMP = (float*)(ws + OFF_IMP); float* OBF = (float*)((unsigned char*)p.out + DO_OBF); const float* GATE = (const float*)(ws + OFF_GATE);
    for (size_t it = gt; it < (size_t)B_ * 2 * S_; it += nth) {
        const int t = (int)(it % S_); const size_t bg = it / S_; const int g = (int)(bg % 2), b = (int)(bg / 2);
        const bf16* KC = (const bf16*)(ws + OFF_KCMP) + bg * NCMPP * 64; const bf16* VC = (const bf16*)(ws + OFF_VCMP) + bg * NCMPP * 64;
        float* imp = IMP + it * NSLC; for (int j = 0; j < NSLC; ++j) imp[j] = 0.f;
        const int nval = t >= 31 ? (t - 31) / 16 + 1 : 0;
        for (int r = 0; r < 4; ++r) {
            const int h = g * 4 + r; const float sl = alibi_slope2(h);
            float q[64], o[64]; load64((const bf16*)(ws + OFF_NQ) + (((size_t)b * 8 + h) * S_ + t) * 64, q);
#pragma unroll
            for (int i = 0; i < 64; ++i) o[i] = 0.f;
            float m = -INFINITY, l = 0.f;
            for (int n = 0; n < nval; ++n) { const float s = dotq(q, KC + (size_t)n * 64) - sl * (float)(t - (16 * n + 31)); if (s > m) { l *= exp2f(m - s); m = s; } l += exp2f(s - m); }
            const float il = nval ? 1.0f / l : 0.f;
            for (int n = 0; n < nval; ++n) {
                const float s = dotq(q, KC + (size_t)n * 64) - sl * (float)(t - (16 * n + 31)); const float pr = exp2f(s - m) * il;
                axpy64(o, pr, VC + (size_t)n * 64);
                const int j0 = n >> 2;
                if ((n & 3) == 3) { imp[j0] += 0.5f * pr; if (j0 + 1 < NSLC) imp[j0 + 1] += 0.5f * pr; } else imp[j0] += pr;
            }
            const float g0 = GATE[((size_t)b * S_ + t) * 24 + h * 3 + 0]; float* ob = OBF + ((size_t)b * S_ + t) * 512 + h * 64;
#pragma unroll
            for (int i = 0; i < 64; ++i) ob[i] = g0 * o[i];
        }
    }
}
DEV void phase_nsa_topk(const Params& p, long gt, long nth) {
    unsigned char* ws = p.ws; const float* IMP = (const float*)(ws + OFF_IMP); int* SEL = (int*)(ws + OFF_SEL);
    for (size_t it = gt; it < (size_t)B_ * 2 * S_; it += nth) {
        const int t = (int)(it % S_); const int qb = t / 64; const float* imp = IMP + it * NSLC; int* sel = SEL + it * 16;
        static_assert(NSLC <= 128, "selection mask is 128 bits");
        unsigned long long tk0 = 0ull, tk1 = 0ull;
        for (int k = 0; k < TOPN; ++k) {
            float best = -INFINITY; int bj = 0;
            for (int j = 0; j < NSLC; ++j) {
                if (((j < 64 ? tk0 : tk1) >> (j & 63)) & 1ull) continue;
                const float sc = (j * 64 > t) ? -1.0f : ((j == 0 || j == qb || j == qb - 1) ? 1e4f : imp[j]);
                if (sc > best) { best = sc; bj = j; }
            }
            if (bj < 64) tk0 |= 1ull << bj; else tk1 |= 1ull << (bj - 64);
            sel[k] = bj;
        }
        for (int k = TOPN; k < 16; ++k) sel[k] = -1;
    }
}
DEV void phase_nsa_slc_win(const Params& p, long gt, long nth) {
    unsigned char* ws = p.ws; const int* SEL = (const int*)(ws + OFF_SEL); float* OBF = (float*)((unsigned char*)p.out + DO_OBF); const float* GATE = (const float*)(ws + OFF_GATE);
    bf16* OB = (bf16*)((unsigned char*)p.out + DO_OB);
    for (size_t it = gt; it < (size_t)B_ * 8 * S_; it += nth) {
        const int t = (int)(it % S_); const size_t bh = it / S_; const int h = (int)(bh % 8), b = (int)(bh / 8), g = h / 4; const size_t bg = (size_t)b * 2 + g;
        const float sl = alibi_slope2(h);
        float q[64], o[64]; load64((const bf16*)(ws + OFF_NQ) + (bh * S_ + t) * 64, q);
        float* ob = OBF + ((size_t)b * S_ + t) * 512 + h * 64; const float g1 = GATE[((size_t)b * S_ + t) * 24 + h * 3 + 1], g2 = GATE[((size_t)b * S_ + t) * 24 + h * 3 + 2];
#pragma unroll
        for (int i = 0; i < 64; ++i) o[i] = 0.f;
        {
            const bf16* K = (const bf16*)(ws + OFF_KS) + bg * S_ * 64; const bf16* V = (const bf16*)(ws + OFF_VS) + bg * S_ * 64; const int* sel = SEL + (bg * S_ + t) * 16;
            float m = -INFINITY, l = 0.f;
            for (int k = 0; k < 16; ++k) { const int blk = sel[k]; if (blk < 0 || blk * 64 > t) continue;
                for (int i = 0; i < 64; ++i) { const int kp = blk * 64 + i; if (kp > t) break; osm_step(dotq(q, K + (size_t)kp * 64) - sl * (float)(t - kp), V + (size_t)kp * 64, m, l, o); } }
            const float il = g1 / l;
#pragma unroll
            for (int i = 0; i < 64; ++i) { ob[i] += il * o[i]; o[i] = 0.f; }
        }
        {
            const bf16* K = (const bf16*)(ws + OFF_KW) + bg * S_ * 64; const bf16* V = (const bf16*)(ws + OFF_VW) + bg * S_ * 64;
            float m = -INFINITY, l = 0.f; const int k0 = t - 511 > 0 ? t - 511 : 0;
            for (int kp = k0; kp <= t; ++kp) osm_step(dotq(q, K + (size_t)kp * 64) - sl * (float)(t - kp), V + (size_t)kp * 64, m, l, o);
            const float il = g2 / l;
#pragma unroll
            for (int i = 0; i < 64; ++i) o[i] = ob[i] + il * o[i];
        }
        store64_bf16(OB + ((size_t)b * S_ + t) * 512 + h * 64, o);
    }
}
#endif
DEV void phase_up(const Params& p, long gt, long nth) {
    unsigned char* ws = p.ws; const bf16* OA = (const bf16*)((unsigned char*)p.out + DO_OA); const bf16* OB = (const bf16*)((unsigned char*)p.out + DO_OB);
    const bf16* GA = (const bf16*)(ws + OFF_GA); const bf16* GB = (const bf16*)(ws + OFF_GB); bf16* MIX = (bf16*)(ws + OFF_MIX);
    constexpr int NGRP = D_ / 64;
    for (size_t it = gt; it < (size_t)T_ * NGRP; it += nth) {
        const int c0 = (int)(it % NGRP) * 64; const size_t row = it / NGRP;
        float a[64], bb[64], ga[64], gb[64];
#pragma unroll
        for (int j = 0; j < 64; ++j) { a[j] = 0.f; bb[j] = 0.f; }
        dot64(OA + row * 512, (const bf16*)(ws + OFF_WAT) + (size_t)c0 * 512, 512, 512, a);
        dot64(OB + row * 512, (const bf16*)(ws + OFF_WBT) + (size_t)c0 * 512, 512, 512, bb);
        load64(GA + row * D_ + c0, ga); load64(GB + row * D_ + c0, gb);
#pragma unroll
        for (int j = 0; j < 64; ++j) a[j] = ga[j] * a[j] + gb[j] * bb[j];
        store64_bf16(MIX + row * D_ + c0, a);
    }
}
DEV void phase_outproj(const Params& p, long gt, long nth) {
    unsigned char* ws = p.ws; const bf16* MIX = (const bf16*)(ws + OFF_MIX); constexpr int NGRP = D_ / 64;
    for (size_t it = gt; it < (size_t)T_ * NGRP; it += nth) {
        const int c0 = (int)(it % NGRP) * 64; const size_t row = it / NGRP;
        float a[64];
#pragma unroll
        for (int j = 0; j < 64; ++j) a[j] = 0.f;
        dot64(MIX + row * D_, (const bf16*)(ws + OFF_WOT) + (size_t)c0 * D_, D_, D_, a);
#pragma unroll
        for (int j = 0; j < 64; ++j) p.out[row * D_ + c0 + j] = p.x[row * D_ + c0 + j] + a[j];
    }
}
DEV void phase_route(const Params& p, long gt, long nth) {
    unsigned char* ws = p.ws; bf16* TN = (bf16*)(ws + OFF_TN); int* RT = (int*)(ws + OFF_ROUTE);
    for (size_t row = gt; row < (size_t)T_; row += nth) {
        const float* xr = p.out + row * D_; float ss = 0.f; for (int k = 0; k < D_; ++k) ss += xr[k] * xr[k];
        const float rs = 1.0f / sqrtf(ss / D_ + RMS_EPS);
        float gl[4], el[16];
        for (int j = 0; j < 4; ++j) gl[j] = 0.f;
        for (int j = 0; j < 16; ++j) el[j] = 0.f;
        for (int k = 0; k < D_; ++k) { const float tv = xr[k] * rs * p.norm_ffn_g[k]; TN[row * D_ + k] = f2bf(tv);
#pragma unroll
            for (int j = 0; j < 4; ++j) gl[j] += tv * p.w_group[(size_t)k * 4 + j];
#pragma unroll
            for (int j = 0; j < 16; ++j) el[j] += tv * p.w_router[(size_t)k * 16 + j]; }
        int gtop = 0; float gm = -INFINITY;
#pragma unroll
        for (int j = 0; j < 4; ++j) { gl[j] += p.b_group[j]; if (gl[j] > gm) { gm = gl[j]; gtop = j; } }
        float gs = 0.f;
#pragma unroll
        for (int j = 0; j < 4; ++j) gs += expf(gl[j] - gm);
        const float pg = 1.0f / gs;
        float e4[4]; float em = -INFINITY; int i0 = 0;
#pragma unroll
        for (int j = 0; j < 4; ++j) { float v = 0.f;
#pragma unroll
            for (int g = 0; g < 4; ++g) v = (g == gtop) ? el[g * 4 + j] + p.b_router[g * 4 + j] : v;
            e4[j] = v; }
#pragma unroll
        for (int j = 0; j < 4; ++j) if (e4[j] > em) { em = e4[j]; i0 = j; }
        float e2 = -INFINITY; int i1 = 0;
#pragma unroll
        for (int j = 0; j < 4; ++j) if (j != i0 && e4[j] > e2) { e2 = e4[j]; i1 = j; }
        const float p0 = 1.0f, p1 = expf(e2 - em);
        const float w0 = p0 / (p0 + p1) * pg, w1 = p1 / (p0 + p1) * pg;
        RT[row * 4 + 0] = gtop * 4 + i0; RT[row * 4 + 1] = gtop * 4 + i1; RT[row * 4 + 2] = (int)f2u(w0); RT[row * 4 + 3] = (int)f2u(w1);
    }
}
DEV void phase_moe_up(const Params& p, long gt, long nth) {
    unsigned char* ws = p.ws; const bf16* TN = (const bf16*)(ws + OFF_TN); const int* RT = (const int*)(ws + OFF_ROUTE); bf16* HID = (bf16*)(ws + OFF_HID);
    constexpr int NGRP = DE_ / 64;
    for (size_t it = gt; it < (size_t)T_ * 2 * NGRP; it += nth) {
        const int c0 = (int)(it % NGRP) * 64; size_t r = it / NGRP; const int k = (int)(r % 2); const size_t row = r / 2;
        const int e = RT[row * 4 + k]; const float w = u2f((unsigned)RT[row * 4 + 2 + k]);
        float a[64], u[64];
#pragma unroll
        for (int j = 0; j < 64; ++j) { a[j] = 0.f; u[j] = 0.f; }
        dot64(TN + row * D_, (const bf16*)(ws + OFF_WGT) + ((size_t)e * DE_ + c0) * D_, D_, D_, a);
        dot64(TN + row * D_, (const bf16*)(ws + OFF_WUT) + ((size_t)e * DE_ + c0) * D_, D_, D_, u);
#pragma unroll
        for (int j = 0; j < 64; ++j) a[j] = w * (a[j] * sigmoidf_(a[j])) * u[j];
        store64_bf16(HID + row * (2 * DE_) + k * DE_ + c0, a);
    }
}
DEV void phase_moe_down(const Params& p, long gt, long nth) {
    unsigned char* ws = p.ws; const int* RT = (const int*)(ws + OFF_ROUTE); const bf16* HID = (const bf16*)(ws + OFF_HID); constexpr int NGRP = D_ / 64;
    for (size_t it = gt; it < (size_t)T_ * NGRP; it += nth) {
        const int c0 = (int)(it % NGRP) * 64; const size_t row = it / NGRP;
        float a[64];
#pragma unroll
        for (int j = 0; j < 64; ++j) a[j] = 0.f;
        for (int k = 0; k < 2; ++k) { const int e = RT[row * 4 + k]; dot64(HID + row * (2 * DE_) + k * DE_, (const bf16*)(ws + OFF_WDT) + ((size_t)e * D_ + c0) * DE_, DE_, DE_, a); }
#pragma unroll
        for (int j = 0; j < 64; ++j) p.out[row * D_ + c0 + j] += a[j];
    }
}

#ifndef CPU_EMU
typedef short bf16x8 __attribute__((ext_vector_type(8)));
typedef float f32x4 __attribute__((ext_vector_type(4)));
typedef unsigned u32x4 __attribute__((ext_vector_type(4)));
typedef unsigned u32x2 __attribute__((ext_vector_type(2)));
#define LDS3 __attribute__((address_space(3)))
constexpr int NW = CFG_NW, NTHREADS = 64 * NW, BM = 32 * NW;
constexpr int GEMM_NST = NW >= 8 ? 3 : 2, GEMM_STAGE = (128 + BM) * 128;
constexpr int LDS_TILE_BYTES = NW >= 8 ? GEMM_NST * GEMM_STAGE : 69632;
constexpr int BWL_OFF = LDS_TILE_BYTES + 32, BWL_BYTES = 128 * 20 * 4;
constexpr int LDS_BYTES = LDS_TILE_BYTES + 64 + BWL_BYTES;
static_assert(2 * LDS_BYTES <= 160 * 1024, "two workgroups per CU");
struct GemmSrc { const bf16* X; size_t ldx; const int* xidx; const bf16* W0; const bf16* W1; int ksplit; size_t ldw; int K; };
typedef float f32x2v __attribute__((ext_vector_type(2)));
typedef __bf16 bf16x2v __attribute__((ext_vector_type(2)));
DEV unsigned pk_bf16(float lo, float hi) { return __builtin_bit_cast(unsigned, __builtin_convertvector((f32x2v){lo, hi}, bf16x2v)); }
DEV void zero_acc(f32x4 (&acc)[4][4]) {
#pragma unroll
    for (int i = 0; i < 4; ++i)
#pragma unroll
        for (int j = 0; j < 4; ++j) acc[i][j] = (f32x4){0.f, 0.f, 0.f, 0.f};
}
DEV void glds16g(const void* g, unsigned lds) { unsigned keep; lds = __builtin_amdgcn_readfirstlane(lds); asm volatile("s_mov_b32 %0, m0\n\ts_mov_b32 m0, %2\n\ts_nop 0\n\tglobal_load_lds_dwordx4 %1, off\n\ts_mov_b32 m0, %0" : "=&s"(keep) : "v"(g), "s"(lds) : "memory"); }
DEV void gemm_mainloop(f32x4 (&acc)[4][4], const GemmSrc& g, int m0, int n0, unsigned char* smem) {
    constexpr int WP = 16 / NW, XP = BM / 8 / NW, NVMG = WP + XP;
    const int t = threadIdx.x, lane = t & 63, w = __builtin_amdgcn_readfirstlane(t >> 6), wn = w / (NW / 2), wm = w % (NW / 2);
    const int lr = 8 * w + (lane >> 3);
    const int gch = ((lane & 7) ^ ((4 * w + (lane >> 4)) & 7)) * 8;
    int xr[XP];
#pragma unroll
    for (int i = 0; i < XP; ++i) { int r = m0 + lr + 8 * NW * i; if (g.xidx) { r = g.xidx[r]; r = (unsigned)r < (unsigned)T_ ? r : 0; } xr[i] = r; }
    if (g.xidx) {
#pragma unroll
        for (int i = 0; i < XP; ++i) asm volatile("" :: "v"(xr[i]));
    }
    const size_t wrow0 = (size_t)(n0 + lr) * g.ldw + gch;
    const unsigned sbase = (unsigned)(size_t)(LDS3 unsigned char*)smem;
    const int fsw = ((lane >> 4) ^ ((lane & 15) >> 1)) << 4;
    const int waddr = (64 * wn + (lane & 15)) * 128 + fsw, xaddr = 16384 + (64 * wm + (lane & 15)) * 128 + fsw;
    const int nk = g.K / 64;
    auto gissue = [&](int kt) {
        const int k = kt * 64; const bf16* wb = (k < g.ksplit ? g.W0 + k : g.W1 + (k - g.ksplit)) + wrow0; const unsigned lb = sbase + (unsigned)((kt % GEMM_NST) * GEMM_STAGE + w * 1024);
#pragma unroll
        for (int i = 0; i < WP; ++i) glds16g(wb + (size_t)(8 * NW * i) * g.ldw, lb + i * (NW * 1024));
#pragma unroll
        for (int i = 0; i < XP; ++i) glds16g(g.X + (size_t)xr[i] * g.ldx + (gch + k), lb + 16384 + i * (NW * 1024));
    };
#pragma unroll
    for (int j = 0; j < GEMM_NST - 1; ++j) if (j < nk) gissue(j);
    for (int kt = 0; kt < nk; ++kt) {
        const int ahead = nk - 1 - kt < GEMM_NST - 2 ? nk - 1 - kt : GEMM_NST - 2;
        if (ahead >= 2) asm volatile("s_waitcnt vmcnt(%0)" :: "n"(2 * NVMG) : "memory"); else if (ahead == 1) asm volatile("s_waitcnt vmcnt(%0)" :: "n"(NVMG) : "memory"); else asm volatile("s_waitcnt vmcnt(0)" ::: "memory");
        __builtin_amdgcn_s_barrier();
        asm volatile("" ::: "memory");
        if (kt + GEMM_NST - 1 < nk) gissue(kt + GEMM_NST - 1);
        const unsigned char* b = smem + (kt % GEMM_NST) * GEMM_STAGE;
#pragma unroll
        for (int kk = 0; kk < 2; ++kk) {
            bf16x8 wf[4], xf[4];
#pragma unroll
            for (int i = 0; i < 4; ++i) { wf[i] = *(const bf16x8*)(b + ((waddr ^ (kk << 6)) + i * 2048)); xf[i] = *(const bf16x8*)(b + ((xaddr ^ (kk << 6)) + i * 2048)); }
            __builtin_amdgcn_s_setprio(1);
#pragma unroll
            for (int i = 0; i < 4; ++i)
#pragma unroll
                for (int j = 0; j < 4; ++j) acc[i][j] = __builtin_amdgcn_mfma_f32_16x16x32_bf16(wf[i], xf[j], acc[i][j], 0, 0, 0);
            __builtin_amdgcn_s_setprio(0);
        }
    }
    asm volatile("s_waitcnt lgkmcnt(0)" ::: "memory");
    __builtin_amdgcn_s_barrier();
    asm volatile("" ::: "memory");
}
DEV int vblock() { const int G = gridDim.x, b = blockIdx.x; return (G % 8 == 0) ? (b % 8) * (G / 8) + b / 8 : b; }
DEV void tile_coords(int lin, int ntm, int ntn, int& pm, int& pn) { const int grp = lin / (8 * ntn), rem = lin % (8 * ntn), fm = grp * 8, gsz = (ntm - fm) < 8 ? (ntm - fm) : 8; pm = fm + rem % gsz; pn = rem / gsz; }
DEV float rsum16(float v) { v += __shfl_xor(v, 16); v += __shfl_xor(v, 32); return v; }

DEV void bphase_inproj(const Params& p, unsigned char* smem) {
    unsigned char* ws = p.ws; const int lane = threadIdx.x & 63, w = threadIdx.x >> 6, wn = w / (NW / 2), wm = w % (NW / 2), q = lane >> 4, c = lane & 15;
    constexpr int NTM = T_ / BM, NTN = NP / 128;
    GemmSrc g{(const bf16*)((unsigned char*)p.out + DO_H), (size_t)D_, nullptr, (const bf16*)(ws + OFF_WINT), (const bf16*)(ws + OFF_WINT), 1 << 30, (size_t)D_, D_};
    for (int lin = vblock(); lin < NTM * NTN; lin += gridDim.x) {
        int pm, pn; tile_coords(lin, NTM, NTN, pm, pn); const int m0 = pm * BM, n0 = pn * 128;
        f32x4 acc[4][4]; zero_acc(acc);
        gemm_mainloop(acc, g, m0, n0, smem);
        const int n0w = n0 + 64 * wn, m0w = m0 + 64 * wm, b = m0 / S_, s0 = m0w % S_;
        if (n0 < C_GA) {
            bf16* dst; const float* gain = nullptr; float mul = 1.f;
            if (n0 < C_KC) { const int which = n0 / 512, h = (n0w % 512) / 64;
                dst = (bf16*)(ws + (which == 0 ? OFF_FQ : which == 1 ? OFF_FK : which == 2 ? OFF_FV : OFF_NQ)) + ((size_t)b * 8 + h) * S_ * 64;
                if (which != 2) { gain = which == 0 ? p.fox_q_g : which == 1 ? p.fox_k_g : p.nsa_q_g; mul = which == 1 ? 1.f : QSCALE; } }
            else { const int which = (n0 - C_KC) / 128; dst = (bf16*)(ws + OFF_KCR + (size_t)which * SZ_KV) + ((size_t)b * 2 + wn) * S_ * 64; if (which == 2 || which == 4) gain = p.nsa_k_g; }
            f32x4 g4[4];
#pragma unroll
            for (int nf = 0; nf < 4; ++nf) g4[nf] = gain ? *(const f32x4*)(gain + 16 * nf + 4 * q) : (f32x4){1.f, 1.f, 1.f, 1.f};
#pragma unroll
            for (int mf = 0; mf < 4; ++mf) {
                float rs = 1.f;
                if (gain) { float ss = 0.f;
#pragma unroll
                    for (int nf = 0; nf < 4; ++nf) { const f32x4 v = acc[nf][mf]; ss += (v[0] * v[0] + v[1] * v[1]) + (v[2] * v[2] + v[3] * v[3]); }
                    rs = 1.0f / sqrtf(rsum16(ss) * (1.0f / 64) + RMS_EPS) * mul; }
                bf16* drow = dst + (size_t)(s0 + 16 * mf + c) * 64 + 4 * q;
#pragma unroll
                for (int nf = 0; nf < 4; ++nf) { const f32x4 v = acc[nf][mf] * rs * g4[nf]; *(u32x2*)(drow + 16 * nf) = (u32x2){pk_bf16(v[0], v[1]), pk_bf16(v[2], v[3])}; }
            }
        } else if (n0 < C_FF) {
            const bool isb = n0 >= C_GB; bf16* dst = (bf16*)(ws + (isb ? OFF_GB : OFF_GA)) + (n0w - (isb ? C_GB : C_GA)) + 4 * q;
#pragma unroll
            for (int mf = 0; mf < 4; ++mf) { bf16* drow = dst + (size_t)(m0w + 16 * mf + c) * D_;
#pragma unroll
                for (int nf = 0; nf < 4; ++nf) { const f32x4 v = acc[nf][mf]; *(u32x2*)(drow + 16 * nf) = (u32x2){pk_bf16(sigmoidf_(v[0]), sigmoidf_(v[1])), pk_bf16(sigmoidf_(v[2]), sigmoidf_(v[3]))}; } }
        } else if (wn == 0) {
            float* lf = (float*)(ws + OFF_LOGF); float* gt_ = (float*)(ws + OFF_GATE);
#pragma unroll
            for (int mf = 0; mf < 4; ++mf) { const int m = m0w + 16 * mf + c, s = m % S_;
#pragma unroll
                for (int r = 0; r < 4; ++r) { const int j = 4 * q + r; const float v0 = acc[0][mf][r];
                    if (j < 8) { const float v = v0 + p.b_forget[j]; lf[((size_t)b * 8 + j) * S_ + s] = fminf(v, 0.f) - log1pf(expf(-fabsf(v))); }
                    else gt_[(size_t)m * 24 + (j - 8)] = sigmoidf_(v0);
                    gt_[(size_t)m * 24 + 8 + j] = sigmoidf_(acc[1][mf][r]); } }
        }
    }
}
DEV void st_dev(void* ptr, u32x2 v) { __hip_atomic_store((unsigned long long*)ptr, __builtin_bit_cast(unsigned long long, v), __ATOMIC_RELAXED, __HIP_MEMORY_SCOPE_AGENT); }
DEV void st_dev(float* ptr, float v) { __hip_atomic_store(ptr, v, __ATOMIC_RELAXED, __HIP_MEMORY_SCOPE_AGENT); }
DEV f32x2v ld_dev(const float* ptr) { return __builtin_bit_cast(f32x2v, __hip_atomic_load((const unsigned long long*)ptr, __ATOMIC_RELAXED, __HIP_MEMORY_SCOPE_AGENT)); }
DEV bf16* ao_row(const Params& p, int which  , int b, int q) { return (bf16*)((unsigned char*)p.out + (size_t)(q / BM) * ((size_t)BM * D_ * 4) + (size_t)(which * 2 + b) * ((size_t)BM * 1024) + (size_t)(q % BM) * 1024); }
DEV void up_tile(const Params& p, unsigned char* smem, int pm, int pn) {
    unsigned char* ws = p.ws; asm volatile("" : "+v"(ws)); int t = threadIdx.x; asm volatile("" : "+v"(t)); const int lane = t & 63, w = t >> 6, wn = w / (NW / 2), wm = w % (NW / 2), q = lane >> 4, c = lane & 15;
    GemmSrc ga{ao_row(p, 0, pm / (S_ / BM), (pm % (S_ / BM)) * BM), 512, nullptr, (const bf16*)(ws + OFF_WAT), (const bf16*)(ws + OFF_WAT), 1 << 30, 512, 512};
    GemmSrc gb{ao_row(p, 1, pm / (S_ / BM), (pm % (S_ / BM)) * BM), 512, nullptr, (const bf16*)(ws + OFF_WBT), (const bf16*)(ws + OFF_WBT), 1 << 30, 512, 512};
    const bf16* GA = (const bf16*)(ws + OFF_GA); const bf16* GB = (const bf16*)(ws + OFF_GB); bf16* MIX = (bf16*)(ws + OFF_MIX);
    {
        const int m0 = pm * BM, n0 = pn * 128;
        f32x4 acc[4][4], acc2[4][4]; zero_acc(acc); zero_acc(acc2);
        gemm_mainloop(acc, ga, 0, n0, smem);
        gemm_mainloop(acc2, gb, 0, n0, smem);
        const int n0w = n0 + 64 * wn, m0w = m0 + 64 * wm;
        const unsigned eoff = (unsigned)(((size_t)(m0w + c) * D_ + n0w + 4 * q) * 2);
#pragma unroll
        for (int mf = 0; mf < 4; ++mf) {
#pragma unroll
            for (int nf = 0; nf < 4; ++nf) { const unsigned off = eoff + (unsigned)(mf * 16 * D_ * 2 + nf * 32); const u32x2 gv = *(const u32x2*)((const unsigned char*)GA + off), hv = *(const u32x2*)((const unsigned char*)GB + off);
                const f32x4 v = acc[nf][mf] * (f32x4){u2f(gv.x << 16), u2f(gv.x & 0xffff0000u), u2f(gv.y << 16), u2f(gv.y & 0xffff0000u)} + acc2[nf][mf] * (f32x4){u2f(hv.x << 16), u2f(hv.x & 0xffff0000u), u2f(hv.y << 16), u2f(hv.y & 0xffff0000u)};
                __hip_atomic_store((unsigned long long*)((unsigned char*)MIX + off), __builtin_bit_cast(unsigned long long, (u32x2){pk_bf16(v[0], v[1]), pk_bf16(v[2], v[3])}), __ATOMIC_RELAXED, __HIP_MEMORY_SCOPE_AGENT); }
            asm volatile("" ::: "memory"); }
    }
}
DEV void out_tile(const Params& p, unsigned char* smem, int pm, int pn) {
    unsigned char* ws = p.ws; asm volatile("" : "+v"(ws)); int t = threadIdx.x; asm volatile("" : "+v"(t)); const int lane = t & 63, w = t >> 6, wn = w / (NW / 2), wm = w % (NW / 2), q = lane >> 4, c = lane & 15;
    GemmSrc g{(const bf16*)(ws + OFF_MIX), (size_t)D_, nullptr, (const bf16*)(ws + OFF_WOT), (const bf16*)(ws + OFF_WOT), 1 << 30, (size_t)D_, D_};
    {
        const int m0 = pm * BM, n0 = pn * 128;
        f32x4 acc[4][4]; zero_acc(acc);
        const int n0w = n0 + 64 * wn, m0w = m0 + 64 * wm; float* ssp = (float*)(ws + OFF_SSP);
        {
            const unsigned lb = (unsigned)(size_t)(LDS3 unsigned char*)smem + BWL_OFF; const unsigned char* src = ws + OFF_BW + (size_t)n0 * 80 + lane * 16;
            const int w1 = __builtin_amdgcn_readfirstlane(w);
            for (int ch = w1; ch < BWL_BYTES / 1024; ch += NW) glds16g(src + ch * 1024, lb + ch * 1024);
        }
        f32x4 xv[4][4];
#pragma unroll
        for (int mf = 0; mf < 4; ++mf)
#pragma unroll
            for (int nf = 0; nf < 4; ++nf) xv[mf][nf] = *(const f32x4*)(p.x + (size_t)(m0w + 16 * mf + c) * D_ + n0w + 16 * nf + 4 * q);
        gemm_mainloop(acc, g, m0, n0, smem);
        const float* bwl = (const float*)(smem + BWL_OFF) + (64 * wn + 4 * q) * 20 + c; bf16* TN = (bf16*)(ws + OFF_TN);
        f32x4 gf[4];
#pragma unroll
        for (int nf = 0; nf < 4; ++nf) gf[nf] = *(const f32x4*)(p.norm_ffn_g + n0w + 16 * nf + 4 * q);
        float* red = (float*)smem;
#pragma unroll
        for (int mf = 0; mf < 4; ++mf) { float ss = 0.f; f32x4 a0 = {0.f, 0.f, 0.f, 0.f}, a1 = {0.f, 0.f, 0.f, 0.f};
#pragma unroll
            for (int nf = 0; nf < 4; ++nf) { const size_t off = (size_t)(m0w + 16 * mf + c) * D_ + n0w + 16 * nf + 4 * q; const f32x4 v = xv[mf][nf] + acc[nf][mf]; *(f32x4*)(p.out + off) = v; ss += (v[0] * v[0] + v[1] * v[1]) + (v[2] * v[2] + v[3] * v[3]);
                const f32x4 tv = v * gf[nf]; *(u32x2*)(TN + off) = (u32x2){pk_bf16(tv[0], tv[1]), pk_bf16(tv[2], tv[3])};
#pragma unroll
                for (int i = 0; i < 4; ++i) { const float b0 = bwl[(16 * nf + i) * 20], b1 = c < 4 ? bwl[(16 * nf + i) * 20 + 16] : 0.f; a0 = __builtin_amdgcn_mfma_f32_16x16x4f32(v[i], b0, a0, 0, 0, 0); a1 = __builtin_amdgcn_mfma_f32_16x16x4f32(v[i], b1, a1, 0, 0, 0); } }
            ss = rsum16(ss); if (q == 0) red[(wn * BM + 64 * wm + 16 * mf + c) * 24 + 20] = ss;
            float* rr = red + (wn * BM + 64 * wm + 16 * mf + 4 * q) * 24 + c;
#pragma unroll
            for (int r = 0; r < 4; ++r) { rr[r * 24] = a0[r]; if (c < 4) rr[r * 24 + 16] = a1[r]; } }
        __syncthreads();
        float* plt = (float*)(ws + OFF_PL) + ((size_t)pn * T_ + m0) * 20;
        for (int idx = t; idx < BM * 5; idx += NTHREADS) { const int row = idx / 5, k = idx % 5; const f32x4 v = *(const f32x4*)(red + row * 24 + 4 * k) + *(const f32x4*)(red + (BM + row) * 24 + 4 * k);
            st_dev(plt + 4 * idx, (u32x2){f2u(v[0]), f2u(v[1])}); st_dev(plt + 4 * idx + 2, (u32x2){f2u(v[2]), f2u(v[3])}); }
        if (t < BM) st_dev(ssp + (size_t)pn * T_ + m0 + t, red[t * 24 + 20] + red[(BM + t) * 24 + 20]);
    }
}

struct TrJob { const float* src; int ldsrc; bf16* dst; int lddst; int kind; int e; };
DEV void transpose_tile(const TrJob& j, int r0, int k0) {
    const int lane = threadIdx.x & 63;
    const float* colp; bool valid = true;
    if (j.kind == 0) colp = j.src + (r0 + lane);
    else if (j.kind == 1) { const int oc = orig_col(r0 + lane); valid = oc >= 0; colp = j.src + (valid ? oc : 0); }
    else { const int jj = (r0 / 64) * 32 + (lane & 31); colp = j.src + jj; }
    colp += (size_t)k0 * j.ldsrc;
    bf16* drow = j.dst + (size_t)(r0 + lane) * j.lddst + k0;
    {
        float v[64];
#pragma unroll
        for (int kk = 0; kk < 64; ++kk) v[kk] = valid ? colp[(size_t)kk * j.ldsrc] : 0.f;
#pragma unroll
        for (int c8 = 0; c8 < 8; ++c8) *(u32x4*)(drow + 8 * c8) = (u32x4){pk_bf16(v[8 * c8], v[8 * c8 + 1]), pk_bf16(v[8 * c8 + 2], v[8 * c8 + 3]), pk_bf16(v[8 * c8 + 4], v[8 * c8 + 5]), pk_bf16(v[8 * c8 + 6], v[8 * c8 + 7])};
    }
}
constexpr int T_WIN = (NP / 64) * (D_ / 64), T_WA = (D_ / 64) * (512 / 64), T_WO = (D_ / 64) * (D_ / 64), T_W1 = (256 / 64) * (2048 / 64), T_W2 = (64 / 64) * (256 / 64),
              T_GU = (2 * DE_ / 64) * (D_ / 64), T_WD = (D_ / 64) * (DE_ / 64);
constexpr int NJOB0 = T_WIN + 2 * T_W1 + 2 * T_W2, NJOB1 = 2 * T_WA + T_WO, NJOB2 = NE * (T_GU + T_WD);
DEV void prep_job(const Params& p, int stage, int r) {
    unsigned char* ws = p.ws; asm volatile("" : "+v"(ws)); const int lane = threadIdx.x & 63; TrJob j; int K = D_;
    if (stage == 0) {
        if (r < T_WIN) { j = TrJob{p.w_in, D_IN, (bf16*)(ws + OFF_WINT), D_, 1, 0}; K = D_; }
        else if ((r -= T_WIN) < 2 * T_W1) { const int kv = r / T_W1; r %= T_W1; j = TrJob{kv ? p.cmp_v_w1 : p.cmp_k_w1, 256, (bf16*)(ws + OFF_W1T) + (size_t)kv * 256 * 2048, 2048, 0, 0}; K = 2048; }
        else { r -= 2 * T_W1; const int kv = r / T_W2; r %= T_W2; j = TrJob{kv ? p.cmp_v_w2 : p.cmp_k_w2, 64, (bf16*)(ws + OFF_W2T) + (size_t)kv * 128 * 256, 256, 0, 0}; K = 256; }
    } else if (stage == 1) {
        if (r < T_WA) { j = TrJob{p.w_fox_up, D_, (bf16*)(ws + OFF_WAT), 512, 0, 0}; K = 512; }
        else if ((r -= T_WA) < T_WA) { j = TrJob{p.w_nsa_up, D_, (bf16*)(ws + OFF_WBT), 512, 0, 0}; K = 512; }
        else { r -= T_WA; j = TrJob{p.w_out, D_, (bf16*)(ws + OFF_WOT), D_, 0, 0}; K = D_; }
    } else {
        if (r < NE * T_GU) { const int e = r / T_GU; r %= T_GU; j = TrJob{nullptr, DE_, (bf16*)(ws + OFF_WGT) + (size_t)e * 2 * DE_ * D_, D_, 2, e}; K = D_; }
        else { r -= NE * T_GU; const int e = r / T_WD; r %= T_WD; j = TrJob{p.w_down + (size_t)e * DE_ * D_, D_, (bf16*)(ws + OFF_WDT) + (size_t)e * D_ * DE_, DE_, 0, 0}; K = DE_; }
    }
    const int nkt = K / 64, r0 = (r / nkt) * 64, k0 = (r % nkt) * 64;
    if (j.kind == 2) j.src = ((lane < 32) ? p.w_gate : p.w_up) + (size_t)j.e * D_ * DE_;
    transpose_tile(j, r0, k0);
}
DEV void route_item(const Params& p, unsigned char* smem, int R) {
    unsigned char* ws = p.ws; asm volatile("" : "+v"(ws)); int t = threadIdx.x; asm volatile("" : "+v"(t));
    unsigned* cnt = (unsigned*)(ws + OFF_CTL) + CTL_CNT; const size_t stoff = OFF_STOK, swoff = OFF_SW;
    static_assert(NTHREADS == 2 * BM, "two threads per token");
    const int half = t & 1; const size_t row = (size_t)R * BM + (t >> 1); float* l = (float*)smem + (t >> 1) * 21;
    f32x2v acc[10]; float ss = 0.f;
#pragma unroll
    for (int j = 0; j < 10; ++j) acc[j] = (f32x2v){0.f, 0.f};
#pragma unroll
    for (int pp = 0; pp < 4; ++pp) { const int part = 4 * half + pp; const float* pl = (const float*)(ws + OFF_PL) + ((size_t)part * T_ + row) * 20;
#pragma unroll
        for (int j = 0; j < 10; ++j) acc[j] += ld_dev(pl + 2 * j);
        ss += __hip_atomic_load((const float*)(ws + OFF_SSP) + (size_t)part * T_ + row, __ATOMIC_RELAXED, __HIP_MEMORY_SCOPE_AGENT); }
#pragma unroll
    for (int j = 0; j < 10; ++j) { acc[j][0] += __shfl_xor(acc[j][0], 1); acc[j][1] += __shfl_xor(acc[j][1], 1); }
    ss += __shfl_xor(ss, 1);
    if (half == 0) {
        const float rsr = 1.0f / sqrtf(ss / D_ + RMS_EPS);
        ((float*)(ws + OFF_RS))[row] = rsr;
#pragma unroll
        for (int j = 0; j < 10; ++j) { l[2 * j] = acc[j][0]; l[2 * j + 1] = acc[j][1]; }
        float gl[4]; int gtop = 0; float gm = -INFINITY;
#pragma unroll
        for (int j = 0; j < 4; ++j) { gl[j] = l[16 + j] * rsr + p.b_group[j]; if (gl[j] > gm) { gm = gl[j]; gtop = j; } }
        float gs = 0.f;
#pragma unroll
        for (int j = 0; j < 4; ++j) gs += expf(gl[j] - gm);
        const float pg = 1.0f / gs;
        float e4[4]; float em = -INFINITY; int i0 = 0;
#pragma unroll
        for (int j = 0; j < 4; ++j) { e4[j] = l[gtop * 4 + j] * rsr + p.b_router[gtop * 4 + j]; if (e4[j] > em) { em = e4[j]; i0 = j; } }
        float e2 = -INFINITY; int i1 = 0;
#pragma unroll
        for (int j = 0; j < 4; ++j) if (j != i0 && e4[j] > e2) { e2 = e4[j]; i1 = j; }
        const float p1 = expf(e2 - em); const float w0 = 1.0f / (1.0f + p1) * pg, w1 = p1 / (1.0f + p1) * pg;
        const int lo = i0 < i1 ? i0 : i1, hi = i0 < i1 ? i1 : i0; const int pidx = lo == 0 ? hi - 1 : (lo == 1 ? hi + 1 : 5);
        const int cls = gtop * 6 + pidx;
        const unsigned rank = atomicAdd(cnt + cls * CST, 1u);
        ((int*)(ws + stoff))[(size_t)cls * T_ + rank] = (int)row; float* swp = (float*)(ws + swoff) + ((size_t)cls * T_ + rank) * 2; swp[0] = i0 < i1 ? w0 : w1; swp[1] = i0 < i1 ? w1 : w0;
    }
}
DEV void class_experts(int cls, int& elo, int& ehi) { const int g = cls / 6, pi = cls % 6; const int lo = pi < 3 ? 0 : (pi < 5 ? 1 : 2); const int hi = pi < 3 ? pi + 1 : (pi < 5 ? pi - 1 : 3); elo = g * 4 + lo; ehi = g * 4 + hi; }
DEV int moe_find_class(const unsigned* cnt, int mtile_lin, int& tile0, int& ntc) {
    int t0 = 0;
    for (int k = 0; k < NCLS; ++k) { const int n = (int)((cnt[k * CST] + (unsigned)(BM - 1)) / (unsigned)BM); if (mtile_lin < t0 + n) { tile0 = t0; ntc = n; return k; } t0 += n; }
    return -1;
}
DEV int moe_total_tiles(const unsigned* cnt) { int t0 = 0; for (int k = 0; k < NCLS; ++k) t0 += (int)((cnt[k * CST] + (unsigned)(BM - 1)) / (unsigned)BM); return t0; }
DEV void dep_post(unsigned* ctr, bool wb);
DEV void dep_wait(unsigned* ctr, unsigned target, unsigned* bar, bool acq);
DEV unsigned xb_xcc_id();
DEV void bphase_moe_up(const Params& p, unsigned char* smem) {
    unsigned char* ws = p.ws; const int lane = threadIdx.x & 63, w = threadIdx.x >> 6, wn = w / (NW / 2), wm = w % (NW / 2), q = lane >> 4, c = lane & 15;
    const unsigned* cnt = (const unsigned*)(ws + OFF_CTL) + CTL_CNT; bf16* HID = (bf16*)(ws + OFF_HID);
    constexpr int NTN = (2 * 2 * DE_) / 128, NTE = NTN / 2;
    const int tot = moe_total_tiles(cnt);
    for (int lin = vblock(); lin < tot * NTN; lin += gridDim.x) {
        int cls = -1, t0 = 0, ntc = 0, acc_t = 0;
        for (int k = 0; k < NCLS; ++k) { const int n = (int)((cnt[k * CST] + (unsigned)(BM - 1)) / (unsigned)BM); if (cls < 0 && lin < (acc_t + n) * NTN) { cls = k; t0 = acc_t; ntc = n; } acc_t += n; }
        const int idin = lin - t0 * NTN, nt = idin / ntc, mt = idin % ntc; const int slot0 = (t0 + mt) * BM;
        int elo, ehi; class_experts(cls, elo, ehi); const int half = nt / NTE, e = half ? ehi : elo; const int n0 = (nt % NTE) * 128;
        const bf16* wb = (const bf16*)(ws + OFF_WGT) + (size_t)e * (2 * DE_) * D_;
        const int* st = (const int*)(ws + OFF_STOK) + (size_t)cls * T_; const float* sw = (const float*)(ws + OFF_SW) + (size_t)cls * T_ * 2;
        GemmSrc g{(const bf16*)(ws + OFF_TN), (size_t)D_, st, wb, wb, 1 << 30, (size_t)D_, D_};
        f32x4 acc[4][4]; zero_acc(acc);
        float wt4[4], rs4[4];
        { const unsigned ncl = cnt[cls * CST];
#pragma unroll
          for (int mf = 0; mf < 4; ++mf) { const int rk = mt * BM + 64 * wm + 16 * mf + c; const bool vr = (unsigned)rk < ncl; const int tok = vr ? st[rk] : 0; wt4[mf] = vr ? sw[2 * rk + half] : 0.f; rs4[mf] = vr ? ((const float*)(ws + OFF_RS))[tok] : 0.f; } }
        gemm_mainloop(acc, g, mt * BM, n0, smem);
        const int j0 = ((n0 + 64 * wn) / 64) * 32;
#pragma unroll
        for (int mf = 0; mf < 4; ++mf) { const int slot = slot0 + 64 * wm + 16 * mf + c; const float wt = wt4[mf], rsr = rs4[mf]; bf16* drow = HID + (size_t)slot * (2 * DE_) + half * DE_ + j0 + 4 * q;
#pragma unroll
            for (int nf = 0; nf < 2; ++nf) { const f32x4 gv = acc[nf][mf], uv = acc[nf + 2][mf]; f32x4 h;
#pragma unroll
                for (int r = 0; r < 4; ++r) { const float gs = gv[r] * rsr; h[r] = wt * (gs * sigmoidf_(gs)) * (uv[r] * rsr); }
                st_dev(drow + 16 * nf, (u32x2){pk_bf16(h[0], h[1]), pk_bf16(h[2], h[3])}); } }
        dep_post((unsigned*)(ws + OFF_CTL) + CTL_HIDDONE + 4 * (t0 + mt), false);
    }
}
DEV void bphase_moe_down(const Params& p, unsigned char* smem) {
    unsigned char* ws = p.ws; const int lane = threadIdx.x & 63, w = threadIdx.x >> 6, wn = w / (NW / 2), wm = w % (NW / 2), q = lane >> 4, c = lane & 15;
    const unsigned* cnt = (const unsigned*)(ws + OFF_CTL) + CTL_CNT;
    constexpr int NTN = D_ / 128;
    const int tot = moe_total_tiles(cnt);
    unsigned* ctl = (unsigned*)(ws + OFF_CTL); int* slot = (int*)(smem + LDS_BYTES - 16); const unsigned x = xb_xcc_id() & 7u;
    for (unsigned s8 = 0; s8 < 8; ++s8) { const unsigned xq = (x + s8) & 7u;
      for (;;) {
        if (threadIdx.x == 0) slot[0] = (int)atomicAdd(ctl + CTL_MDQ + 64 * xq, 1u);
        __syncthreads();
        const int nq = slot[0];
        __syncthreads();
        const int lin = ((nq >> 6) * 8 + (int)xq) * 64 + (nq & 63);
        if ((lin & ~63) >= tot * NTN) break;
        if (lin >= tot * NTN) continue;
        int cls = -1, t0 = 0, ntc = 0, acc_t = 0;
        for (int k = 0; k < NCLS; ++k) { const int n = (int)((cnt[k * CST] + (unsigned)(BM - 1)) / (unsigned)BM); if (cls < 0 && lin < (acc_t + n) * NTN) { cls = k; t0 = acc_t; ntc = n; } acc_t += n; }
        const int idin = lin - t0 * NTN, nt = idin / ntc, mt = idin % ntc; const int slot0 = (t0 + mt) * BM, n0 = nt * 128;
        dep_wait(ctl + CTL_HIDDONE + 4 * (t0 + mt), 16u, ctl + CTL_BAR, false);
        int elo, ehi; class_experts(cls, elo, ehi);
        GemmSrc g{(const bf16*)(ws + OFF_HID), (size_t)(2 * DE_), nullptr, (const bf16*)(ws + OFF_WDT) + (size_t)elo * D_ * DE_, (const bf16*)(ws + OFF_WDT) + (size_t)ehi * D_ * DE_, DE_, (size_t)DE_, 2 * DE_};
        f32x4 acc[4][4]; zero_acc(acc);
        const int n0w = n0 + 64 * wn; const unsigned ncl = cnt[cls * CST];
        f32x4 xv[4][4]; int tk[4];
#pragma unroll
        for (int mf = 0; mf < 4; ++mf) { const int rk = mt * BM + 64 * wm + 16 * mf + c; tk[mf] = (unsigned)rk < ncl ? ((const int*)(ws + OFF_STOK))[(size_t)cls * T_ + rk] : -1; }
#pragma unroll
        for (int mf = 0; mf < 4; ++mf) { const float* orow = p.out + (size_t)(tk[mf] < 0 ? 0 : tk[mf]) * D_ + n0w + 4 * q;
#pragma unroll
            for (int nf = 0; nf < 4; ++nf) xv[mf][nf] = *(const f32x4*)(orow + 16 * nf); }
        gemm_mainloop(acc, g, slot0, n0, smem);
#pragma unroll
        for (int mf = 0; mf < 4; ++mf) { if (tk[mf] < 0) continue; float* orow = p.out + (size_t)tk[mf] * D_ + n0w + 4 * q;
#pragma unroll
            for (int nf = 0; nf < 4; ++nf) *(f32x4*)(orow + 16 * nf) = xv[mf][nf] + acc[nf][mf]; }
      }
    }
}

typedef float f32x16 __attribute__((ext_vector_type(16)));
typedef short s16x4 __attribute__((ext_vector_type(4)));
constexpr int AT_K = 0, AT_V = 8192, AT_B = 16384, AT_STAGE = 16384 + (NW > 4 ? NW : 4) * 256;
constexpr float NEG_BIG = -INFINITY;
constexpr float SM_THR = 8.0f;
DEV float xhalf_max(float v) { auto rr = __builtin_amdgcn_permlane32_swap(f2u(v), f2u(v), false, false); return fmaxf(u2f(rr[0]), u2f(rr[1])); }
DEV float xhalf_sum(float v) { auto rr = __builtin_amdgcn_permlane32_swap(f2u(v), f2u(v), false, false); return u2f(rr[0]) + u2f(rr[1]); }
DEV bf16x8 pack8(const f32x16& p, int b) {
    u32x4 w = {pk_bf16(p[b + 0], p[b + 1]), pk_bf16(p[b + 2], p[b + 3]), pk_bf16(p[b + 4], p[b + 5]), pk_bf16(p[b + 6], p[b + 7])};
    return __builtin_bit_cast(bf16x8, w);
}
struct AttnLane {
    int kofs[4];
    int vofs;
};
DEV AttnLane attn_lane_setup(int lane) {
    AttnLane a; const int r = lane & 31, hh = lane >> 5, sw = (r >> 1) & 7;
#pragma unroll
    for (int s = 0; s < 4; ++s) a.kofs[s] = r * 128 + (((2 * s + hh) ^ sw) << 4);
    const int qq = (lane & 15) >> 2, pp = lane & 3, blk = (lane >> 4) & 1; const int cb = (2 * blk + (pp >> 1)) ^ (((qq >> 1) & 1) << 2);
    a.vofs = (4 * hh + qq) * 128 + (cb << 4) + 8 * (pp & 1);
    return a;
}
DEV void attn_qk(f32x16& sA, f32x16& sB, const unsigned char* kt, const AttnLane& a, const bf16x8 (&qf)[4]) {
#pragma unroll
    for (int s = 0; s < 4; ++s) { const bf16x8 ka = *(const bf16x8*)(kt + a.kofs[s]); const bf16x8 kb = *(const bf16x8*)(kt + 4096 + a.kofs[s]);
        sA = __builtin_amdgcn_mfma_f32_32x32x16_bf16(ka, qf[s], sA, 0, 0, 0); sB = __builtin_amdgcn_mfma_f32_32x32x16_bf16(kb, qf[s], sB, 0, 0, 0); }
}
DEV void attn_bias_init(f32x16& sA, f32x16& sB, const float* bl, int hh) {
#pragma unroll
    for (int g = 0; g < 4; ++g) { const f32x4 va = *(const f32x4*)(bl + 8 * g + 4 * hh); const f32x4 vb = *(const f32x4*)(bl + 32 + 8 * g + 4 * hh);
#pragma unroll
        for (int r = 0; r < 4; ++r) { sA[4 * g + r] = va[r]; sB[4 * g + r] = vb[r]; } }
}
DEV void attn_softmax(f32x16& sA, f32x16& sB, float& m, float& l, f32x16& o0, f32x16& o1, bf16x8 (&pa)[4]) {
    float mx = sA[0];
#pragma unroll
    for (int i = 1; i < 16; ++i) mx = fmaxf(mx, sA[i]);
#pragma unroll
    for (int i = 0; i < 16; ++i) mx = fmaxf(mx, sB[i]);
    mx = xhalf_max(mx);
    float ms = m == NEG_BIG ? 0.f : m, alpha = 1.0f;
    if (__builtin_amdgcn_ballot_w64(mx > m + SM_THR)) {
        const float mn = fmaxf(m, mx); ms = mn == NEG_BIG ? 0.f : mn;
        alpha = __builtin_amdgcn_exp2f(m - ms); m = mn;
        o0 = o0 * alpha; o1 = o1 * alpha;
    }
    float ps = 0.f;
#pragma unroll
    for (int i = 0; i < 16; ++i) { sA[i] = __builtin_amdgcn_exp2f(sA[i] - ms); ps += sA[i]; }
#pragma unroll
    for (int i = 0; i < 16; ++i) { sB[i] = __builtin_amdgcn_exp2f(sB[i] - ms); ps += sB[i]; }
    l = l * alpha + ps;
    pa[0] = pack8(sA, 0); pa[1] = pack8(sA, 8); pa[2] = pack8(sB, 0); pa[3] = pack8(sB, 8);
}
template <int OFF> DEV s16x4 tr_read(unsigned addr) { s16x4 r; asm volatile("ds_read_b64_tr_b16 %0, %1 offset:%2" : "=&v"(r) : "v"(addr), "i"(OFF) : "memory"); return r; }
DEV void attn_pv(f32x16& o0, f32x16& o1, const unsigned char* vt, const AttnLane& a, const bf16x8 (&pa)[4]) {
    const unsigned vb = (unsigned)(size_t)(LDS3 const unsigned char*)vt + (unsigned)a.vofs;
#pragma unroll
    for (int dt = 0; dt < 2; ++dt) {
        const unsigned vd = vb ^ (unsigned)(dt << 6);
        const s16x4 l0 = tr_read<0>(vd), h0 = tr_read<1024>(vd), l1 = tr_read<2048>(vd), h1 = tr_read<3072>(vd), l2 = tr_read<4096>(vd), h2 = tr_read<5120>(vd), l3 = tr_read<6144>(vd), h3 = tr_read<7168>(vd);
        asm volatile("s_waitcnt lgkmcnt(0)" ::: "memory"); __builtin_amdgcn_sched_barrier(0);
#define PKV(L, H) (bf16x8){L[0], L[1], L[2], L[3], H[0], H[1], H[2], H[3]}
        f32x16& o = dt ? o1 : o0;
        o = __builtin_amdgcn_mfma_f32_32x32x16_bf16(PKV(l0, h0), pa[0], o, 0, 0, 0);
        o = __builtin_amdgcn_mfma_f32_32x32x16_bf16(PKV(l1, h1), pa[1], o, 0, 0, 0);
        o = __builtin_amdgcn_mfma_f32_32x32x16_bf16(PKV(l2, h2), pa[2], o, 0, 0, 0);
        o = __builtin_amdgcn_mfma_f32_32x32x16_bf16(PKV(l3, h3), pa[3], o, 0, 0, 0);
    }
}
DEV void attn_softmax_pv(f32x16& sA, f32x16& sB, float& m, float& l, f32x16& o0, f32x16& o1, const unsigned char* vt, const AttnLane& a) {
    float mx = sA[0];
#pragma unroll
    for (int i = 1; i < 16; ++i) mx = fmaxf(mx, sA[i]);
#pragma unroll
    for (int i = 0; i < 16; ++i) mx = fmaxf(mx, sB[i]);
    mx = xhalf_max(mx);
    float ms = m == NEG_BIG ? 0.f : m, alpha = 1.0f;
    if (__builtin_amdgcn_ballot_w64(mx > m + SM_THR)) {
        const float mn = fmaxf(m, mx); ms = mn == NEG_BIG ? 0.f : mn;
        alpha = __builtin_amdgcn_exp2f(m - ms); m = mn;
        o0 = o0 * alpha; o1 = o1 * alpha;
    }
    __builtin_amdgcn_sched_barrier(0);
    const unsigned vb = (unsigned)(size_t)(LDS3 const unsigned char*)vt + (unsigned)a.vofs, vd1 = vb ^ 64u;
    const s16x4 l0 = tr_read<0>(vb), h0 = tr_read<1024>(vb), l1 = tr_read<2048>(vb), h1 = tr_read<3072>(vb), l2 = tr_read<4096>(vb), h2 = tr_read<5120>(vb), l3 = tr_read<6144>(vb), h3 = tr_read<7168>(vb);
    __builtin_amdgcn_sched_barrier(0);
    float ps = 0.f;
#pragma unroll
    for (int i = 0; i < 16; ++i) { sA[i] = __builtin_amdgcn_exp2f(sA[i] - ms); ps += sA[i]; }
#pragma unroll
    for (int i = 0; i < 16; ++i) { sB[i] = __builtin_amdgcn_exp2f(sB[i] - ms); ps += sB[i]; }
    l = l * alpha + ps;
    const bf16x8 pa0 = pack8(sA, 0), pa1 = pack8(sA, 8), pa2 = pack8(sB, 0), pa3 = pack8(sB, 8);
    asm volatile("s_waitcnt lgkmcnt(0)" ::: "memory"); __builtin_amdgcn_sched_barrier(0);
    o0 = __builtin_amdgcn_mfma_f32_32x32x16_bf16(PKV(l0, h0), pa0, o0, 0, 0, 0);
    o0 = __builtin_amdgcn_mfma_f32_32x32x16_bf16(PKV(l1, h1), pa1, o0, 0, 0, 0);
    o0 = __builtin_amdgcn_mfma_f32_32x32x16_bf16(PKV(l2, h2), pa2, o0, 0, 0, 0);
    o0 = __builtin_amdgcn_mfma_f32_32x32x16_bf16(PKV(l3, h3), pa3, o0, 0, 0, 0);
    __builtin_amdgcn_sched_barrier(0);
    const s16x4 m0 = tr_read<0>(vd1), n0 = tr_read<1024>(vd1), m1 = tr_read<2048>(vd1), n1 = tr_read<3072>(vd1), m2 = tr_read<4096>(vd1), n2 = tr_read<5120>(vd1), m3 = tr_read<6144>(vd1), n3 = tr_read<7168>(vd1);
    asm volatile("s_waitcnt lgkmcnt(0)" ::: "memory"); __builtin_amdgcn_sched_barrier(0);
    o1 = __builtin_amdgcn_mfma_f32_32x32x16_bf16(PKV(m0, n0), pa0, o1, 0, 0, 0);
    o1 = __builtin_amdgcn_mfma_f32_32x32x16_bf16(PKV(m1, n1), pa1, o1, 0, 0, 0);
    o1 = __builtin_amdgcn_mfma_f32_32x32x16_bf16(PKV(m2, n2), pa2, o1, 0, 0, 0);
    o1 = __builtin_amdgcn_mfma_f32_32x32x16_bf16(PKV(m3, n3), pa3, o1, 0, 0, 0);
#undef PKV
}
DEV void glds16(const void* g, unsigned lds) { unsigned keep; lds = __builtin_amdgcn_readfirstlane(lds); asm volatile("s_mov_b32 %0, m0\n\ts_mov_b32 m0, %2\n\ts_nop 0\n\tglobal_load_lds_dwordx4 %1, off\n\ts_mov_b32 m0, %0" : "=&s"(keep) : "v"(g), "s"(lds) : "memory"); }
DEV void glds4(const void* g, unsigned lds) { unsigned keep; lds = __builtin_amdgcn_readfirstlane(lds); asm volatile("s_mov_b32 %0, m0\n\ts_mov_b32 m0, %2\n\ts_nop 0\n\tglobal_load_lds_dword %1, off\n\ts_mov_b32 m0, %0" : "=&s"(keep) : "v"(g), "s"(lds) : "memory"); }
DEV void kv_issue(const bf16* Kg, const bf16* Vg, int key0, unsigned sb  ) {
    const int t = threadIdx.x, lane = t & 63, w = __builtin_amdgcn_readfirstlane(t >> 6), row = 8 * w + (lane >> 3), p = lane & 7;
    const int ck = (p ^ ((row >> 1) & 7)) * 8, cv = (p ^ (((row >> 1) & 1) << 2)) * 8;
#pragma unroll
    for (int i = 0; i < 8 / NW + (8 % NW != 0); ++i) { if (NW > 8 && w >= 8) break; const size_t ro = (size_t)(key0 + row + 8 * NW * i) * 64;
        glds16(Kg + ro + ck, sb + AT_K + (w + NW * i) * 1024);
        glds16(Vg + ro + cv, sb + AT_V + (w + NW * i) * 1024); }
}
constexpr int KV_NVM = 2 * (8 / NW);
static_assert(8 % NW == 0, "K/V staging assumes the wave count divides 8");
template <int GB  , class KeyF, class BiasF, class NeedF, class ConsF>
DEV void stream_tiles(unsigned char* smem, const bf16* Kg, const bf16* Vg, const float* gbias, int ntiles, KeyF key0_of, BiasF bias_of, int brow, const AttnLane& al, const bf16x8 (&qf)[4], int hh, NeedF need, ConsF cons) {
    if (ntiles <= 0) return;
    const int t = threadIdx.x, lane = t & 63, w = __builtin_amdgcn_readfirstlane(t >> 6);
    auto issue = [&](int i) {
        const int k0 = key0_of(i); unsigned char* sb = smem + (i % 3) * AT_STAGE; const unsigned sba = (unsigned)(size_t)(LDS3 unsigned char*)smem + (unsigned)((i % 3) * AT_STAGE);
        kv_issue(Kg, Vg, k0, sba);
        if (GB) glds4(gbias + k0 + lane, sba + AT_B + w * 256);
        else if (t < 256) ((float*)(sb + AT_B))[t] = bias_of(k0, t);
    };
    auto qk = [&](int i, f32x16& sA, f32x16& sB) {
        if (need(i)) { const unsigned char* sb = smem + (i % 3) * AT_STAGE; attn_bias_init(sA, sB, (const float*)(sb + AT_B) + brow, hh); attn_qk(sA, sB, sb + AT_K, al, qf); }
        __builtin_amdgcn_sched_barrier(0);
    };
    auto sync_next = [&](int i) {
        asm volatile("s_waitcnt vmcnt(0)" ::: "memory"); asm volatile("s_waitcnt lgkmcnt(0)" ::: "memory");
        __builtin_amdgcn_s_barrier(); asm volatile("" ::: "memory");
        if (i + 2 < ntiles) issue(i + 2);
    };
    issue(0); if (ntiles > 1) issue(1);
    if (ntiles > 1) asm volatile("s_waitcnt vmcnt(%0)" :: "n"(KV_NVM + GB) : "memory"); else asm volatile("s_waitcnt vmcnt(0)" ::: "memory");
    asm volatile("s_waitcnt lgkmcnt(0)" ::: "memory");
    __builtin_amdgcn_s_barrier(); asm volatile("" ::: "memory");
    f32x16 a0, b0, a1, b1;
    qk(0, a0, b0);
    for (int i = 0; i < ntiles; i += 2) {
        if (i + 1 < ntiles) { sync_next(i); qk(i + 1, a1, b1); }
        if (need(i)) cons(i, smem + (i % 3) * AT_STAGE, a0, b0);
        if (i + 1 < ntiles) {
            if (i + 2 < ntiles) { sync_next(i + 1); qk(i + 2, a0, b0); }
            if (need(i + 1)) cons(i + 1, smem + ((i + 1) % 3) * AT_STAGE, a1, b1);
        }
    }
    asm volatile("s_waitcnt lgkmcnt(0)" ::: "memory");
    __builtin_amdgcn_s_barrier();
    asm volatile("" ::: "memory");
}
DEV int fx_nch(int qb) { return ((FX_ROWS / 64) * (qb + 1) + FX_CH - 1) / FX_CH; }
DEV int fx_part_index(int bh, int qb, int c) {
    const int off = qb < 2 * FX_QQ ? (qb - FX_QQ) * 2 : (qb < 3 * FX_QQ ? 2 * FX_QQ + (qb - 2 * FX_QQ) * 3 : 5 * FX_QQ + (qb - 3 * FX_QQ) * 4);
    return bh * FX_PART_PER_BH + off + c;
}
DEV unsigned char* fx_part_ptr(const Params& p, int pi) { return (size_t)pi < FX_P1 ? (unsigned char*)p.out + (size_t)T_ * 1024 * 2 + (size_t)pi * FX_PART_BYTES : p.ws + OFF_FXPART + ((size_t)pi - FX_P1) * FX_PART_BYTES; }
DEV void fox_unit(const Params& p, unsigned char* smem, int bh, int qb, int c) {
    unsigned char* ws = p.ws; int t = threadIdx.x; asm volatile("" : "+v"(t)); asm volatile("" : "+v"(ws));
    const int lane = t & 63, w = t >> 6, r = lane & 31, hh = lane >> 5;
    const bf16* Kg = (const bf16*)(ws + OFF_FK) + (size_t)bh * S_ * 64; const bf16* Vg = (const bf16*)(ws + OFF_FV) + (size_t)bh * S_ * 64; const float* cum = (const float*)(ws + OFF_CUM) + (size_t)bh * S_;
    const int q0 = qb * FX_ROWS, qw0 = q0 + 32 * w, q = qw0 + r;
    const int ntiles = (q0 + FX_ROWS) / 64;
    int* kts = (int*)(smem + LDS_TILE_BYTES + 16);
    if (t == 0) kts[0] = ntiles - 1;
    __syncthreads();
    { const float cref = cum[q0], thr = -(160.0f + 2.0f * ((const float*)(ws + OFF_CTL))[CTL_QKB]); if (t < ntiles && cum[t * 64 + 63] - cref >= thr) atomicMin(kts, t); }
    __syncthreads();
    const int kt0 = kts[0], cfirst = kt0 / FX_CH, nch = fx_nch(qb);
    const int lo = c * FX_CH > kt0 ? c * FX_CH : kt0, hi = (c + 1) * FX_CH < ntiles ? (c + 1) * FX_CH : ntiles;
    if (c == nch - 1 && t == 0) st_dev((float*)(ws + OFF_FXINFO) + bh * FX_NQB + qb, __builtin_bit_cast(float, cfirst));
    if (lo >= hi) return;
    const AttnLane al = attn_lane_setup(lane);
    bf16x8 qf[4]; { const bf16* qrow = (const bf16*)(ws + OFF_FQ) + ((size_t)bh * S_ + q) * 64 + 8 * hh;
#pragma unroll
        for (int s = 0; s < 4; ++s) qf[s] = *(const bf16x8*)(qrow + 16 * s); }
    asm volatile("" :: "v"(qf[0]), "v"(qf[1]), "v"(qf[2]), "v"(qf[3]));
    f32x16 o0, o1;
#pragma unroll
    for (int i = 0; i < 16; ++i) { o0[i] = 0.f; o1[i] = 0.f; }
    float m = NEG_BIG, l = 0.f;
    stream_tiles<1>(smem, Kg, Vg, cum, hi - lo, [&](int i) { return (lo + i) * 64; }, [&](int k0, int tt) { return 0.f; }, w * 64, al, qf, hh,
        [&](int i) { return (lo + i) * 64 <= qw0 + 31; },
        [&](int i, const unsigned char* sb, f32x16& sA, f32x16& sB) {
            const int kt = lo + i;
            if (kt * 64 + 63 > qw0) {
#pragma unroll
                for (int e = 0; e < 16; ++e) { const int key = kt * 64 + (e & 3) + 8 * (e >> 2) + 4 * hh; if (key > q) sA[e] = NEG_BIG; if (key + 32 > q) sB[e] = NEG_BIG; }
            }
            attn_softmax_pv(sA, sB, m, l, o0, o1, sb + AT_V, al);
        });
    const float lt = xhalf_sum(l);
    if (nch - cfirst == 1) {
        const float il = 1.0f / lt;
        bf16* orow = ao_row(p, 0, bh / 8, q) + (bh % 8) * 64 + 4 * hh;
#pragma unroll
        for (int g = 0; g < 4; ++g) {
            st_dev(orow + 8 * g, (u32x2){pk_bf16(o0[4 * g] * il, o0[4 * g + 1] * il), pk_bf16(o0[4 * g + 2] * il, o0[4 * g + 3] * il)});
            st_dev(orow + 32 + 8 * g, (u32x2){pk_bf16(o1[4 * g] * il, o1[4 * g + 1] * il), pk_bf16(o1[4 * g + 2] * il, o1[4 * g + 3] * il)}); }
    } else {
        unsigned char* pp = fx_part_ptr(p, fx_part_index(bh, qb, c)); bf16* orow = (bf16*)pp + (size_t)(32 * w + r) * 64 + 4 * hh;
#pragma unroll
        for (int g = 0; g < 4; ++g) {
            st_dev(orow + 8 * g, (u32x2){pk_bf16(o0[4 * g], o0[4 * g + 1]), pk_bf16(o0[4 * g + 2], o0[4 * g + 3])});
            st_dev(orow + 32 + 8 * g, (u32x2){pk_bf16(o1[4 * g], o1[4 * g + 1]), pk_bf16(o1[4 * g + 2], o1[4 * g + 3])}); }
        if (hh == 0) { float* ml = (float*)(pp + FX_ROWS * 64 * 2); st_dev(ml + 32 * w + r, m); st_dev(ml + FX_ROWS + 32 * w + r, lt); }
    }
}
DEV void fox_merge(const Params& p, int bh, int qb) {
    unsigned char* ws = p.ws; asm volatile("" : "+v"(ws)); const int t = threadIdx.x, row = t >> 1, half = t & 1;
    const int cfirst = ((const int*)(ws + OFF_FXINFO))[bh * FX_NQB + qb], nch = fx_nch(qb);
    if (nch - cfirst < 2) return;
    float mt = NEG_BIG;
    for (int c = cfirst; c < nch; ++c) mt = fmaxf(mt, ((const float*)(fx_part_ptr(p, fx_part_index(bh, qb, c)) + FX_ROWS * 64 * 2))[row]);
    float acc[32], lt = 0.f;
#pragma unroll
    for (int i = 0; i < 32; ++i) acc[i] = 0.f;
    for (int c = cfirst; c < nch; ++c) {
        const unsigned char* pp = fx_part_ptr(p, fx_part_index(bh, qb, c)); const float* ml = (const float*)(pp + FX_ROWS * 64 * 2);
        const float mc = ml[row]; if (mc == NEG_BIG) continue;
        const float sc = __builtin_amdgcn_exp2f(mc - mt); lt += sc * ml[FX_ROWS + row];
        const u32x4* src = (const u32x4*)((const bf16*)pp + (size_t)row * 64 + 32 * half);
#pragma unroll
        for (int k = 0; k < 4; ++k) { const u32x4 v = src[k];
            acc[8 * k + 0] += sc * u2f(v.x << 16); acc[8 * k + 1] += sc * u2f(v.x & 0xffff0000u); acc[8 * k + 2] += sc * u2f(v.y << 16); acc[8 * k + 3] += sc * u2f(v.y & 0xffff0000u);
            acc[8 * k + 4] += sc * u2f(v.z << 16); acc[8 * k + 5] += sc * u2f(v.z & 0xffff0000u); acc[8 * k + 6] += sc * u2f(v.w << 16); acc[8 * k + 7] += sc * u2f(v.w & 0xffff0000u); }
    }
    const float il = 1.0f / lt;
    bf16* orow = ao_row(p, 0, bh / 8, qb * FX_ROWS + row) + (bh % 8) * 64 + 32 * half;
#pragma unroll
    for (int k = 0; k < 4; ++k) { st_dev(orow + 8 * k, (u32x2){pk_bf16(acc[8 * k] * il, acc[8 * k + 1] * il), pk_bf16(acc[8 * k + 2] * il, acc[8 * k + 3] * il)}); st_dev(orow + 8 * k + 4, (u32x2){pk_bf16(acc[8 * k + 4] * il, acc[8 * k + 5] * il), pk_bf16(acc[8 * k + 6] * il, acc[8 * k + 7] * il)}); }
}
constexpr int NSQ = 8 * NW;
constexpr int NS_IMP = 3 * AT_STAGE, NS_SEL = NS_IMP + NSQ * 128 * 4, NS_UNI = NS_SEL + NSQ * 16, NS_WUNI = NS_UNI + 16, NS_CNT = NS_WUNI + NW * 16, NS_LIST = NS_CNT + 16, NS_END = NS_LIST + 128;
static_assert(NS_END <= LDS_TILE_BYTES && NSLC <= 128, "NSA LDS map");
DEV void nsa_item(const Params& p, unsigned char* smem, int bg, int qb) {
    unsigned char* ws = p.ws; int t = threadIdx.x; asm volatile("" : "+v"(t)); asm volatile("" : "+v"(ws));
    const int lane = t & 63, w = t >> 6, r = lane & 31, hh = lane >> 5;
    const int b = bg / 2, g = bg % 2, q0 = qb * NSQ, hl = r >> 3, head = g * 4 + hl, qi = 8 * w + (r & 7), qpos = q0 + qi, qblk = qpos >> 6;
    const AttnLane al = attn_lane_setup(lane);
    bf16x8 qf[4]; { const bf16* qrow = (const bf16*)(ws + OFF_NQ) + (((size_t)b * 8 + head) * S_ + qpos) * 64 + 8 * hh;
#pragma unroll
        for (int s = 0; s < 4; ++s) qf[s] = *(const bf16x8*)(qrow + 16 * s); }
    asm volatile("" :: "v"(qf[0]), "v"(qf[1]), "v"(qf[2]), "v"(qf[3]));
    float* imp = (float*)(smem + NS_IMP); unsigned* selw = (unsigned*)(smem + NS_SEL); unsigned* uni = (unsigned*)(smem + NS_UNI); unsigned* wuni = (unsigned*)(smem + NS_WUNI);
    int* lcnt = (int*)(smem + NS_CNT); unsigned char* blist = smem + NS_LIST;
    for (int i = t; i < NSQ * 128; i += NTHREADS) imp[i] = 0.f;
    if (t < 4) uni[t] = 0u; if (t < 4 * NW) wuni[t] = 0u;
    __syncthreads();
    float gate[3]; { const float* gp = (const float*)(ws + OFF_GATE) + ((size_t)b * S_ + qpos) * 24 + head * 3; gate[0] = gp[0]; gate[1] = gp[1]; gate[2] = gp[2]; }
    asm volatile("" :: "v"(gate[0]), "v"(gate[1]), "v"(gate[2]));
    const float sl_t = alibi_slope2(g * 4 + ((t >> 6) & 3));
    int dead_dist; { const float dd = (160.0f + 2.0f * ((const float*)(ws + OFF_CTL))[CTL_QKB + 1]) / alibi_slope2(g * 4 + 3); dead_dist = dd < (float)S_ ? (int)dd + 1 : S_; }
    f32x16 tot0, tot1, o0, o1;
#pragma unroll
    for (int i = 0; i < 16; ++i) { tot0[i] = 0.f; tot1[i] = 0.f; o0[i] = 0.f; o1[i] = 0.f; }
    {
        const bf16* Kg = (const bf16*)(ws + OFF_KCMP) + (size_t)bg * NCMPP * 64; const bf16* Vg = (const bf16*)(ws + OFF_VCMP) + (size_t)bg * NCMPP * 64;
        const int ncmp = (q0 + NSQ - 32) / 16 + 1, ntl_all = (ncmp + 63) / 64;
        const int tc0 = dead_dist >= S_ ? 0 : (((q0 - 31 - dead_dist - 16) / 16 + 1) > 0 ? ((q0 - 31 - dead_dist - 16) / 16 + 1) / 64 : 0);
        const int ntl = ntl_all - tc0;
        auto key0_of = [&](int i) { return (tc0 + i) * 64; };
        auto bias_of = [&](int k0, int tt) { return sl_t * (float)(16 * (k0 + (tt & 63)) + 31 - q0); };
        float m = NEG_BIG, l = 0.f;
        auto cmask = [&](int i, f32x16& sA, f32x16& sB) {
#pragma unroll
            for (int e = 0; e < 16; ++e) { const int n = (tc0 + i) * 64 + (e & 3) + 8 * (e >> 2) + 4 * hh; if (16 * n + 31 > qpos) sA[e] = NEG_BIG; if (16 * (n + 32) + 31 > qpos) sB[e] = NEG_BIG; }
        };
        auto always = [&](int) { return true; };
        stream_tiles<0>(smem, Kg, Vg, nullptr, ntl, key0_of, bias_of, hl * 64, al, qf, hh, always, [&](int i, const unsigned char* sb, f32x16& sA, f32x16& sB) {
            cmask(i, sA, sB);
            float mx = sA[0];
#pragma unroll
            for (int e = 1; e < 16; ++e) mx = fmaxf(mx, sA[e]);
#pragma unroll
            for (int e = 0; e < 16; ++e) mx = fmaxf(mx, sB[e]);
            mx = xhalf_max(mx);
            const float mn = fmaxf(m, mx), ms = mn == NEG_BIG ? 0.f : mn; float ps = 0.f;
#pragma unroll
            for (int e = 0; e < 16; ++e) ps += __builtin_amdgcn_exp2f(sA[e] - ms) + __builtin_amdgcn_exp2f(sB[e] - ms);
            l = l * __builtin_amdgcn_exp2f(m - ms) + ps; m = mn;
        });
        const float lt = xhalf_sum(l), il = lt > 0.f ? 1.0f / lt : 0.f, ms = m == NEG_BIG ? 0.f : m;
        stream_tiles<0>(smem, Kg, Vg, nullptr, ntl, key0_of, bias_of, hl * 64, al, qf, hh, always, [&](int i, const unsigned char* sb, f32x16& sA, f32x16& sB) {
            cmask(i, sA, sB);
#pragma unroll
            for (int e = 0; e < 16; ++e) { sA[e] = __builtin_amdgcn_exp2f(sA[e] - ms) * il; sB[e] = __builtin_amdgcn_exp2f(sB[e] - ms) * il; }
            bf16x8 pa[4] = {pack8(sA, 0), pack8(sA, 8), pack8(sB, 0), pack8(sB, 8)};
            __builtin_amdgcn_sched_barrier(0);
            attn_pv(o0, o1, sb + AT_V, al, pa);
            __builtin_amdgcn_sched_barrier(0);
#pragma unroll
            for (int blk = 0; blk < 2; ++blk)
#pragma unroll
                for (int gq = 0; gq < 4; ++gq) {
                    const f32x16& sp = blk ? sB : sA;
                    float sp3 = 0.5f * sp[4 * gq + 3], mainv = (sp[4 * gq] + sp[4 * gq + 1]) + (sp[4 * gq + 2] + sp3);
                    mainv += __shfl_xor(mainv, 8); mainv += __shfl_xor(mainv, 16); sp3 += __shfl_xor(sp3, 8); sp3 += __shfl_xor(sp3, 16);
                    const int j = (tc0 + i) * 16 + 8 * blk + 2 * gq + hh;
                    if (hl == 0 && j < NSLC) { atomicAdd(imp + qi * 128 + j, mainv); if (j + 1 < NSLC) atomicAdd(imp + qi * 128 + j + 1, sp3); }
                }
        });
        const float g0 = gate[0];
        tot0 = o0 * g0; tot1 = o1 * g0;
    }
    {
        const int part = lane & 7, ql = lane >> 3, qp = q0 + 8 * w + ql, qb64 = qp >> 6; const float* irow = imp + (8 * w + ql) * 128 + part * 16;
        float v[16];
#pragma unroll
        for (int e = 0; e < 16; ++e) { const int j = part * 16 + e; v[e] = (j >= NSLC || j > qb64) ? -1.0f : ((j == 0 || j == qb64 || j == qb64 - 1) ? 1e4f : irow[e]); }
        unsigned mk[4] = {0u, 0u, 0u, 0u};
        if (__builtin_amdgcn_ballot_w64(qb64 >= TOPN)) {
            for (int it = 0; it < TOPN; ++it) {
                float bv = v[0]; int bj = part * 16;
#pragma unroll
                for (int e = 1; e < 16; ++e) if (v[e] > bv) { bv = v[e]; bj = part * 16 + e; }
#pragma unroll
                for (int off = 1; off < 8; off <<= 1) { const float ov = __shfl_xor(bv, off); const int oj = __shfl_xor(bj, off); if (ov > bv || (ov == bv && oj < bj)) { bv = ov; bj = oj; } }
#pragma unroll
                for (int e = 0; e < 16; ++e) if (part * 16 + e == bj) v[e] = -2.0f;
                if (bj <= qb64) {
#pragma unroll
                    for (int k = 0; k < 4; ++k) mk[k] |= (bj >> 5) == k ? (1u << (bj & 31)) : 0u; }
            }
        } else {
#pragma unroll
            for (int k = 0; k < 4; ++k) { const int hi = qb64 - 32 * k; mk[k] = hi >= 31 ? 0xffffffffu : (hi < 0 ? 0u : ((2u << hi) - 1u)); }
        }
        if (part == 0) {
#pragma unroll
            for (int k = 0; k < 4; ++k) { selw[(8 * w + ql) * 4 + k] = mk[k]; atomicOr(uni + k, mk[k]); atomicOr(wuni + w * 4 + k, mk[k]); } }
    }
    unsigned char* park = smem + NS_IMP + w * 4096 + r * 128 + 8 * hh;
#pragma unroll
    for (int gq = 0; gq < 4; ++gq) {
        *(u32x2*)(park + 16 * gq) = (u32x2){pk_bf16(tot0[4 * gq], tot0[4 * gq + 1]), pk_bf16(tot0[4 * gq + 2], tot0[4 * gq + 3])};
        *(u32x2*)(park + 64 + 16 * gq) = (u32x2){pk_bf16(tot1[4 * gq], tot1[4 * gq + 1]), pk_bf16(tot1[4 * gq + 2], tot1[4 * gq + 3])}; }
    __syncthreads();
    {
        bool on = false; int below = 0; int* wcnt = lcnt + 1;
        if (t < 128) {
            const bool live = q0 - (64 * t + 63) <= dead_dist;
            on = t < NSLC && live && ((uni[t >> 5] >> (t & 31)) & 1u); const unsigned long long bal = __builtin_amdgcn_ballot_w64(on);
            below = __builtin_popcountll(bal & ((1ull << lane) - 1ull)); if (lane == 0) wcnt[t >> 6] = __builtin_popcountll(bal);
        }
        __syncthreads();
        if (on) blist[(t >= 64 ? wcnt[0] : 0) + below] = (unsigned char)t;
        if (t == 0) lcnt[0] = wcnt[0] + wcnt[1];
    }
    __syncthreads();
    {
        const bf16* Kg = (const bf16*)(ws + OFF_KS) + (size_t)bg * S_ * 64; const bf16* Vg = (const bf16*)(ws + OFF_VS) + (size_t)bg * S_ * 64;
        const int ntl = lcnt[0];
#pragma unroll
        for (int i = 0; i < 16; ++i) { o0[i] = 0.f; o1[i] = 0.f; }
        float m = NEG_BIG, l = 0.f;
        stream_tiles<0>(smem, Kg, Vg, nullptr, ntl, [&](int i) { return (int)blist[i] * 64; }, [&](int k0, int tt) { return sl_t * (float)(k0 + (tt & 63) - q0); }, hl * 64, al, qf, hh,
            [&](int i) { const int jb = blist[i]; return (bool)((wuni[w * 4 + (jb >> 5)] >> (jb & 31)) & 1u); },
            [&](int i, const unsigned char* sb, f32x16& sA, f32x16& sB) {
                const int jb = blist[i];
                const bool mine = (selw[qi * 4 + (jb >> 5)] >> (jb & 31)) & 1u;
#pragma unroll
                for (int e = 0; e < 16; ++e) { const int kp = jb * 64 + (e & 3) + 8 * (e >> 2) + 4 * hh; if (!mine || kp > qpos) sA[e] = NEG_BIG; if (!mine || kp + 32 > qpos) sB[e] = NEG_BIG; }
                attn_softmax_pv(sA, sB, m, l, o0, o1, sb + AT_V, al);
            });
        const float gl = gate[1] / xhalf_sum(l);
#pragma unroll
        for (int gq = 0; gq < 4; ++gq) {
            const u32x2 a = *(const u32x2*)(park + 16 * gq), bq = *(const u32x2*)(park + 64 + 16 * gq);
            *(u32x2*)(park + 16 * gq) = (u32x2){pk_bf16(u2f(a.x << 16) + o0[4 * gq] * gl, u2f(a.x & 0xffff0000u) + o0[4 * gq + 1] * gl), pk_bf16(u2f(a.y << 16) + o0[4 * gq + 2] * gl, u2f(a.y & 0xffff0000u) + o0[4 * gq + 3] * gl)};
            *(u32x2*)(park + 64 + 16 * gq) = (u32x2){pk_bf16(u2f(bq.x << 16) + o1[4 * gq] * gl, u2f(bq.x & 0xffff0000u) + o1[4 * gq + 1] * gl), pk_bf16(u2f(bq.y << 16) + o1[4 * gq + 2] * gl, u2f(bq.y & 0xffff0000u) + o1[4 * gq + 3] * gl)}; }
    }
    {
        const bf16* Kg = (const bf16*)(ws + OFF_KW) + (size_t)bg * S_ * 64; const bf16* Vg = (const bf16*)(ws + OFF_VW) + (size_t)bg * S_ * 64;
        const int klo = q0 - 511 > 0 ? q0 - 511 : 0, t_lo = klo / 64, t_hi = (q0 + NSQ - 1) / 64;
#pragma unroll
        for (int i = 0; i < 16; ++i) { o0[i] = 0.f; o1[i] = 0.f; }
        float m = NEG_BIG, l = 0.f;
        stream_tiles<0>(smem, Kg, Vg, nullptr, t_hi - t_lo + 1, [&](int i) { return (t_lo + i) * 64; }, [&](int k0, int tt) { return sl_t * (float)(k0 + (tt & 63) - q0); }, hl * 64, al, qf, hh,
            [&](int) { return true; },
            [&](int i, const unsigned char* sb, f32x16& sA, f32x16& sB) {
                const int k0 = (t_lo + i) * 64;
                if (k0 + 63 > q0 + 8 * w || k0 < q0 + 8 * w + 7 - 511) {
#pragma unroll
                    for (int e = 0; e < 16; ++e) { const int kp = k0 + (e & 3) + 8 * (e >> 2) + 4 * hh; if (kp > qpos || kp < qpos - 511) sA[e] = NEG_BIG; if (kp + 32 > qpos || kp + 32 < qpos - 511) sB[e] = NEG_BIG; }
                }
                attn_softmax_pv(sA, sB, m, l, o0, o1, sb + AT_V, al);
            });
        const float gl = gate[2] / xhalf_sum(l);
        int qpos2 = qpos; asm volatile("" : "+v"(qpos2));
        bf16* orow = ao_row(p, 1, b, qpos2) + head * 64 + 4 * hh;
#pragma unroll
        for (int gq = 0; gq < 4; ++gq) {
            const u32x2 a = *(const u32x2*)(park + 16 * gq), bq = *(const u32x2*)(park + 64 + 16 * gq);
            st_dev(orow + 8 * gq, (u32x2){pk_bf16(u2f(a.x << 16) + o0[4 * gq] * gl, u2f(a.x & 0xffff0000u) + o0[4 * gq + 1] * gl), pk_bf16(u2f(a.y << 16) + o0[4 * gq + 2] * gl, u2f(a.y & 0xffff0000u) + o0[4 * gq + 3] * gl)});
            st_dev(orow + 32 + 8 * gq, (u32x2){pk_bf16(u2f(bq.x << 16) + o1[4 * gq] * gl, u2f(bq.x & 0xffff0000u) + o1[4 * gq + 1] * gl), pk_bf16(u2f(bq.y << 16) + o1[4 * gq + 2] * gl, u2f(bq.y & 0xffff0000u) + o1[4 * gq + 3] * gl)}); }
    }
}
#define XB_TMO      128
#define XB_XCNT(j)  (256  + 64 * (j))
#define XB_XSUB(j)  (1280 + 64 * (j))
#define XB_XGEN(j)  (2304 + 64 * (j))
#define XB_TOP      3328
#define XB_TOPGEN   3392
#define XB_SPIN_CAP (1u << 20)
DEV unsigned xb_ld(unsigned* p) { return __hip_atomic_load(p, __ATOMIC_RELAXED, __HIP_MEMORY_SCOPE_AGENT); }
DEV unsigned xb_add(unsigned* p, unsigned v) { return __hip_atomic_fetch_add(p, v, __ATOMIC_RELAXED, __HIP_MEMORY_SCOPE_AGENT); }
DEV unsigned xb_xcc_id() { return (unsigned)__builtin_amdgcn_s_getreg((3 << 11) | 20) & 0xFu; }
#define XB_SPIN(cond, bar) do { unsigned _sp = 0; while (cond) { __builtin_amdgcn_s_sleep(1); \
    if ((++_sp & 255u) == 0u) { if (xb_ld(&(bar)[XB_TMO])) break; if (_sp > XB_SPIN_CAP) { atomicAdd(&(bar)[XB_TMO], 1u); break; } } } } while (0)
struct XcdBarrier { unsigned* bar; unsigned x; volatile unsigned* st; };
DEV XcdBarrier xcd_barrier_post(unsigned* bar, volatile unsigned* st) { XcdBarrier b; b.bar = bar; b.x = xb_xcc_id(); b.st = st; if (threadIdx.x == 0) (void)xb_add(&bar[XB_XCNT(b.x)], 1u); return b; }
DEV void xcd_barrier_complete(unsigned* bar, unsigned x, unsigned& nloc, unsigned& nx) {
    const unsigned G = gridDim.x; unsigned sum, cnt, mine, sp = 0u;
    for (;;) {
        sum = 0u; cnt = 0u; mine = 0u;
#pragma unroll
        for (unsigned j = 0; j < 16; ++j) { const unsigned c = xb_ld(&bar[XB_XCNT(j)]); sum += c; cnt += (c > 0u) ? 1u : 0u; mine = (j == x) ? c : mine; }
        if (sum == G) break;
        __builtin_amdgcn_s_sleep(1);
        if ((++sp & 255u) == 0u) { if (xb_ld(&bar[XB_TMO])) break; if (sp > XB_SPIN_CAP) { atomicAdd(&bar[XB_TMO], 1u); break; } }
    }
    nloc = mine > 0u ? mine : 1u; nx = cnt > 0u ? cnt : 1u;
}
DEV void xcd_barrier(const XcdBarrier& b) {
    asm volatile("s_waitcnt vmcnt(0)" ::: "memory");
    __syncthreads();
    if (threadIdx.x == 0) {
        unsigned* bar = b.bar;
        __builtin_amdgcn_s_waitcnt(0);
        unsigned nloc = b.st[0], nx = b.st[1];
        if (nloc == 0u) { xcd_barrier_complete(bar, b.x, nloc, nx); b.st[0] = nloc; b.st[1] = nx; }
        const unsigned old = xb_add(&bar[XB_XSUB(b.x)], 1u);
        const unsigned gen = old / nloc;
        if (old + 1u == (gen + 1u) * nloc) {
            __builtin_amdgcn_fence(__ATOMIC_RELEASE, "agent");
            asm volatile("s_waitcnt vmcnt(0)" ::: "memory");
            const unsigned og = xb_add(&bar[XB_TOP], 1u);
            const unsigned tg = og / nx;
            if (og + 1u == (tg + 1u) * nx) xb_add(&bar[XB_TOPGEN], 1u);
            else XB_SPIN(xb_ld(&bar[XB_TOPGEN]) == tg, bar);
            __builtin_amdgcn_fence(__ATOMIC_ACQUIRE, "agent");
            xb_add(&bar[XB_XGEN(b.x)], 1u);
            asm volatile("s_waitcnt vmcnt(0)" ::: "memory");
        } else {
            XB_SPIN(xb_ld(&bar[XB_XGEN(b.x)]) == gen, bar);
            __builtin_amdgcn_fence(__ATOMIC_ACQUIRE, "agent");
            asm volatile("s_waitcnt vmcnt(0)" ::: "memory");
        }
    }
    __syncthreads();
}

constexpr int CTL_DEP = 320;
DEV void dep_post(unsigned* ctr, bool wb) {
    asm volatile("s_waitcnt vmcnt(0)" ::: "memory"); __syncthreads();
    if (threadIdx.x == 0) { if (wb) { __builtin_amdgcn_fence(__ATOMIC_RELEASE, "agent"); asm volatile("s_waitcnt vmcnt(0)" ::: "memory"); } (void)xb_add(ctr, 1u); }
}
DEV bool dep_post_last(unsigned* ctr, unsigned target, int* slot) {
    asm volatile("s_waitcnt vmcnt(0)" ::: "memory"); __syncthreads();
    if (threadIdx.x == 0) slot[1] = (xb_add(ctr, 1u) + 1u == target) ? 1 : 0;
    __syncthreads();
    return slot[1] != 0;
}
DEV void dep_wait(unsigned* ctr, unsigned target, unsigned* bar, bool acq) {
    if (threadIdx.x == 0) { XB_SPIN(xb_ld(ctr) < target, bar); if (acq) __builtin_amdgcn_fence(__ATOMIC_ACQUIRE, "agent"); asm volatile("s_waitcnt vmcnt(0)" ::: "memory"); }
    __syncthreads();
}
constexpr int CTL_UPQ = 4608, CTL_ROWDONE = 11264, CTL_UPDONE = 13312, CTL_OUTDONE = 5120, RDST = 16, NCPI = (NJOB2 + NW - 1) / NW;
DEV void bphase_attn(const Params& p, unsigned char* smem) {
    constexpr int NBH = B_ * 8, QQ = FX_QQ, NU = NBH * QQ * (4 + 3 + 2 + 1), NQB = S_ / (8 * NW), NITEM = B_ * 2 * NQB, NMERGE = B_ * 8 * (FX_NQB - FX_QQ), NH1 = NITEM / 2;
    static_assert(NSQ * 4 == BM && B_ == 2 && (S_ / BM) * B_ == 128, "row-block bookkeeping");
    unsigned* ctl = (unsigned*)(p.ws + OFF_CTL); unsigned* head = ctl + CTL_FOXQ; int* slot = (int*)(smem + LDS_BYTES - 16);
    int stage = 0;
    for (;;) {
        if (threadIdx.x == 0) slot[0] = (int)atomicAdd(head, 1u);
        __syncthreads();
        const int idx = slot[0];
        __syncthreads();
        if (idx >= NU && stage == 0) { dep_post(ctl + CTL_DEP + 64, false); dep_wait(ctl + CTL_DEP, gridDim.x, ctl + CTL_BAR, true); stage = 1; }
        if (idx >= NU + NITEM + NMERGE + NCPI) break;
        if (idx < NU) {
            int u = idx, grp = 0; while (u >= NBH * QQ * (4 - grp)) { u -= NBH * QQ * (4 - grp); ++grp; }
            const int nc = 4 - grp, per = NBH * nc, qb = (3 - grp) * QQ + QQ - 1 - u / per, rr = u % per, c = rr / NBH, j = rr % NBH, h = 7 - j / B_, b = j % B_;
            fox_unit(p, smem, b * 8 + h, qb, c);
            continue;
        }
        const int a = idx - NU;
        if (a >= NH1 + NMERGE && a < NH1 + NMERGE + NCPI) {
            const int jj = (a - NH1 - NMERGE) * NW + (int)(threadIdx.x >> 6);
            if (jj < NJOB2) prep_job(p, 2, __builtin_amdgcn_readfirstlane(jj));
        } else if (a >= NH1 && a < NH1 + NMERGE) {
            if (stage == 1) { dep_wait(ctl + CTL_DEP + 64, gridDim.x, ctl + CTL_BAR, true); stage = 2; }
            const int im = a - NH1;
            fox_merge(p, im % (B_ * 8), FX_QQ + im / (B_ * 8));
            dep_post(ctl + CTL_DEP + 128, false);
        } else {
            const int it = a < NH1 ? a : a - NMERGE - NCPI, bg = it % (B_ * 2), qb = NQB - 1 - it / (B_ * 2);
            nsa_item(p, smem, bg, qb);
            dep_post(ctl + CTL_ROWDONE + RDST * ((bg / 2) * (S_ / BM) + qb / 4), false);
        }
    }
    const unsigned x = xb_xcc_id() & 7u; bool first = true, first2 = true;
    for (unsigned s8 = 0; s8 < 8; ++s8) {
        const unsigned xq = (x + s8) & 7u; unsigned* qh = ctl + CTL_UPQ + 64 * xq;
        for (;;) {
            if (threadIdx.x == 0) slot[0] = (int)atomicAdd(qh, 1u);
            __syncthreads();
            const int n = slot[0];
            __syncthreads();
            if (n >= 256) break;
            const int j = ((n & 127) >> 3) * 8 + (int)xq, R = (j & 1) * (S_ / BM) + (S_ / BM - 1 - (j >> 1));
            if (n < 128) {
                if (first) { dep_wait(ctl + CTL_DEP + 64, gridDim.x, ctl + CTL_BAR, false); dep_wait(ctl + CTL_DEP + 128, NMERGE, ctl + CTL_BAR, false); }
                dep_wait(ctl + CTL_ROWDONE + RDST * R, 8, ctl + CTL_BAR, first); first = false;
                up_tile(p, smem, R, n & 7);
                dep_post(ctl + CTL_UPDONE + RDST * R, false);
            } else {
                if (R < S_ / BM) dep_wait(ctl + CTL_UPDONE + RDST * (R + S_ / BM), 8, ctl + CTL_BAR, false);
                dep_wait(ctl + CTL_UPDONE + RDST * R, 8, ctl + CTL_BAR, first2); first2 = false;
                out_tile(p, smem, R, n & 7);
                if (dep_post_last(ctl + CTL_OUTDONE + RDST * R, 8u, slot)) route_item(p, smem, R);
            }
        }
    }
}

DEV void bphase_prep(const Params& p, unsigned char* smem, int stage, int skip) {
    unsigned char* ws = p.ws; const int t = threadIdx.x, lane = t & 63, w = t >> 6;
    const int G = gridDim.x, nj = stage ? NJOB1 : NJOB0, first = stage ? (vblock() + G - (skip % G)) % G : (int)blockIdx.x;
    for (int it = first * NW + w; it < nj; it += G * NW) prep_job(p, stage, __builtin_amdgcn_readfirstlane(it));
    if (stage) return;
    for (int i = blockIdx.x * NTHREADS + t; i < D_ * 20; i += gridDim.x * NTHREADS) { const int k = i / 20, j = i % 20; ((float*)(ws + OFF_BW))[i] = p.norm_ffn_g[k] * (j < 16 ? p.w_router[(size_t)k * 16 + j] : p.w_group[(size_t)k * 4 + (j - 16)]); }
    for (int i = blockIdx.x * NTHREADS + t; i < 2 * 64 * 256 / 8; i += gridDim.x * NTHREADS) { const int kv = i / (64 * 256 / 8), rr = i % (64 * 256 / 8); *(u32x4*)((bf16*)(ws + OFF_W2T) + (size_t)kv * 128 * 256 + 64 * 256 + rr * 8) = (u32x4){0u, 0u, 0u, 0u}; }
    if (blockIdx.x == 8 && t < 2) {
        const float* gq = t ? p.nsa_q_g : p.fox_q_g; const float* gk = t ? p.nsa_k_g : p.fox_k_g; float a = 0.f, bq = 0.f;
        for (int i = 0; i < 64; ++i) { a = fmaxf(a, fabsf(gq[i])); bq = fmaxf(bq, fabsf(gk[i])); }
        ((float*)(ws + OFF_CTL))[CTL_QKB + t] = 64.0f * a * bq * QSCALE * 1.01f; }
    bf16* H = (bf16*)((unsigned char*)p.out + DO_H);
    {
        constexpr int NV = D_ / 256; const int rstep = gridDim.x * NW; int row = blockIdx.x * NW + w;
        f32x4 v[NV], vn[NV];
        if (row < T_) {
#pragma unroll
            for (int i = 0; i < NV; ++i) v[i] = *(const f32x4*)(p.x + (size_t)row * D_ + 256 * i + 4 * lane); }
        for (; row < T_; row += rstep) {
            const int nrow = row + rstep;
            if (nrow < T_) {
#pragma unroll
                for (int i = 0; i < NV; ++i) vn[i] = *(const f32x4*)(p.x + (size_t)nrow * D_ + 256 * i + 4 * lane); }
            float ss = 0.f;
#pragma unroll
            for (int i = 0; i < NV; ++i) ss += (v[i][0] * v[i][0] + v[i][1] * v[i][1]) + (v[i][2] * v[i][2] + v[i][3] * v[i][3]);
#pragma unroll
            for (int o = 1; o < 64; o <<= 1) ss += __shfl_xor(ss, o);
            const float rs = 1.0f / sqrtf(ss / D_ + RMS_EPS);
#pragma unroll
            for (int i = 0; i < NV; ++i) { const f32x4 gv = *(const f32x4*)(p.norm_mix_g + 256 * i + 4 * lane); const f32x4 tv = v[i] * gv * rs;
                *(u32x2*)(H + (size_t)row * D_ + 256 * i + 4 * lane) = (u32x2){pk_bf16(tv[0], tv[1]), pk_bf16(tv[2], tv[3])}; }
#pragma unroll
            for (int i = 0; i < NV; ++i) v[i] = vn[i];
        }
    }
}
DEV void bphase_scan_cmp1(const Params& p, unsigned char* smem) {
    unsigned char* ws = p.ws; const int t = threadIdx.x, lane = t & 63, w = t >> 6, wn = w / (NW / 2), wm = w % (NW / 2), q = lane >> 4, c = lane & 15;
    constexpr int MT = NCMPP / BM, NTILE = 2 * 2 * B_ * 2 * MT * 2, NSEQ = B_ * 8;
    constexpr int NBIAS = 2 * 4 * 8;
    for (int it = vblock(); it < NTILE + NSEQ + NBIAS; it += gridDim.x) {
        if (it >= NTILE + NSEQ) {
            const int r = it - NTILE - NSEQ, ks = r & 7, jg = (r >> 3) & 3, kv = r >> 5, jq = t >> 6; constexpr int KS = 256 / NW;
            const float* w1 = (kv ? p.cmp_v_w1 : p.cmp_k_w1) + jg * 64 + lane; const float* pos = kv ? p.cmp_v_pos : p.cmp_k_pos;
            float sacc = 0.f;
#pragma unroll 16
            for (int k = ks * 256 + jq * KS; k < ks * 256 + (jq + 1) * KS; ++k) sacc += pos[k] * w1[(size_t)k * 256];
            float* red = (float*)smem; red[t] = sacc; __syncthreads();
            if (t < 64) { float tot = 0.f; for (int k2 = 0; k2 < NW; ++k2) tot += red[64 * k2 + t]; ((float*)(ws + OFF_BIAS1P))[(ks * 2 + kv) * 256 + jg * 64 + t] = tot; }
            __syncthreads();
            continue;
        }
        if (it < NTILE) {
            const int kh = it & 1, nt = (it >> 1) & 1; int r = it >> 2; const int mt = r % MT; r /= MT; const int bg = r % (B_ * 2), kv = r / (B_ * 2);
            const bf16* Wb = (const bf16*)(ws + OFF_W1T) + (size_t)kv * 256 * 2048 + kh * 1024;
            GemmSrc g{(const bf16*)(ws + (kv ? OFF_VCR : OFF_KCR)) + (size_t)bg * S_ * 64 + kh * 1024, 1024, nullptr, Wb, Wb, 1 << 30, 2048, 1024};
            f32x4 acc[4][4]; zero_acc(acc);
            gemm_mainloop(acc, g, mt * BM, nt * 128, smem);
            const int n0w = nt * 128 + 64 * wn, m0w = mt * BM + 64 * wm;
            float* dst = (float*)(ws + OFF_CPART) + (((size_t)(kh * 2 + kv) * B_ * 2 + bg) * NCMPP + m0w + c) * 256 + n0w + 4 * q;
#pragma unroll
            for (int nf = 0; nf < 4; ++nf)
#pragma unroll
                for (int mf = 0; mf < 4; ++mf) *(f32x4*)(dst + (size_t)(16 * mf) * 256 + 16 * nf) = acc[nf][mf];
        } else {
            const int seq = it - NTILE; constexpr int PER = S_ / NTHREADS; const float* lf = (const float*)(ws + OFF_LOGF) + (size_t)seq * S_ + t * PER; float* cum = (float*)(ws + OFF_CUM) + (size_t)seq * S_ + t * PER;
            float v[PER]; float run = 0.f;
#pragma unroll
            for (int i = 0; i < PER; ++i) { run += lf[i]; v[i] = run; }
            float inc = run;
#pragma unroll
            for (int o = 1; o < 64; o <<= 1) { const float u = __shfl_up(inc, o); if (lane >= o) inc += u; }
            float* wt = (float*)smem; if (lane == 63) wt[w] = inc;
            __syncthreads();
            float base = inc - run; for (int k = 0; k < w; ++k) base += wt[k];
#pragma unroll
            for (int i = 0; i < PER; ++i) cum[i] = -(v[i] + base) * LOG2E;
            __syncthreads();
        }
    }
}
DEV void bphase_cmp2(const Params& p, unsigned char* smem) {
    unsigned char* ws = p.ws; const int lane = threadIdx.x & 63, w = threadIdx.x >> 6, wn = w / (NW / 2), wm = w % (NW / 2), q = lane >> 4, c = lane & 15;
    constexpr int MT = (B_ * 2 * NCMPP) / BM;
    for (int it = vblock(); it < 2 * MT; it += gridDim.x) {
        const int kv = it / MT, mt = it % MT; const bf16* Wb = (const bf16*)(ws + OFF_W2T) + (size_t)kv * 128 * 256;
        {
            const float* p0 = (const float*)(ws + OFF_CPART) + ((size_t)(0 * 2 + kv) * B_ * 2 * NCMPP + (size_t)mt * BM) * 256; const float* p1 = p0 + (size_t)2 * B_ * 2 * NCMPP * 256;
            bf16* hd = (bf16*)(ws + OFF_CHID) + ((size_t)kv * B_ * 2 * NCMPP + (size_t)mt * BM) * 256; f32x4 bv = {0.f, 0.f, 0.f, 0.f}; static_assert((4 * NTHREADS) % 256 == 0, "a thread keeps its 4 columns");
            for (int ks = 0; ks < 8; ++ks) bv = bv + *(const f32x4*)((const float*)(ws + OFF_BIAS1P) + (ks * 2 + kv) * 256 + (4 * threadIdx.x) % 256);
            for (int i = threadIdx.x; i < BM * 256 / 4; i += NTHREADS) { f32x4 v = *(const f32x4*)(p0 + 4 * (size_t)i) + *(const f32x4*)(p1 + 4 * (size_t)i) + bv;
#pragma unroll
                for (int r2 = 0; r2 < 4; ++r2) { const float u = v[r2]; v[r2] = u * sigmoidf_(1.5957691216057308f * (u + 0.044715f * u * u * u)); }
                *(u32x2*)(hd + 4 * (size_t)i) = (u32x2){pk_bf16(v[0], v[1]), pk_bf16(v[2], v[3])}; }
            asm volatile("s_waitcnt vmcnt(0)" ::: "memory"); __syncthreads();
        }
        GemmSrc g{(const bf16*)(ws + OFF_CHID) + (size_t)kv * B_ * 2 * NCMPP * 256, 256, nullptr, Wb, Wb, 1 << 30, 256, 256};
        f32x4 acc[4][4]; zero_acc(acc);
        gemm_mainloop(acc, g, mt * BM, 0, smem);
        if (wn == 0) {
            f32x4 g4[4];
#pragma unroll
            for (int nf = 0; nf < 4; ++nf) g4[nf] = kv == 0 ? *(const f32x4*)(p.nsa_k_g + 16 * nf + 4 * q) : (f32x4){1.f, 1.f, 1.f, 1.f};
#pragma unroll
            for (int mf = 0; mf < 4; ++mf) { const int row = mt * BM + 64 * wm + 16 * mf + c; float rs = 1.f;
                if (kv == 0) { float ss = 0.f;
#pragma unroll
                    for (int nf = 0; nf < 4; ++nf) { const f32x4 v = acc[nf][mf]; ss += (v[0] * v[0] + v[1] * v[1]) + (v[2] * v[2] + v[3] * v[3]); }
                    rs = 1.0f / sqrtf(rsum16(ss) * (1.0f / 64) + RMS_EPS); }
                if ((row % NCMPP) >= NCMP) rs = 0.f;
                bf16* drow = (bf16*)(ws + (kv ? OFF_VCMP : OFF_KCMP)) + (size_t)row * 64 + 4 * q;
#pragma unroll
                for (int nf = 0; nf < 4; ++nf) { const f32x4 v = acc[nf][mf] * rs * g4[nf]; *(u32x2*)(drow + 16 * nf) = (u32x2){pk_bf16(v[0], v[1]), pk_bf16(v[2], v[3])}; } }
        }
    }
}
#endif

#ifndef CPU_EMU
__global__ void __launch_bounds__(NTHREADS, 2) fwd_megakernel(Params p) {
    __shared__ __attribute__((aligned(16))) unsigned char smem[LDS_BYTES];
    cg::grid_group grid = cg::this_grid();
    volatile unsigned* bst = (volatile unsigned*)(smem + LDS_BYTES - 32);
    if (threadIdx.x < 2) bst[threadIdx.x] = 0u;
    __syncthreads();
    XcdBarrier bar = xcd_barrier_post((unsigned*)(p.ws + OFF_CTL) + CTL_BAR, bst);
    bphase_prep(p, smem, 0, 0);      xcd_barrier(bar);
    if (p.ws == nullptr) grid.sync();
    bphase_inproj(p, smem);          xcd_barrier(bar);
    bphase_scan_cmp1(p, smem);
    bphase_prep(p, smem, 1, 2 * 2 * B_ * 2 * (NCMPP / BM) * 2 + B_ * 8 + 64);     xcd_barrier(bar);
    bphase_cmp2(p, smem);            dep_post((unsigned*)(p.ws + OFF_CTL) + CTL_DEP, true);
    bphase_attn(p, smem);            xcd_barrier(bar);
    bphase_moe_up(p, smem);
    bphase_moe_down(p, smem);
}

extern "C" void kernel_launch(void* const* d_in, const int* in_sizes, int n_in, void* d_out, int out_size, void* d_ws, size_t ws_size, hipStream_t stream) {
    static int grid_blocks = 0;
    if (!grid_blocks) {
        if (n_in != 25 || out_size != T_ * D_ || ws_size < WS_END) { fprintf(stderr, "kernel_launch: unexpected shapes (n_in %d out %d ws %zu need %zu)\n", n_in, out_size, ws_size, (size_t)WS_END); grid_blocks = -1; return; }
        int dev = 0, cus = 0, per_cu = 0;
        hipGetDevice(&dev); hipDeviceGetAttribute(&cus, hipDeviceAttributeMultiprocessorCount, dev);
        hipOccupancyMaxActiveBlocksPerMultiprocessor(&per_cu, fwd_megakernel, NTHREADS, 0);
        if (per_cu < 1) { fprintf(stderr, "kernel_launch: occupancy query says %d blocks per CU\n", per_cu); grid_blocks = -1; return; }
        if (per_cu > 2) per_cu = 2;
        if (NW >= 8) per_cu = 1;
        grid_blocks = cus * per_cu;
    }
    if (grid_blocks < 0) return;
    Params p{};
    const float** f = (const float**)&p;
    for (int i = 0; i < 25; ++i) f[i] = (const float*)d_in[i];
    p.out = (float*)d_out; p.ws = (unsigned char*)d_ws;
    void* args[] = {&p};
    if (hipMemsetAsync((char*)d_ws + OFF_CTL, 0, 65536, stream) != hipSuccess) { fprintf(stderr, "kernel_launch: memset of the control words failed\n"); return; }
    hipError_t e = hipLaunchCooperativeKernel((void*)fwd_megakernel, dim3(grid_blocks), dim3(NTHREADS), args, 0, stream);
    if (e != hipSuccess) fprintf(stderr, "cooperative launch failed: %s (grid %d)\n", hipGetErrorString(e), grid_blocks);
}
#endif
```

```cpp
#ifndef CPU_EMU
#include <hip/hip_runtime.h>
#include <hip/hip_cooperative_groups.h>
#include <cstdio>
#include <cstdint>
namespace cg = cooperative_groups;
#define DEV __device__ __forceinline__
#else
#include <cstdio>
#include <cstdint>
#include <cstring>
#include <cmath>
#define DEV inline
struct uint4 { unsigned x, y, z, w; };
static inline float exp2f_(float x) { return exp2f(x); }
#endif

#ifndef CFG_NW
#define CFG_NW 4
#endif
#define CFG_NW_FOR_WS CFG_NW
#ifndef CFG_B
#define CFG_B 2
#define CFG_S 8192
#define CFG_D 1024
#define CFG_DE 512
#endif

constexpr int B_ = CFG_B, S_ = CFG_S, D_ = CFG_D, DE_ = CFG_DE, T_ = B_ * S_;
constexpr int HD = 64, FH = 8, NH = 8, NKV = 2, NR = 4;
constexpr int NCMP = (S_ - 32) / 16 + 1, NCMPP = ((NCMP + 31) / 32) * 32, NSLC = S_ / 64, TOPN = NSLC < 16 ? NSLC : 16;
constexpr int NE = 16;
constexpr float RMS_EPS = 1e-6f;
constexpr float LOG2E = 1.4426950408889634f;
constexpr float QSCALE = 0.125f * LOG2E;
constexpr int C_FQ = 0, C_FK = 512, C_FV = 1024, C_NQ = 1536, C_KC = 2048, C_VC = 2176, C_KS = 2304, C_VS = 2432, C_KW = 2560, C_VW = 2688,
              C_GA = 2816, C_GB = 2816 + D_, C_FF = 2816 + 2 * D_, C_NG = C_FF + 8, C_END = C_NG + 24, NP = ((C_END + 127) / 128) * 128;
constexpr int O_FQ = 0, O_FK = 512, O_FV = 1024, O_FF = 1536, O_NQ = 1544, O_KC = 2056, O_VC = 2184, O_KS = 2312, O_VS = 2440, O_KW = 2568, O_VW = 2696,
              O_NG = 2824, O_GA = 2848, O_GB = 2848 + D_, D_IN = 2848 + 2 * D_;

typedef unsigned short bf16;

constexpr size_t al256(size_t x) { return (x + 255) & ~(size_t)255; }
constexpr size_t OFF_CTL = 0, SZ_CTL = 1 << 20;
constexpr size_t OFF_WINT = OFF_CTL + SZ_CTL;
constexpr size_t OFF_WAT = OFF_WINT + al256((size_t)NP * D_ * 2);
constexpr size_t OFF_WBT = OFF_WAT + al256((size_t)D_ * 512 * 2);
constexpr size_t OFF_WOT = OFF_WBT + al256((size_t)D_ * 512 * 2);
constexpr size_t OFF_W1T = OFF_WOT + al256((size_t)D_ * D_ * 2);
constexpr size_t OFF_W2T = OFF_W1T + al256((size_t)2 * 256 * 2048 * 2);
constexpr size_t OFF_BIAS1 = OFF_W2T + al256((size_t)2 * 128 * 256 * 2);
constexpr size_t OFF_WGT = OFF_BIAS1 + al256((size_t)2 * 256 * 4);
constexpr size_t OFF_WUT = OFF_WGT + al256((size_t)NE * DE_ * D_ * 2);
constexpr size_t OFF_WDT = OFF_WUT + al256((size_t)NE * DE_ * D_ * 2);
constexpr size_t SZ_HEADS = al256((size_t)B_ * 8 * S_ * 64 * 2), SZ_KV = al256((size_t)B_ * 2 * S_ * 64 * 2);
constexpr size_t OFF_FQ = OFF_WDT + al256((size_t)NE * D_ * DE_ * 2);
constexpr size_t OFF_FK = OFF_FQ + SZ_HEADS, OFF_FV = OFF_FK + SZ_HEADS, OFF_NQ = OFF_FV + SZ_HEADS;
constexpr size_t OFF_KCR = OFF_NQ + SZ_HEADS, OFF_VCR = OFF_KCR + SZ_KV, OFF_KS = OFF_VCR + SZ_KV, OFF_VS = OFF_KS + SZ_KV, OFF_KW = OFF_VS + SZ_KV, OFF_VW = OFF_KW + SZ_KV;
constexpr size_t OFF_GA = OFF_VW + SZ_KV, OFF_GB = OFF_GA + al256((size_t)T_ * D_ * 2);
constexpr size_t OFF_LOGF = OFF_GB + al256((size_t)T_ * D_ * 2);
constexpr size_t OFF_CUM = OFF_LOGF + al256((size_t)B_ * 8 * S_ * 4);
constexpr size_t OFF_GATE = OFF_CUM + al256((size_t)B_ * 8 * S_ * 4);
constexpr size_t OFF_KCMP = OFF_GATE + al256((size_t)T_ * 24 * 4);
constexpr size_t OFF_VCMP = OFF_KCMP + al256((size_t)B_ * 2 * NCMPP * 64 * 2);
constexpr size_t OFF_CHID = OFF_VCMP + al256((size_t)B_ * 2 * NCMPP * 64 * 2);
#ifdef CPU_EMU
constexpr size_t OFF_IMP = OFF_CHID + al256((size_t)2 * B_ * 2 * NCMPP * 256 * 2);
constexpr size_t OFF_SEL = OFF_IMP + al256((size_t)B_ * 2 * S_ * NSLC * 4);
constexpr size_t OFF_ROUTE = OFF_SEL + al256((size_t)B_ * 2 * S_ * 16 * 4);
#else
constexpr size_t OFF_ROUTE = OFF_CHID + al256((size_t)2 * B_ * 2 * NCMPP * 256 * 2);
#endif
constexpr int NCLS = 24, MOE_BM = 32 * CFG_NW_FOR_WS, NSLOT = T_ + NCLS * MOE_BM;
constexpr size_t OFF_STOK = OFF_ROUTE + al256((size_t)T_ * 16);
constexpr size_t OFF_SW = OFF_STOK + al256((size_t)NCLS * T_ * 4);
constexpr int FX_ROWS = 32 * CFG_NW, FX_CH = 32, FX_NQB = S_ / FX_ROWS, FX_QQ = FX_NQB / 4, FX_PART_PER_BH = 9 * FX_QQ, FX_PART_BYTES = FX_ROWS * 64 * 2 + FX_ROWS * 8;
constexpr size_t FX_NPART = (size_t)B_ * 8 * FX_PART_PER_BH;
constexpr size_t FX_P1 = ((size_t)T_ * D_ * 4 - (size_t)T_ * 1024 * 2) / FX_PART_BYTES;
constexpr size_t OFF_FXINFO = OFF_SW + al256((size_t)NCLS * T_ * 8);
constexpr size_t OFF_FXPART = OFF_FXINFO + al256((size_t)B_ * 8 * FX_NQB * 4);
constexpr size_t OFF_SSP = OFF_FXPART + al256((FX_NPART > FX_P1 ? FX_NPART - FX_P1 : 0) * FX_PART_BYTES);
constexpr size_t OFF_CPART = OFF_SSP + al256((size_t)T_ * 16 * 4);
constexpr size_t OFF_BIAS1P = OFF_CPART + al256((size_t)2 * 2 * B_ * 2 * NCMPP * 256 * 4);
constexpr size_t WS_END = OFF_BIAS1P + al256((size_t)8 * 2 * 256 * 4);
static_assert(D_ / 64 <= 16, "one partial per 64-column slice");
static_assert(S_ != 8192 || (FX_NQB % 4 == 0 && FX_QQ * (FX_ROWS / 64) == FX_CH), "a quarter of the query blocks must span exactly FX_CH key tiles");
constexpr int CTL_BAR = 1024;
constexpr int CTL_HIDDONE = 7168, CTL_MDQ = 15360;
constexpr int CTL_CNT = 8192, CTL_CUR = 8192 + 24 * 64, CTL_FOXQ = 192, CTL_QKB = 256, CST = 64;
constexpr size_t OFF_MIX = OFF_FQ;
constexpr size_t OFF_TN = OFF_GA;
constexpr size_t OFF_PL = OFF_FV;
constexpr size_t OFF_HID = OFF_FQ;
constexpr size_t OFF_RS = OFF_CTL + (128 << 10), OFF_BW = OFF_CTL + (256 << 10);
static_assert((size_t)NSLOT * 2 * DE_ * 2 <= 3 * SZ_HEADS && (size_t)8 * T_ * 20 * 4 <= SZ_HEADS && OFF_BW + (size_t)D_ * 20 * 4 <= SZ_CTL, "overlays");
constexpr size_t DO_H = 0, DO_OA = 0, DO_OB = (size_t)T_ * 512 * 2, DO_OBF = (size_t)T_ * 1024 * 2;

struct Params {
    const float *x, *norm_mix_g, *w_in, *b_forget, *fox_q_g, *fox_k_g, *nsa_q_g, *nsa_k_g, *cmp_k_w1, *cmp_k_w2, *cmp_k_pos, *cmp_v_w1, *cmp_v_w2, *cmp_v_pos,
        *w_fox_up, *w_nsa_up, *w_out, *norm_ffn_g, *w_group, *b_group, *w_router, *b_router, *w_gate, *w_up, *w_down;
    float* out; unsigned char* ws;
};

#ifndef CPU_EMU
DEV float u2f(unsigned u) { return __uint_as_float(u); }
DEV unsigned f2u(float f) { return __float_as_uint(f); }
#else
DEV float u2f(unsigned u) { float f; memcpy(&f, &u, 4); return f; }
DEV unsigned f2u(float f) { unsigned u; memcpy(&u, &f, 4); return u; }
#endif
DEV float bf2f(bf16 v) { return u2f((unsigned)v << 16); }
DEV bf16 f2bf(float f) { unsigned u = f2u(f); return (bf16)((u + 0x7fffu + ((u >> 16) & 1u)) >> 16); }
#ifndef CPU_EMU
DEV float sigmoidf_(float v) { return __builtin_amdgcn_rcpf(1.0f + __builtin_amdgcn_exp2f(-1.4426950408889634f * v)); }
#else
DEV float sigmoidf_(float v) { return 1.0f / (1.0f + expf(-v)); }
#endif
DEV float alibi_slope2(int h) { return exp2f(-(float)(h + 1)) * LOG2E; }
DEV int orig_col(int c) {
    if (c < C_FF) { if (c < C_NQ) return c; if (c < C_GA) return c - C_NQ + O_NQ; return c - C_GA + O_GA; }
    if (c < C_NG) return c - C_FF + O_FF;
    if (c < C_END) return c - C_NG + O_NG;
    return -1;
}
DEV void unpack8(const uint4& v, float* f) {
    f[0] = u2f(v.x << 16); f[1] = u2f(v.x & 0xffff0000u); f[2] = u2f(v.y << 16); f[3] = u2f(v.y & 0xffff0000u);
    f[4] = u2f(v.z << 16); f[5] = u2f(v.z & 0xffff0000u); f[6] = u2f(v.w << 16); f[7] = u2f(v.w & 0xffff0000u);
}
DEV void dot64(const bf16* a, const bf16* bt, size_t ldb, int K, float (&acc)[64]) {
    for (int k0 = 0; k0 < K; k0 += 8) {
        float af[8]; unpack8(*(const uint4*)(a + k0), af);
#pragma unroll
        for (int j = 0; j < 64; ++j) {
            float bfv[8]; unpack8(*(const uint4*)(bt + (size_t)j * ldb + k0), bfv);
            acc[j] += ((af[0] * bfv[0] + af[1] * bfv[1]) + (af[2] * bfv[2] + af[3] * bfv[3])) + ((af[4] * bfv[4] + af[5] * bfv[5]) + (af[6] * bfv[6] + af[7] * bfv[7]));
        }
    }
}
DEV void load64(const bf16* p, float (&q)[64]) {
#pragma unroll
    for (int c = 0; c < 8; ++c) { float f[8]; unpack8(*(const uint4*)(p + 8 * c), f);
#pragma unroll
        for (int i = 0; i < 8; ++i) q[8 * c + i] = f[i]; }
}
DEV float dotq(const float (&q)[64], const bf16* k) {
    float s = 0.f;
#pragma unroll
    for (int c = 0; c < 8; ++c) { float f[8]; unpack8(*(const uint4*)(k + 8 * c), f);
#pragma unroll
        for (int i = 0; i < 8; ++i) s += q[8 * c + i] * f[i]; }
    return s;
}
DEV void axpy64(float (&o)[64], float p, const bf16* v) {
#pragma unroll
    for (int c = 0; c < 8; ++c) { float f[8]; unpack8(*(const uint4*)(v + 8 * c), f);
#pragma unroll
        for (int i = 0; i < 8; ++i) o[8 * c + i] += p * f[i]; }
}
DEV void store64_bf16(bf16* p, const float (&v)[64]) {
#pragma unroll
    for (int c = 0; c < 8; ++c) { uint4 o;
        o.x = (unsigned)f2bf(v[8 * c + 0]) | ((unsigned)f2bf(v[8 * c + 1]) << 16); o.y = (unsigned)f2bf(v[8 * c + 2]) | ((unsigned)f2bf(v[8 * c + 3]) << 16);
        o.z = (unsigned)f2bf(v[8 * c + 4]) | ((unsigned)f2bf(v[8 * c + 5]) << 16); o.w = (unsigned)f2bf(v[8 * c + 6]) | ((unsigned)f2bf(v[8 * c + 7]) << 16);
        *(uint4*)(p + 8 * c) = o; }
}
DEV void osm_step(float s, const bf16* vrow, float& m, float& l, float (&o)[64]) {
    if (s > m) { const float a = exp2f(m - s);
#pragma unroll
        for (int i = 0; i < 64; ++i) o[i] *= a;
        l *= a; m = s; }
    const float p = exp2f(s - m); l += p; axpy64(o, p, vrow);
}

DEV void transpose_item(const float* src, int K, int N, bf16* dst, size_t i) { const int n = (int)(i / K), k = (int)(i % K); dst[i] = f2bf(src[(size_t)k * N + n]); }
DEV void phase_prep(const Params& p, long gt, long nth) {
    unsigned char* ws = p.ws;
    { bf16* d = (bf16*)(ws + OFF_WINT); for (size_t i = gt; i < (size_t)NP * D_; i += nth) { const int c = (int)(i / D_), k = (int)(i % D_), oc = orig_col(c); d[i] = oc < 0 ? (bf16)0 : f2bf(p.w_in[(size_t)k * D_IN + oc]); } }
    { bf16* d = (bf16*)(ws + OFF_WAT); for (size_t i = gt; i < (size_t)D_ * 512; i += nth) transpose_item(p.w_fox_up, 512, D_, d, i); }
    { bf16* d = (bf16*)(ws + OFF_WBT); for (size_t i = gt; i < (size_t)D_ * 512; i += nth) transpose_item(p.w_nsa_up, 512, D_, d, i); }
    { bf16* d = (bf16*)(ws + OFF_WOT); for (size_t i = gt; i < (size_t)D_ * D_; i += nth) transpose_item(p.w_out, D_, D_, d, i); }
    for (int kv = 0; kv < 2; ++kv) {
        const float* w1 = kv ? p.cmp_v_w1 : p.cmp_k_w1; const float* w2 = kv ? p.cmp_v_w2 : p.cmp_k_w2; const float* pos = kv ? p.cmp_v_pos : p.cmp_k_pos;
        bf16* d1 = (bf16*)(ws + OFF_W1T) + (size_t)kv * 256 * 2048; bf16* d2 = (bf16*)(ws + OFF_W2T) + (size_t)kv * 64 * 256; float* b1 = (float*)(ws + OFF_BIAS1) + kv * 256;
        for (size_t i = gt; i < (size_t)256 * 2048; i += nth) transpose_item(w1, 2048, 256, d1, i);
        for (size_t i = gt; i < (size_t)64 * 256; i += nth) transpose_item(w2, 256, 64, d2, i);
        for (size_t j = gt; j < 256; j += nth) { float s = 0.f; for (int k = 0; k < 2048; ++k) s += pos[k] * w1[(size_t)k * 256 + j]; b1[j] = s; }
    }
#ifdef CPU_EMU
    for (int e = 0; e < NE; ++e) {
        bf16* dg = (bf16*)(ws + OFF_WGT) + (size_t)e * DE_ * D_; bf16* du = (bf16*)(ws + OFF_WUT) + (size_t)e * DE_ * D_; bf16* dd = (bf16*)(ws + OFF_WDT) + (size_t)e * D_ * DE_;
        for (size_t i = gt; i < (size_t)DE_ * D_; i += nth) { transpose_item(p.w_gate + (size_t)e * D_ * DE_, D_, DE_, dg, i); transpose_item(p.w_up + (size_t)e * D_ * DE_, D_, DE_, du, i); }
        for (size_t i = gt; i < (size_t)D_ * DE_; i += nth) transpose_item(p.w_down + (size_t)e * DE_ * D_, DE_, D_, dd, i);
    }
#else
    {
        bf16* d = (bf16*)(ws + OFF_WGT);
        for (size_t i = gt; i < (size_t)NE * 2 * DE_ * D_; i += nth) { const int k = (int)(i % D_); const size_t r = i / D_; const int row = (int)(r % (2 * DE_)), e = (int)(r / (2 * DE_));
            const int j = (row / 64) * 32 + (row % 32); const float* src = ((row % 64) < 32 ? p.w_gate : p.w_up) + (size_t)e * D_ * DE_; d[i] = f2bf(src[(size_t)k * DE_ + j]); }
        for (int e = 0; e < NE; ++e) { bf16* dd = (bf16*)(ws + OFF_WDT) + (size_t)e * D_ * DE_; for (size_t i = gt; i < (size_t)D_ * DE_; i += nth) transpose_item(p.w_down + (size_t)e * DE_ * D_, DE_, D_, dd, i); }
        int* st = (int*)(ws + OFF_STOK); for (size_t i = gt; i < (size_t)NSLOT; i += nth) st[i] = -1;
    }
#endif
    bf16* H = (bf16*)((unsigned char*)p.out + DO_H);
    for (size_t r = gt; r < (size_t)T_; r += nth) {
        const float* xr = p.x + r * D_; float ss = 0.f; for (int k = 0; k < D_; ++k) ss += xr[k] * xr[k];
        const float rs = 1.0f / sqrtf(ss / D_ + RMS_EPS);
        for (int k = 0; k < D_; ++k) H[r * D_ + k] = f2bf(xr[k] * rs * p.norm_mix_g[k]);
    }
}
DEV void phase_inproj(const Params& p, long gt, long nth) {
    unsigned char* ws = p.ws; const bf16* H = (const bf16*)((unsigned char*)p.out + DO_H); const bf16* WT = (const bf16*)(ws + OFF_WINT);
    constexpr int NGRP = NP / 64;
    for (size_t it = gt; it < (size_t)T_ * NGRP; it += nth) {
        const int grp = (int)(it % NGRP); const size_t row = it / NGRP; const int b = (int)(row / S_), s = (int)(row % S_); const int c0 = grp * 64;
        if (c0 >= C_END) continue;
        float acc[64];
#pragma unroll
        for (int j = 0; j < 64; ++j) acc[j] = 0.f;
        dot64(H + row * D_, WT + (size_t)c0 * D_, D_, D_, acc);
        if (c0 < C_KC) {
            const int which = c0 / 512, h = (c0 % 512) / 64;
            bf16* dst = (bf16*)(ws + (which == 0 ? OFF_FQ : which == 1 ? OFF_FK : which == 2 ? OFF_FV : OFF_NQ)) + (((size_t)b * 8 + h) * S_ + s) * 64;
            if (which != 2) {
                const float* g = which == 0 ? p.fox_q_g : which == 1 ? p.fox_k_g : p.nsa_q_g; float ss = 0.f;
#pragma unroll
                for (int j = 0; j < 64; ++j) ss += acc[j] * acc[j];
                const float rs = 1.0f / sqrtf(ss * (1.0f / 64) + RMS_EPS) * (which == 1 ? 1.0f : QSCALE);
#pragma unroll
                for (int j = 0; j < 64; ++j) acc[j] = acc[j] * rs * g[j];
            }
            store64_bf16(dst, acc);
        } else if (c0 < C_GA) {
            const int which = (c0 - C_KC) / 128, g2 = ((c0 - C_KC) % 128) / 64;
            bf16* dst = (bf16*)(ws + OFF_KCR + (size_t)which * SZ_KV) + (((size_t)b * 2 + g2) * S_ + s) * 64;
            if (which == 2 || which == 4) { float ss = 0.f;
#pragma unroll
                for (int j = 0; j < 64; ++j) ss += acc[j] * acc[j];
                const float rs = 1.0f / sqrtf(ss * (1.0f / 64) + RMS_EPS);
#pragma unroll
                for (int j = 0; j < 64; ++j) acc[j] = acc[j] * rs * p.nsa_k_g[j];
            }
            store64_bf16(dst, acc);
        } else if (c0 < C_FF) {
            const bool isb = c0 >= C_GB; const int cc = c0 - (isb ? C_GB : C_GA);
#pragma unroll
            for (int j = 0; j < 64; ++j) acc[j] = sigmoidf_(acc[j]);
            store64_bf16((bf16*)(ws + (isb ? OFF_GB : OFF_GA)) + row * D_ + cc, acc);
        } else {
            float* lf = (float*)(ws + OFF_LOGF); float* gt_ = (float*)(ws + OFF_GATE);
#pragma unroll
            for (int j = 0; j < 8; ++j) { const float v = acc[j] + p.b_forget[j]; lf[((size_t)b * 8 + j) * S_ + s] = fminf(v, 0.f) - log1pf(expf(-fabsf(v))); }
#pragma unroll
            for (int j = 0; j < 24; ++j) gt_[row * 24 + j] = sigmoidf_(acc[8 + j]);
        }
    }
}
DEV void phase_scan_cmp1(const Params& p, long gt, long nth) {
    unsigned char* ws = p.ws; const float* lf = (const float*)(ws + OFF_LOGF); float* cum = (float*)(ws + OFF_CUM);
    for (size_t it = gt; it < (size_t)B_ * 8; it += nth) { float c = 0.f; for (int s = 0; s < S_; ++s) { c += lf[it * S_ + s]; cum[it * S_ + s] = c * LOG2E; } }
    for (size_t it = gt; it < (size_t)2 * B_ * 2 * NCMP * 4; it += nth) {
        const int jg = (int)(it % 4); size_t r = it / 4; const int n = (int)(r % NCMP); r /= NCMP; const int bg = (int)(r % (B_ * 2)), kv = (int)(r / (B_ * 2));
        const bf16* raw = (const bf16*)(ws + (kv ? OFF_VCR : OFF_KCR)) + ((size_t)bg * S_ + 16 * n) * 64;
        const bf16* w1t = (const bf16*)(ws + OFF_W1T) + (size_t)kv * 256 * 2048 + (size_t)jg * 64 * 2048; const float* b1 = (const float*)(ws + OFF_BIAS1) + kv * 256 + jg * 64;
        float acc[64];
#pragma unroll
        for (int j = 0; j < 64; ++j) acc[j] = b1[j];
        dot64(raw, w1t, 2048, 2048, acc);
#pragma unroll
        for (int j = 0; j < 64; ++j) { const float v = acc[j]; acc[j] = 0.5f * v * (1.0f + tanhf(0.7978845608028654f * (v + 0.044715f * v * v * v))); }
        store64_bf16((bf16*)(ws + OFF_CHID) + (((size_t)kv * B_ * 2 + bg) * NCMPP + n) * 256 + jg * 64, acc);
    }
}
DEV void phase_cmp2(const Params& p, long gt, long nth) {
    unsigned char* ws = p.ws;
    for (size_t i = gt; i < (size_t)2 * B_ * 2 * (NCMPP - NCMP) * 64; i += nth) { const int d = (int)(i % 64); size_t r = i / 64; const int n = NCMP + (int)(r % (NCMPP - NCMP)); r /= (NCMPP - NCMP); const int bg = (int)(r % (B_ * 2)), kv = (int)(r / (B_ * 2));
        ((bf16*)(ws + (kv ? OFF_VCMP : OFF_KCMP)))[((size_t)bg * NCMPP + n) * 64 + d] = 0; }
    for (size_t it = gt; it < (size_t)2 * B_ * 2 * NCMP; it += nth) {
        const int n = (int)(it % NCMP); size_t r = it / NCMP; const int bg = (int)(r % (B_ * 2)), kv = (int)(r / (B_ * 2));
        const bf16* hid = (const bf16*)(ws + OFF_CHID) + (((size_t)kv * B_ * 2 + bg) * NCMPP + n) * 256; const bf16* w2t = (const bf16*)(ws + OFF_W2T) + (size_t)kv * 64 * 256;
        float acc[64];
#pragma unroll
        for (int j = 0; j < 64; ++j) acc[j] = 0.f;
        dot64(hid, w2t, 256, 256, acc);
        if (kv == 0) { float ss = 0.f;
#pragma unroll
            for (int j = 0; j < 64; ++j) ss += acc[j] * acc[j];
            const float rs = 1.0f / sqrtf(ss * (1.0f / 64) + RMS_EPS);
#pragma unroll
            for (int j = 0; j < 64; ++j) acc[j] = acc[j] * rs * p.nsa_k_g[j];
        }
        store64_bf16((bf16*)(ws + (kv ? OFF_VCMP : OFF_KCMP)) + ((size_t)bg * NCMPP + n) * 64, acc);
    }
}
DEV void phase_fox(const Params& p, long gt, long nth) {
    unsigned char* ws = p.ws; const float* cum = (const float*)(ws + OFF_CUM); bf16* OA = (bf16*)((unsigned char*)p.out + DO_OA);
    for (size_t it = gt; it < (size_t)B_ * 8 * S_; it += nth) {
        const size_t it2 = (size_t)B_ * 8 * S_ - 1 - it;
        const int t = (int)(it2 % S_); const size_t bh = it2 / S_; const int h = (int)(bh % 8), b = (int)(bh / 8);
        const bf16* K = (const bf16*)(ws + OFF_FK) + bh * S_ * 64; const bf16* V = (const bf16*)(ws + OFF_FV) + bh * S_ * 64;
        float q[64], o[64]; load64((const bf16*)(ws + OFF_FQ) + (bh * S_ + t) * 64, q);
#pragma unroll
        for (int i = 0; i < 64; ++i) o[i] = 0.f;
        float m = -INFINITY, l = 0.f; const float cq = cum[bh * S_ + t];
        for (int k = 0; k <= t; ++k) osm_step(dotq(q, K + (size_t)k * 64) + (cq - cum[bh * S_ + k]), V + (size_t)k * 64, m, l, o);
        const float il = 1.0f / l;
#pragma unroll
        for (int i = 0; i < 64; ++i) o[i] *= il;
        store64_bf16(OA + ((size_t)b * S_ + t) * 512 + h * 64, o);
    }
}
#ifdef CPU_EMU
DEV void phase_nsa_cmp(const Params& p, long gt, long nth) {
    unsigned char* ws = p.ws; float* IMP = (float*)(ws + OFF_IMP); float* OBF = (float*)((unsigned char*)p.out + DO_OBF); const float* GATE = (const float*)(ws + OFF_GATE);
    for (size_t it = gt; it < (size_t)B_ * 2 * S_; it += nth) {
        const int t = (int)(it % S_); const size_t bg = it / S_; const int g = (int)(bg % 2), b = (int)(bg / 2);
        const bf16* KC = (const bf16*)(ws + OFF_KCMP) + bg * NCMPP * 64; const bf16* VC = (const bf16*)(ws + OFF_VCMP) + bg * NCMPP * 64;
        float* imp = IMP + it * NSLC; for (int j = 0; j < NSLC; ++j) imp[j] = 0.f;
        const int nval = t >= 31 ? (t - 31) / 16 + 1 : 0;
        for (int r = 0; r < 4; ++r) {
            const int h = g * 4 + r; const float sl = alibi_slope2(h);
            float q[64], o[64]; load64((const bf16*)(ws + OFF_NQ) + (((size_t)b * 8 + h) * S_ + t) * 64, q);
#pragma unroll
            for (int i = 0; i < 64; ++i) o[i] = 0.f;
            float m = -INFINITY, l = 0.f;
            for (int n = 0; n < nval; ++n) { const float s = dotq(q, KC + (size_t)n * 64) - sl * (float)(t - (16 * n + 31)); if (s > m) { l *= exp2f(m - s); m = s; } l += exp2f(s - m); }
            const float il = nval ? 1.0f / l : 0.f;
            for (int n = 0; n < nval; ++n) {
                const float s = dotq(q, KC + (size_t)n * 64) - sl * (float)(t - (16 * n + 31)); const float pr = exp2f(s - m) * il;
                axpy64(o, pr, VC + (size_t)n * 64);
                const int j0 = n >> 2;
                if ((n & 3) == 3) { imp[j0] += 0.5f * pr; if (j0 + 1 < NSLC) imp[j0 + 1] += 0.5f * pr; } else imp[j0] += pr;
            }
            const float g0 = GATE[((size_t)b * S_ + t) * 24 + h * 3 + 0]; float* ob = OBF + ((size_t)b * S_ + t) * 512 + h * 64;
#pragma unroll
            for (int i = 0; i < 64; ++i) ob[i] = g0 * o[i];
        }
    }
}
DEV void phase_nsa_topk(const Params& p, long gt, long nth) {
    unsigned char* ws = p.ws; const float* IMP = (const float*)(ws + OFF_IMP); int* SEL = (int*)(ws + OFF_SEL);
    for (size_t it = gt; it < (size_t)B_ * 2 * S_; it += nth) {
        const int t = (int)(it % S_); const int qb = t / 64; const float* imp = IMP + it * NSLC; int* sel = SEL + it * 16;
        static_assert(NSLC <= 128, "selection mask is 128 bits");
        unsigned long long tk0 = 0ull, tk1 = 0ull;
        for (int k = 0; k < TOPN; ++k) {
            float best = -INFINITY; int bj = 0;
            for (int j = 0; j < NSLC; ++j) {
                if (((j < 64 ? tk0 : tk1) >> (j & 63)) & 1ull) continue;
                const float sc = (j * 64 > t) ? -1.0f : ((j == 0 || j == qb || j == qb - 1) ? 1e4f : imp[j]);
                if (sc > best) { best = sc; bj = j; }
            }
            if (bj < 64) tk0 |= 1ull << bj; else tk1 |= 1ull << (bj - 64);
            sel[k] = bj;
        }
        for (int k = TOPN; k < 16; ++k) sel[k] = -1;
    }
}
DEV void phase_nsa_slc_win(const Params& p, long gt, long nth) {
    unsigned char* ws = p.ws; const int* SEL = (const int*)(ws + OFF_SEL); float* OBF = (float*)((unsigned char*)p.out + DO_OBF); const float* GATE = (const float*)(ws + OFF_GATE);
    bf16* OB = (bf16*)((unsigned char*)p.out + DO_OB);
    for (size_t it = gt; it < (size_t)B_ * 8 * S_; it += nth) {
        const int t = (int)(it % S_); const size_t bh = it / S_; const int h = (int)(bh % 8), b = (int)(bh / 8), g = h / 4; const size_t bg = (size_t)b * 2 + g;
        const float sl = alibi_slope2(h);
        float q[64], o[64]; load64((const bf16*)(ws + OFF_NQ) + (bh * S_ + t) * 64, q);
        float* ob = OBF + ((size_t)b * S_ + t) * 512 + h * 64; const float g1 = GATE[((size_t)b * S_ + t) * 24 + h * 3 + 1], g2 = GATE[((size_t)b * S_ + t) * 24 + h * 3 + 2];
#pragma unroll
        for (int i = 0; i < 64; ++i) o[i] = 0.f;
        {
            const bf16* K = (const bf16*)(ws + OFF_KS) + bg * S_ * 64; const bf16* V = (const bf16*)(ws + OFF_VS) + bg * S_ * 64; const int* sel = SEL + (bg * S_ + t) * 16;
            float m = -INFINITY, l = 0.f;
            for (int k = 0; k < 16; ++k) { const int blk = sel[k]; if (blk < 0 || blk * 64 > t) continue;
                for (int i = 0; i < 64; ++i) { const int kp = blk * 64 + i; if (kp > t) break; osm_step(dotq(q, K + (size_t)kp * 64) - sl * (float)(t - kp), V + (size_t)kp * 64, m, l, o); } }
            const float il = g1 / l;
#pragma unroll
            for (int i = 0; i < 64; ++i) { ob[i] += il * o[i]; o[i] = 0.f; }
        }
        {
            const bf16* K = (const bf16*)(ws + OFF_KW) + bg * S_ * 64; const bf16* V = (const bf16*)(ws + OFF_VW) + bg * S_ * 64;
            float m = -INFINITY, l = 0.f; const int k0 = t - 511 > 0 ? t - 511 : 0;
            for (int kp = k0; kp <= t; ++kp) osm_step(dotq(q, K + (size_t)kp * 64) - sl * (float)(t - kp), V + (size_t)kp * 64, m, l, o);
            const float il = g2 / l;
#pragma unroll
            for (int i = 0; i < 64; ++i) o[i] = ob[i] + il * o[i];
        }
        store64_bf16(OB + ((size_t)b * S_ + t) * 512 + h * 64, o);
    }
}
#endif
DEV void phase_up(const Params& p, long gt, long nth) {
    unsigned char* ws = p.ws; const bf16* OA = (const bf16*)((unsigned char*)p.out + DO_OA); const bf16* OB = (const bf16*)((unsigned char*)p.out + DO_OB);
    const bf16* GA = (const bf16*)(ws + OFF_GA); const bf16* GB = (const bf16*)(ws + OFF_GB); bf16* MIX = (bf16*)(ws + OFF_MIX);
    constexpr int NGRP = D_ / 64;
    for (size_t it = gt; it < (size_t)T_ * NGRP; it += nth) {
        const int c0 = (int)(it % NGRP) * 64; const size_t row = it / NGRP;
        float a[64], bb[64], ga[64], gb[64];
#pragma unroll
        for (int j = 0; j < 64; ++j) { a[j] = 0.f; bb[j] = 0.f; }
        dot64(OA + row * 512, (const bf16*)(ws + OFF_WAT) + (size_t)c0 * 512, 512, 512, a);
        dot64(OB + row * 512, (const bf16*)(ws + OFF_WBT) + (size_t)c0 * 512, 512, 512, bb);
        load64(GA + row * D_ + c0, ga); load64(GB + row * D_ + c0, gb);
#pragma unroll
        for (int j = 0; j < 64; ++j) a[j] = ga[j] * a[j] + gb[j] * bb[j];
        store64_bf16(MIX + row * D_ + c0, a);
    }
}
DEV void phase_outproj(const Params& p, long gt, long nth) {
    unsigned char* ws = p.ws; const bf16* MIX = (const bf16*)(ws + OFF_MIX); constexpr int NGRP = D_ / 64;
    for (size_t it = gt; it < (size_t)T_ * NGRP; it += nth) {
        const int c0 = (int)(it % NGRP) * 64; const size_t row = it / NGRP;
        float a[64];
#pragma unroll
        for (int j = 0; j < 64; ++j) a[j] = 0.f;
        dot64(MIX + row * D_, (const bf16*)(ws + OFF_WOT) + (size_t)c0 * D_, D_, D_, a);
#pragma unroll
        for (int j = 0; j < 64; ++j) p.out[row * D_ + c0 + j] = p.x[row * D_ + c0 + j] + a[j];
    }
}
DEV void phase_route(const Params& p, long gt, long nth) {
    unsigned char* ws = p.ws; bf16* TN = (bf16*)(ws + OFF_TN); int* RT = (int*)(ws + OFF_ROUTE);
    for (size_t row = gt; row < (size_t)T_; row += nth) {
        const float* xr = p.out + row * D_; float ss = 0.f; for (int k = 0; k < D_; ++k) ss += xr[k] * xr[k];
        const float rs = 1.0f / sqrtf(ss / D_ + RMS_EPS);
        float gl[4], el[16];
        for (int j = 0; j < 4; ++j) gl[j] = 0.f;
        for (int j = 0; j < 16; ++j) el[j] = 0.f;
        for (int k = 0; k < D_; ++k) { const float tv = xr[k] * rs * p.norm_ffn_g[k]; TN[row * D_ + k] = f2bf(tv);
#pragma unroll
            for (int j = 0; j < 4; ++j) gl[j] += tv * p.w_group[(size_t)k * 4 + j];
#pragma unroll
            for (int j = 0; j < 16; ++j) el[j] += tv * p.w_router[(size_t)k * 16 + j]; }
        int gtop = 0; float gm = -INFINITY;
#pragma unroll
        for (int j = 0; j < 4; ++j) { gl[j] += p.b_group[j]; if (gl[j] > gm) { gm = gl[j]; gtop = j; } }
        float gs = 0.f;
#pragma unroll
        for (int j = 0; j < 4; ++j) gs += expf(gl[j] - gm);
        const float pg = 1.0f / gs;
        float e4[4]; float em = -INFINITY; int i0 = 0;
#pragma unroll
        for (int j = 0; j < 4; ++j) { float v = 0.f;
#pragma unroll
            for (int g = 0; g < 4; ++g) v = (g == gtop) ? el[g * 4 + j] + p.b_router[g * 4 + j] : v;
            e4[j] = v; }
#pragma unroll
        for (int j = 0; j < 4; ++j) if (e4[j] > em) { em = e4[j]; i0 = j; }
        float e2 = -INFINITY; int i1 = 0;
#pragma unroll
        for (int j = 0; j < 4; ++j) if (j != i0 && e4[j] > e2) { e2 = e4[j]; i1 = j; }
        const float p0 = 1.0f, p1 = expf(e2 - em);
        const float w0 = p0 / (p0 + p1) * pg, w1 = p1 / (p0 + p1) * pg;
        RT[row * 4 + 0] = gtop * 4 + i0; RT[row * 4 + 1] = gtop * 4 + i1; RT[row * 4 + 2] = (int)f2u(w0); RT[row * 4 + 3] = (int)f2u(w1);
    }
}
DEV void phase_moe_up(const Params& p, long gt, long nth) {
    unsigned char* ws = p.ws; const bf16* TN = (const bf16*)(ws + OFF_TN); const int* RT = (const int*)(ws + OFF_ROUTE); bf16* HID = (bf16*)(ws + OFF_HID);
    constexpr int NGRP = DE_ / 64;
    for (size_t it = gt; it < (size_t)T_ * 2 * NGRP; it += nth) {
        const int c0 = (int)(it % NGRP) * 64; size_t r = it / NGRP; const int k = (int)(r % 2); const size_t row = r / 2;
        const int e = RT[row * 4 + k]; const float w = u2f((unsigned)RT[row * 4 + 2 + k]);
        float a[64], u[64];
#pragma unroll
        for (int j = 0; j < 64; ++j) { a[j] = 0.f; u[j] = 0.f; }
        dot64(TN + row * D_, (const bf16*)(ws + OFF_WGT) + ((size_t)e * DE_ + c0) * D_, D_, D_, a);
        dot64(TN + row * D_, (const bf16*)(ws + OFF_WUT) + ((size_t)e * DE_ + c0) * D_, D_, D_, u);
#pragma unroll
        for (int j = 0; j < 64; ++j) a[j] = w * (a[j] * sigmoidf_(a[j])) * u[j];
        store64_bf16(HID + row * (2 * DE_) + k * DE_ + c0, a);
    }
}
DEV void phase_moe_down(const Params& p, long gt, long nth) {
    unsigned char* ws = p.ws; const int* RT = (const int*)(ws + OFF_ROUTE); const bf16* HID = (const bf16*)(ws + OFF_HID); constexpr int NGRP = D_ / 64;
    for (size_t it = gt; it < (size_t)T_ * NGRP; it += nth) {
        const int c0 = (int)(it % NGRP) * 64; const size_t row = it / NGRP;
        float a[64];
#pragma unroll
        for (int j = 0; j < 64; ++j) a[j] = 0.f;
        for (int k = 0; k < 2; ++k) { const int e = RT[row * 4 + k]; dot64(HID + row * (2 * DE_) + k * DE_, (const bf16*)(ws + OFF_WDT) + ((size_t)e * D_ + c0) * DE_, DE_, DE_, a); }
#pragma unroll
        for (int j = 0; j < 64; ++j) p.out[row * D_ + c0 + j] += a[j];
    }
}

#ifndef CPU_EMU
typedef short bf16x8 __attribute__((ext_vector_type(8)));
typedef float f32x4 __attribute__((ext_vector_type(4)));
typedef unsigned u32x4 __attribute__((ext_vector_type(4)));
typedef unsigned u32x2 __attribute__((ext_vector_type(2)));
#define LDS3 __attribute__((address_space(3)))
constexpr int NW = CFG_NW, NTHREADS = 64 * NW, BM = 32 * NW;
constexpr int GEMM_NST = NW >= 8 ? 3 : 2, GEMM_STAGE = (128 + BM) * 128;
constexpr int LDS_TILE_BYTES = NW >= 8 ? GEMM_NST * GEMM_STAGE : 69632;
constexpr int BWL_OFF = LDS_TILE_BYTES + 32, BWL_BYTES = 128 * 20 * 4;
constexpr int LDS_BYTES = LDS_TILE_BYTES + 64 + BWL_BYTES;
static_assert(2 * LDS_BYTES <= 160 * 1024, "two workgroups per CU");
struct GemmSrc { const bf16* X; size_t ldx; const int* xidx; const bf16* W0; const bf16* W1; int ksplit; size_t ldw; int K; };
typedef float f32x2v __attribute__((ext_vector_type(2)));
typedef __bf16 bf16x2v __attribute__((ext_vector_type(2)));
DEV unsigned pk_bf16(float lo, float hi) { return __builtin_bit_cast(unsigned, __builtin_convertvector((f32x2v){lo, hi}, bf16x2v)); }
DEV void zero_acc(f32x4 (&acc)[4][4]) {
#pragma unroll
    for (int i = 0; i < 4; ++i)
#pragma unroll
        for (int j = 0; j < 4; ++j) acc[i][j] = (f32x4){0.f, 0.f, 0.f, 0.f};
}
DEV void glds16g(const void* g, unsigned lds) { lds = __builtin_amdgcn_readfirstlane(lds); asm volatile("s_mov_b32 m0, %1\n\ts_nop 0\n\tglobal_load_lds_dwordx4 %0, off" :: "v"(g), "s"(lds) : "memory"); }
template <int OFF> DEV bf16x8 frag_read(unsigned addr) { bf16x8 r; asm volatile("ds_read_b128 %0, %1 offset:%2" : "=&v"(r) : "v"(addr), "i"(OFF) : "memory"); return r; }
struct NoWait { DEV void operator()() const {} };
template <bool DB = true, class PW = NoWait>
DEV void gemm_mainloop(f32x4 (&acc)[4][4], const GemmSrc& g, int m0, int n0, unsigned char* smem, PW pw = PW(), int nm0 = -1, int nn0 = 0, bool pre = false) {
    constexpr int WP = 16 / NW, XP = BM / 8 / NW, NVMG = WP + XP;
    const int t = threadIdx.x, lane = t & 63, w = __builtin_amdgcn_readfirstlane(t >> 6), wn = w / (NW / 2), wm = w % (NW / 2);
    const int lr = 8 * w + (lane >> 3);
    const int gch = ((lane & 7) ^ ((4 * w + (lane >> 4)) & 7)) * 8;
    int xr[XP];
#pragma unroll
    for (int i = 0; i < XP; ++i) { int r = m0 + lr + 8 * NW * i; if (g.xidx) { r = g.xidx[r]; r = (unsigned)r < (unsigned)T_ ? r : 0; } xr[i] = r; }
    const size_t wrow0 = (size_t)(n0 + lr) * g.ldw + gch;
    const unsigned sbase = (unsigned)(size_t)(LDS3 unsigned char*)smem;
    const int fsw = ((lane >> 4) ^ ((lane & 15) >> 1)) << 4;
    const int waddr = (64 * wn + (lane & 15)) * 128 + fsw, xaddr = 16384 + (64 * wm + (lane & 15)) * 128 + fsw;
    const int nk = g.K / 64;
    auto gissue_w = [&](int kt) {
        const int k = kt * 64; const bf16* wb = (k < g.ksplit ? g.W0 + k : g.W1 + (k - g.ksplit)) + wrow0; const unsigned lb = sbase + (unsigned)((kt % GEMM_NST) * GEMM_STAGE + w * 1024);
#pragma unroll
        for (int i = 0; i < WP; ++i) glds16g(wb + (size_t)(8 * NW * i) * g.ldw, lb + i * (NW * 1024));
    };
    auto gissue_x = [&](int kt) {
        const int k = kt * 64; const unsigned lb = sbase + (unsigned)((kt % GEMM_NST) * GEMM_STAGE + w * 1024);
#pragma unroll
        for (int i = 0; i < XP; ++i) glds16g(g.X + (size_t)xr[i] * g.ldx + (gch + k), lb + 16384 + i * (NW * 1024));
    };
    auto gissue = [&](int kt) { gissue_w(kt); gissue_x(kt); };
    if (0 < nk && !pre) { gissue_w(0); pw(); }
    if (g.xidx) {
#pragma unroll
        for (int i = 0; i < XP; ++i) asm volatile("" :: "v"(xr[i]));
    }
    if (0 < nk && !pre) gissue_x(0);
#pragma unroll
    for (int j = 1; j < GEMM_NST - 1; ++j) if (j < nk) gissue(j);
    for (int kt = 0; kt < nk; ++kt) {
        const int ahead = nk - 1 - kt < GEMM_NST - 2 ? nk - 1 - kt : GEMM_NST - 2;
        if (ahead >= 2) asm volatile("s_waitcnt vmcnt(%0)" :: "n"(2 * NVMG) : "memory"); else if (ahead == 1) asm volatile("s_waitcnt vmcnt(%0)" :: "n"(NVMG) : "memory"); else asm volatile("s_waitcnt vmcnt(0)" ::: "memory");
        __builtin_amdgcn_s_barrier();
        asm volatile("" ::: "memory");
        if (kt + GEMM_NST - 1 < nk) gissue(kt + GEMM_NST - 1);
        else if (GEMM_NST == 2 && nm0 >= 0) {
            const bf16* wb = g.W0 + ((size_t)(nn0 + lr) * g.ldw + gch); const unsigned lb = sbase + (unsigned)(w * 1024);
#pragma unroll
            for (int i = 0; i < WP; ++i) glds16g(wb + (size_t)(8 * NW * i) * g.ldw, lb + i * (NW * 1024));
#pragma unroll
            for (int i = 0; i < XP; ++i) glds16g(g.X + (size_t)(nm0 + lr + 8 * NW * i) * g.ldx + gch, lb + 16384 + i * (NW * 1024));
        }
        const unsigned char* b = smem + (kt % GEMM_NST) * GEMM_STAGE;
        if (DB) {
            const unsigned ba = sbase + (unsigned)((kt % GEMM_NST) * GEMM_STAGE), w0 = ba + (unsigned)waddr, x0 = ba + (unsigned)xaddr, w1 = ba + (unsigned)(waddr ^ 64), x1 = ba + (unsigned)(xaddr ^ 64);
            const bf16x8 wa0 = frag_read<0>(w0), xa0 = frag_read<0>(x0), xa1 = frag_read<2048>(x0), xa2 = frag_read<4096>(x0), xa3 = frag_read<6144>(x0), wa1 = frag_read<2048>(w0), wa2 = frag_read<4096>(w0), wa3 = frag_read<6144>(w0);
            const bf16x8 wb0 = frag_read<0>(w1), xb0 = frag_read<0>(x1), xb1 = frag_read<2048>(x1), xb2 = frag_read<4096>(x1), xb3 = frag_read<6144>(x1), wb1 = frag_read<2048>(w1), wb2 = frag_read<4096>(w1), wb3 = frag_read<6144>(w1);
            asm volatile("s_waitcnt lgkmcnt(8)" ::: "memory"); __builtin_amdgcn_sched_barrier(0);
            __builtin_amdgcn_s_setprio(1);
#define ROW(i, WF, X0, X1, X2, X3) acc[i][0] = __builtin_amdgcn_mfma_f32_16x16x32_bf16(WF, X0, acc[i][0], 0, 0, 0); acc[i][1] = __builtin_amdgcn_mfma_f32_16x16x32_bf16(WF, X1, acc[i][1], 0, 0, 0); acc[i][2] = __builtin_amdgcn_mfma_f32_16x16x32_bf16(WF, X2, acc[i][2], 0, 0, 0); acc[i][3] = __builtin_amdgcn_mfma_f32_16x16x32_bf16(WF, X3, acc[i][3], 0, 0, 0);
            ROW(0, wa0, xa0, xa1, xa2, xa3) ROW(1, wa1, xa0, xa1, xa2, xa3) ROW(2, wa2, xa0, xa1, xa2, xa3) ROW(3, wa3, xa0, xa1, xa2, xa3)
            __builtin_amdgcn_sched_barrier(0); asm volatile("s_waitcnt lgkmcnt(0)" ::: "memory"); __builtin_amdgcn_sched_barrier(0);
            ROW(0, wb0, xb0, xb1, xb2, xb3) ROW(1, wb1, xb0, xb1, xb2, xb3) ROW(2, wb2, xb0, xb1, xb2, xb3) ROW(3, wb3, xb0, xb1, xb2, xb3)
#undef ROW
            __builtin_amdgcn_s_setprio(0);
        } else {
#pragma unroll
        for (int kk = 0; kk < 2; ++kk) {
            bf16x8 wf[4], xf[4];
#pragma unroll
            for (int i = 0; i < 4; ++i) { wf[i] = *(const bf16x8*)(b + ((waddr ^ (kk << 6)) + i * 2048)); xf[i] = *(const bf16x8*)(b + ((xaddr ^ (kk << 6)) + i * 2048)); }
            __builtin_amdgcn_s_setprio(1);
#pragma unroll
            for (int i = 0; i < 4; ++i)
#pragma unroll
                for (int j = 0; j < 4; ++j) acc[i][j] = __builtin_amdgcn_mfma_f32_16x16x32_bf16(wf[i], xf[j], acc[i][j], 0, 0, 0);
            __builtin_amdgcn_s_setprio(0);
        }
        }
    }
    asm volatile("s_waitcnt lgkmcnt(0)" ::: "memory");
    __builtin_amdgcn_s_barrier();
    asm volatile("" ::: "memory");
}
DEV int vblock() { const int G = gridDim.x, b = blockIdx.x; return (G % 8 == 0) ? (b % 8) * (G / 8) + b / 8 : b; }
DEV void tile_coords(int lin, int ntm, int ntn, int& pm, int& pn) { const int grp = lin / (8 * ntn), rem = lin % (8 * ntn), fm = grp * 8, gsz = (ntm - fm) < 8 ? (ntm - fm) : 8; pm = fm + rem % gsz; pn = rem / gsz; }
DEV float rsum16(float v) { v += __shfl_xor(v, 16); v += __shfl_xor(v, 32); return v; }

DEV u32x4 widen_pair(u32x2 a, u32x2 b) { auto r0 = __builtin_amdgcn_permlane16_swap(a.x, b.x, false, false); auto r1 = __builtin_amdgcn_permlane16_swap(a.y, b.y, false, false); return (u32x4){r0[0], r1[0], r0[1], r1[1]}; }
DEV u32x4 widen_half(u32x2 a, u32x2 b) { auto r0 = __builtin_amdgcn_permlane32_swap(a.x, b.x, false, false); auto r1 = __builtin_amdgcn_permlane32_swap(a.y, b.y, false, false); return (u32x4){r0[0], r1[0], r0[1], r1[1]}; }
DEV void st_dev16(void* ptr, u32x4 v) { asm volatile("global_store_dwordx4 %0, %1, off sc1\n\ts_nop 1" :: "v"(ptr), "v"(v) : "memory"); }
DEV void st_dev(void* ptr, u32x2 v) { __hip_atomic_store((unsigned long long*)ptr, __builtin_bit_cast(unsigned long long, v), __ATOMIC_RELAXED, __HIP_MEMORY_SCOPE_AGENT); }
DEV void st_dev(float* ptr, float v) { __hip_atomic_store(ptr, v, __ATOMIC_RELAXED, __HIP_MEMORY_SCOPE_AGENT); }
DEV f32x2v ld_dev(const float* ptr) { return __builtin_bit_cast(f32x2v, __hip_atomic_load((const unsigned long long*)ptr, __ATOMIC_RELAXED, __HIP_MEMORY_SCOPE_AGENT)); }
DEV void bphase_inproj(const Params& p, unsigned char* smem) {
    unsigned char* ws = p.ws; const int lane = threadIdx.x & 63, w = threadIdx.x >> 6, wn = w / (NW / 2), wm = w % (NW / 2), q = lane >> 4, c = lane & 15;
    constexpr int NTM = T_ / BM, NTN = NP / 128;
    GemmSrc g{(const bf16*)((unsigned char*)p.out + DO_H), (size_t)D_, nullptr, (const bf16*)(ws + OFF_WINT), (const bf16*)(ws + OFF_WINT), 1 << 30, (size_t)D_, D_};
    bool pre = false;
    for (int lin = vblock(); lin < NTM * NTN; lin += gridDim.x) {
        int pm, pn; tile_coords(lin, NTM, NTN, pm, pn); const int m0 = pm * BM, n0 = pn * 128;
        int nm0 = -1, nn0 = 0; if (lin + (int)gridDim.x < NTM * NTN) { int qm, qn; tile_coords(lin + (int)gridDim.x, NTM, NTN, qm, qn); nm0 = qm * BM; nn0 = qn * 128; }
        f32x4 acc[4][4]; zero_acc(acc);
        gemm_mainloop(acc, g, m0, n0, smem, NoWait(), nm0, nn0, pre); pre = nm0 >= 0;
        const int n0w = n0 + 64 * wn, m0w = m0 + 64 * wm, b = m0 / S_, s0 = m0w % S_;
        if (n0 < C_GA) {
            bf16* dst; const float* gain = nullptr; float mul = 1.f;
            if (n0 < C_KC) { const int which = n0 / 512, h = (n0w % 512) / 64;
                dst = (bf16*)(ws + (which == 0 ? OFF_FQ : which == 1 ? OFF_FK : which == 2 ? OFF_FV : OFF_NQ)) + ((size_t)b * 8 + h) * S_ * 64;
                if (which != 2) { gain = which == 0 ? p.fox_q_g : which == 1 ? p.fox_k_g : p.nsa_q_g; mul = which == 1 ? 1.f : QSCALE; } }
            else { const int which = (n0 - C_KC) / 128; dst = (bf16*)(ws + OFF_KCR + (size_t)which * SZ_KV) + ((size_t)b * 2 + wn) * S_ * 64; if (which == 2 || which == 4) gain = p.nsa_k_g; }
            f32x4 g4[4];
#pragma unroll
            for (int nf = 0; nf < 4; ++nf) g4[nf] = gain ? *(const f32x4*)(gain + 16 * nf + 4 * q) : (f32x4){1.f, 1.f, 1.f, 1.f};
#pragma unroll
            for (int mf = 0; mf < 4; ++mf) {
                float rs = 1.f;
                if (gain) { float ss = 0.f;
#pragma unroll
                    for (int nf = 0; nf < 4; ++nf) { const f32x4 v = acc[nf][mf]; ss += (v[0] * v[0] + v[1] * v[1]) + (v[2] * v[2] + v[3] * v[3]); }
                    rs = 1.0f / sqrtf(rsum16(ss) * (1.0f / 64) + RMS_EPS) * mul; }
                bf16* drow = dst + (size_t)(s0 + 16 * mf + c) * 64 + 4 * q + ((q & 1) ? 12 : 0);
#pragma unroll
                for (int nf = 0; nf < 4; nf += 2) { const f32x4 v = acc[nf][mf] * rs * g4[nf], v2 = acc[nf + 1][mf] * rs * g4[nf + 1];
                    *(u32x4*)(drow + 16 * nf) = widen_pair((u32x2){pk_bf16(v[0], v[1]), pk_bf16(v[2], v[3])}, (u32x2){pk_bf16(v2[0], v2[1]), pk_bf16(v2[2], v2[3])}); }
            }
        } else if (n0 < C_FF) {
            const bool isb = n0 >= C_GB; bf16* dst = (bf16*)(ws + (isb ? OFF_GB : OFF_GA)) + (n0w - (isb ? C_GB : C_GA)) + 4 * q + ((q & 1) ? 12 : 0);
#pragma unroll
            for (int mf = 0; mf < 4; ++mf) { bf16* drow = dst + (size_t)(m0w + 16 * mf + c) * D_;
#pragma unroll
                for (int nf = 0; nf < 4; nf += 2) { const f32x4 v = acc[nf][mf], v2 = acc[nf + 1][mf];
                    *(u32x4*)(drow + 16 * nf) = widen_pair((u32x2){pk_bf16(sigmoidf_(v[0]), sigmoidf_(v[1])), pk_bf16(sigmoidf_(v[2]), sigmoidf_(v[3]))}, (u32x2){pk_bf16(sigmoidf_(v2[0]), sigmoidf_(v2[1])), pk_bf16(sigmoidf_(v2[2]), sigmoidf_(v2[3]))}); } }
        } else if (wn == 0) {
            float* lf = (float*)(ws + OFF_LOGF); float* gt_ = (float*)(ws + OFF_GATE);
#pragma unroll
            for (int mf = 0; mf < 4; ++mf) { const int m = m0w + 16 * mf + c, s = m % S_;
#pragma unroll
                for (int r = 0; r < 4; ++r) { const int j = 4 * q + r; const float v0 = acc[0][mf][r];
                    if (j < 8) { const float v = v0 + p.b_forget[j]; lf[((size_t)b * 8 + j) * S_ + s] = fminf(v, 0.f) - log1pf(expf(-fabsf(v))); }
                    else gt_[(size_t)m * 24 + (j - 8)] = sigmoidf_(v0);
                    gt_[(size_t)m * 24 + 8 + j] = sigmoidf_(acc[1][mf][r]); } }
        }
    }
}
DEV bf16* ao_row(const Params& p, int which  , int b, int q) { return (bf16*)((unsigned char*)p.out + (size_t)(q / BM) * ((size_t)BM * D_ * 4) + (size_t)(which * 2 + b) * ((size_t)BM * 1024) + (size_t)(q % BM) * 1024); }
template <class PW>
DEV void up_tile(const Params& p, unsigned char* smem, int pm, int pn, PW pw) {
    unsigned char* ws = p.ws; asm volatile("" : "+v"(ws)); int t = threadIdx.x; asm volatile("" : "+v"(t)); const int lane = t & 63, w = t >> 6, wn = w / (NW / 2), wm = w % (NW / 2), q = lane >> 4, c = lane & 15;
    GemmSrc ga{ao_row(p, 0, pm / (S_ / BM), (pm % (S_ / BM)) * BM), 512, nullptr, (const bf16*)(ws + OFF_WAT), (const bf16*)(ws + OFF_WAT), 1 << 30, 512, 512};
    GemmSrc gb{ao_row(p, 1, pm / (S_ / BM), (pm % (S_ / BM)) * BM), 512, nullptr, (const bf16*)(ws + OFF_WBT), (const bf16*)(ws + OFF_WBT), 1 << 30, 512, 512};
    const bf16* GA = (const bf16*)(ws + OFF_GA); const bf16* GB = (const bf16*)(ws + OFF_GB); bf16* MIX = (bf16*)(ws + OFF_MIX);
    {
        const int m0 = pm * BM, n0 = pn * 128;
        f32x4 acc[4][4], acc2[4][4]; zero_acc(acc); zero_acc(acc2);
        gemm_mainloop<false, PW>(acc, ga, 0, n0, smem, pw);
        gemm_mainloop<false>(acc2, gb, 0, n0, smem);
        const int n0w = n0 + 64 * wn, m0w = m0 + 64 * wm;
        const unsigned eoff = (unsigned)(((size_t)(m0w + c) * D_ + n0w + 4 * q) * 2);
#pragma unroll
        for (int mf = 0; mf < 4; ++mf) {
            u32x2 pk[4];
#pragma unroll
            for (int nf = 0; nf < 4; ++nf) { const unsigned off = eoff + (unsigned)(mf * 16 * D_ * 2 + nf * 32); const u32x2 gv = __builtin_nontemporal_load((const u32x2*)((const unsigned char*)GA + off)), hv = __builtin_nontemporal_load((const u32x2*)((const unsigned char*)GB + off));
                const f32x4 v = acc[nf][mf] * (f32x4){u2f(gv.x << 16), u2f(gv.x & 0xffff0000u), u2f(gv.y << 16), u2f(gv.y & 0xffff0000u)} + acc2[nf][mf] * (f32x4){u2f(hv.x << 16), u2f(hv.x & 0xffff0000u), u2f(hv.y << 16), u2f(hv.y & 0xffff0000u)};
                pk[nf] = (u32x2){pk_bf16(v[0], v[1]), pk_bf16(v[2], v[3])}; }
#pragma unroll
            for (int nf = 0; nf < 4; nf += 2) st_dev16((unsigned char*)MIX + eoff + (unsigned)(mf * 16 * D_ * 2 + nf * 32) + ((q & 1) ? 24u : 0u), widen_pair(pk[nf], pk[nf + 1]));
            asm volatile("" ::: "memory"); }
    }
}
template <class PW>
DEV void out_tile(const Params& p, unsigned char* smem, int pm, int pn, PW pw) {
    unsigned char* ws = p.ws; asm volatile("" : "+v"(ws)); int t = threadIdx.x; asm volatile("" : "+v"(t)); const int lane = t & 63, w = t >> 6, wn = w / (NW / 2), wm = w % (NW / 2), q = lane >> 4, c = lane & 15;
    GemmSrc g{(const bf16*)(ws + OFF_MIX), (size_t)D_, nullptr, (const bf16*)(ws + OFF_WOT), (const bf16*)(ws + OFF_WOT), 1 << 30, (size_t)D_, D_};
    {
        const int m0 = pm * BM, n0 = pn * 128;
        f32x4 acc[4][4]; zero_acc(acc);
        const int n0w = n0 + 64 * wn, m0w = m0 + 64 * wm; float* ssp = (float*)(ws + OFF_SSP);
        {
            const unsigned lb = (unsigned)(size_t)(LDS3 unsigned char*)smem + BWL_OFF; const unsigned char* src = ws + OFF_BW + (size_t)n0 * 80 + lane * 16;
            const int w1 = __builtin_amdgcn_readfirstlane(w);
            for (int ch = w1; ch < BWL_BYTES / 1024; ch += NW) glds16g(src + ch * 1024, lb + ch * 1024);
        }
        f32x4 xv[4][4];
#pragma unroll
        for (int mf = 0; mf < 4; ++mf)
#pragma unroll
            for (int nf = 0; nf < 4; ++nf) xv[mf][nf] = __builtin_nontemporal_load((const f32x4*)(p.x + (size_t)(m0w + 16 * mf + c) * D_ + n0w + 16 * nf + 4 * q));
        gemm_mainloop<true, PW>(acc, g, m0, n0, smem, pw);
        const float* bwl = (const float*)(smem + BWL_OFF) + (64 * wn + 4 * q) * 20 + c; bf16* TN = (bf16*)(ws + OFF_TN);
        f32x4 gf[4];
#pragma unroll
        for (int nf = 0; nf < 4; ++nf) gf[nf] = *(const f32x4*)(p.norm_ffn_g + n0w + 16 * nf + 4 * q);
        float* red = (float*)smem;
#pragma unroll
        for (int mf = 0; mf < 4; ++mf) { float ss = 0.f; f32x4 a0 = {0.f, 0.f, 0.f, 0.f}, a1 = {0.f, 0.f, 0.f, 0.f}; u32x2 tnp[4];
#pragma unroll
            for (int nf = 0; nf < 4; ++nf) { const size_t off = (size_t)(m0w + 16 * mf + c) * D_ + n0w + 16 * nf + 4 * q; const f32x4 v = xv[mf][nf] + acc[nf][mf]; ss += (v[0] * v[0] + v[1] * v[1]) + (v[2] * v[2] + v[3] * v[3]);
                const f32x4 tv = v * gf[nf]; tnp[nf] = (u32x2){pk_bf16(tv[0], tv[1]), pk_bf16(tv[2], tv[3])};
#pragma unroll
                for (int i = 0; i < 4; ++i) { const float b0 = bwl[(16 * nf + i) * 20], b1 = c < 4 ? bwl[(16 * nf + i) * 20 + 16] : 0.f; a0 = __builtin_amdgcn_mfma_f32_16x16x4f32(v[i], b0, a0, 0, 0, 0); a1 = __builtin_amdgcn_mfma_f32_16x16x4f32(v[i], b1, a1, 0, 0, 0); } }
            { bf16* trow = TN + (size_t)(m0w + 16 * mf + c) * D_ + n0w + 4 * q + ((q & 1) ? 12 : 0);
#pragma unroll
              for (int nf = 0; nf < 4; nf += 2) *(u32x4*)(trow + 16 * nf) = widen_pair(tnp[nf], tnp[nf + 1]); }
            ss = rsum16(ss); if (q == 0) red[(wn * BM + 64 * wm + 16 * mf + c) * 24 + 20] = ss;
            float* rr = red + (wn * BM + 64 * wm + 16 * mf + 4 * q) * 24 + c;
#pragma unroll
            for (int r = 0; r < 4; ++r) { rr[r * 24] = a0[r]; if (c < 4) rr[r * 24 + 16] = a1[r]; } }
        __syncthreads();
        float* plt = (float*)(ws + OFF_PL) + ((size_t)pn * T_ + m0) * 20;
        for (int idx = t; idx < BM * 5; idx += NTHREADS) { const int row = idx / 5, k = idx % 5; const f32x4 v = *(const f32x4*)(red + row * 24 + 4 * k) + *(const f32x4*)(red + (BM + row) * 24 + 4 * k);
            st_dev16(plt + 4 * idx, (u32x4){f2u(v[0]), f2u(v[1]), f2u(v[2]), f2u(v[3])}); }
        if (t < BM) st_dev(ssp + (size_t)pn * T_ + m0 + t, red[t * 24 + 20] + red[(BM + t) * 24 + 20]);
    }
}

struct TrJob { const float* src; int ldsrc; bf16* dst; int lddst; int kind; int e; };
DEV void transpose_tile(const TrJob& j, int r0, int k0, bool dev) {
    const int lane = threadIdx.x & 63;
    const float* colp; bool valid = true;
    if (j.kind == 0) colp = j.src + (r0 + lane);
    else if (j.kind == 1) { const int oc = orig_col(r0 + lane); valid = oc >= 0; colp = j.src + (valid ? oc : 0); }
    else { const int jj = (r0 / 64) * 32 + (lane & 31); colp = j.src + jj; }
    colp += (size_t)k0 * j.ldsrc;
    bf16* drow = j.dst + (size_t)(r0 + lane) * j.lddst + k0;
    {
        float v[64];
#pragma unroll
        for (int kk = 0; kk < 64; ++kk) v[kk] = valid ? __builtin_nontemporal_load(colp + (size_t)kk * j.ldsrc) : 0.f;
#pragma unroll
        for (int c8 = 0; c8 < 8; ++c8) {
            if (dev) st_dev16(drow + 8 * c8, (u32x4){pk_bf16(v[8 * c8], v[8 * c8 + 1]), pk_bf16(v[8 * c8 + 2], v[8 * c8 + 3]), pk_bf16(v[8 * c8 + 4], v[8 * c8 + 5]), pk_bf16(v[8 * c8 + 6], v[8 * c8 + 7])});
            else *(u32x4*)(drow + 8 * c8) = (u32x4){pk_bf16(v[8 * c8], v[8 * c8 + 1]), pk_bf16(v[8 * c8 + 2], v[8 * c8 + 3]), pk_bf16(v[8 * c8 + 4], v[8 * c8 + 5]), pk_bf16(v[8 * c8 + 6], v[8 * c8 + 7])}; }
    }
}
constexpr int T_WIN = (NP / 64) * (D_ / 64), T_WA = (D_ / 64) * (512 / 64), T_WO = (D_ / 64) * (D_ / 64), T_W1 = (256 / 64) * (2048 / 64), T_W2 = (64 / 64) * (256 / 64),
              T_GU = (2 * DE_ / 64) * (D_ / 64), T_WD = (D_ / 64) * (DE_ / 64);
constexpr int NJOB0 = T_WIN + 2 * T_W1 + 2 * T_W2, NJOB1 = 2 * T_WA + T_WO, NJOB2 = NE * (T_GU + T_WD);
DEV void prep_job(const Params& p, int stage, int r) {
    unsigned char* ws = p.ws; asm volatile("" : "+v"(ws)); const int lane = threadIdx.x & 63; TrJob j; int K = D_;
    if (stage == 0) {
        if (r < T_WIN) { j = TrJob{p.w_in, D_IN, (bf16*)(ws + OFF_WINT), D_, 1, 0}; K = D_; }
        else if ((r -= T_WIN) < 2 * T_W1) { const int kv = r / T_W1; r %= T_W1; j = TrJob{kv ? p.cmp_v_w1 : p.cmp_k_w1, 256, (bf16*)(ws + OFF_W1T) + (size_t)kv * 256 * 2048, 2048, 0, 0}; K = 2048; }
        else { r -= 2 * T_W1; const int kv = r / T_W2; r %= T_W2; j = TrJob{kv ? p.cmp_v_w2 : p.cmp_k_w2, 64, (bf16*)(ws + OFF_W2T) + (size_t)kv * 128 * 256, 256, 0, 0}; K = 256; }
    } else if (stage == 1) {
        if (r < T_WA) { j = TrJob{p.w_fox_up, D_, (bf16*)(ws + OFF_WAT), 512, 0, 0}; K = 512; }
        else if ((r -= T_WA) < T_WA) { j = TrJob{p.w_nsa_up, D_, (bf16*)(ws + OFF_WBT), 512, 0, 0}; K = 512; }
        else { r -= T_WA; j = TrJob{p.w_out, D_, (bf16*)(ws + OFF_WOT), D_, 0, 0}; K = D_; }
    } else {
        if (r < NE * T_GU) { const int e = r / T_GU; r %= T_GU; j = TrJob{nullptr, DE_, (bf16*)(ws + OFF_WGT) + (size_t)e * 2 * DE_ * D_, D_, 2, e}; K = D_; }
        else { r -= NE * T_GU; const int e = r / T_WD; r %= T_WD; j = TrJob{p.w_down + (size_t)e * DE_ * D_, D_, (bf16*)(ws + OFF_WDT) + (size_t)e * D_ * DE_, DE_, 0, 0}; K = DE_; }
    }
    const int nkt = K / 64, r0 = (r / nkt) * 64, k0 = (r % nkt) * 64;
    if (j.kind == 2) { const float* wg = p.w_gate; const float* wu = p.w_up; asm volatile("" : "+v"(wg)); asm volatile("" : "+v"(wu));
        j.src = ((lane < 32) ? wg : wu) + (size_t)j.e * D_ * DE_; }
    transpose_tile(j, r0, k0, stage == 1);
}
DEV void route_item(const Params& p, unsigned char* smem, int R) {
    unsigned char* ws = p.ws; asm volatile("" : "+v"(ws)); int t = threadIdx.x; asm volatile("" : "+v"(t));
    unsigned* cnt = (unsigned*)(ws + OFF_CTL) + CTL_CNT; const size_t stoff = OFF_STOK, swoff = OFF_SW;
    static_assert(NTHREADS == 2 * BM, "two threads per token");
    const int half = t & 1; const size_t row = (size_t)R * BM + (t >> 1); float* l = (float*)smem + (t >> 1) * 21;
    f32x2v acc[10]; float ss = 0.f;
#pragma unroll
    for (int j = 0; j < 10; ++j) acc[j] = (f32x2v){0.f, 0.f};
#pragma unroll
    for (int pp = 0; pp < 4; ++pp) { const int part = 4 * half + pp; const float* pl = (const float*)(ws + OFF_PL) + ((size_t)part * T_ + row) * 20;
#pragma unroll
        for (int j = 0; j < 10; ++j) acc[j] += ld_dev(pl + 2 * j);
        ss += __hip_atomic_load((const float*)(ws + OFF_SSP) + (size_t)part * T_ + row, __ATOMIC_RELAXED, __HIP_MEMORY_SCOPE_AGENT); }
#pragma unroll
    for (int j = 0; j < 10; ++j) { acc[j][0] += __shfl_xor(acc[j][0], 1); acc[j][1] += __shfl_xor(acc[j][1], 1); }
    ss += __shfl_xor(ss, 1);
    if (half == 0) {
        const float rsr = 1.0f / sqrtf(ss / D_ + RMS_EPS);
        ((float*)(ws + OFF_RS))[row] = rsr;
#pragma unroll
        for (int j = 0; j < 10; ++j) { l[2 * j] = acc[j][0]; l[2 * j + 1] = acc[j][1]; }
        float gl[4]; int gtop = 0; float gm = -INFINITY;
#pragma unroll
        for (int j = 0; j < 4; ++j) { gl[j] = l[16 + j] * rsr + p.b_group[j]; if (gl[j] > gm) { gm = gl[j]; gtop = j; } }
        float gs = 0.f;
#pragma unroll
        for (int j = 0; j < 4; ++j) gs += expf(gl[j] - gm);
        const float pg = 1.0f / gs;
        float e4[4]; float em = -INFINITY; int i0 = 0;
#pragma unroll
        for (int j = 0; j < 4; ++j) { e4[j] = l[gtop * 4 + j] * rsr + p.b_router[gtop * 4 + j]; if (e4[j] > em) { em = e4[j]; i0 = j; } }
        float e2 = -INFINITY; int i1 = 0;
#pragma unroll
        for (int j = 0; j < 4; ++j) if (j != i0 && e4[j] > e2) { e2 = e4[j]; i1 = j; }
        const float p1 = expf(e2 - em); const float w0 = 1.0f / (1.0f + p1) * pg, w1 = p1 / (1.0f + p1) * pg;
        const int lo = i0 < i1 ? i0 : i1, hi = i0 < i1 ? i1 : i0; const int pidx = lo == 0 ? hi - 1 : (lo == 1 ? hi + 1 : 5);
        const int cls = gtop * 6 + pidx;
        const unsigned rank = atomicAdd(cnt + cls * CST, 1u);
        ((int*)(ws + stoff))[(size_t)cls * T_ + rank] = (int)row; float* swp = (float*)(ws + swoff) + ((size_t)cls * T_ + rank) * 2; swp[0] = i0 < i1 ? w0 : w1; swp[1] = i0 < i1 ? w1 : w0;
    }
}
DEV void class_experts(int cls, int& elo, int& ehi) { const int g = cls / 6, pi = cls % 6; const int lo = pi < 3 ? 0 : (pi < 5 ? 1 : 2); const int hi = pi < 3 ? pi + 1 : (pi < 5 ? pi - 1 : 3); elo = g * 4 + lo; ehi = g * 4 + hi; }
DEV int moe_find_class(const unsigned* cnt, int mtile_lin, int& tile0, int& ntc) {
    int t0 = 0;
    for (int k = 0; k < NCLS; ++k) { const int n = (int)((cnt[k * CST] + (unsigned)(BM - 1)) / (unsigned)BM); if (mtile_lin < t0 + n) { tile0 = t0; ntc = n; return k; } t0 += n; }
    return -1;
}
DEV int moe_total_tiles(const unsigned* cnt) { int t0 = 0; for (int k = 0; k < NCLS; ++k) t0 += (int)((cnt[k * CST] + (unsigned)(BM - 1)) / (unsigned)BM); return t0; }
DEV void dep_post(unsigned* ctr, bool wb);
DEV void dep_wait(unsigned* ctr, unsigned target, unsigned* bar, bool acq);
DEV unsigned xb_xcc_id();
DEV void bphase_moe_up(const Params& p, unsigned char* smem) {
    unsigned char* ws = p.ws; const int lane = threadIdx.x & 63, w = threadIdx.x >> 6, wn = w / (NW / 2), wm = w % (NW / 2), q = lane >> 4, c = lane & 15;
    const unsigned* cnt = (const unsigned*)(ws + OFF_CTL) + CTL_CNT; bf16* HID = (bf16*)(ws + OFF_HID);
    constexpr int NTN = (2 * 2 * DE_) / 128, NTE = NTN / 2;
    int* ctab = (int*)(smem + 65536);
    if (threadIdx.x < NCLS) ctab[threadIdx.x] = (int)cnt[threadIdx.x * CST];
    __syncthreads();
    int tot = 0;
    for (int k = 0; k < NCLS; ++k) tot += (ctab[k] + (BM - 1)) / BM;
    unsigned* pend = nullptr;
    for (int lin = vblock(); lin < tot * NTN; lin += gridDim.x) {
        int cls = -1, t0 = 0, ntc = 0, acc_t = 0;
        for (int k = 0; k < NCLS; ++k) { const int n = (ctab[k] + (BM - 1)) / BM; if (cls < 0 && lin < (acc_t + n) * NTN) { cls = k; t0 = acc_t; ntc = n; } acc_t += n; }
        const int idin = lin - t0 * NTN, nt = idin / ntc, mt = idin % ntc; const int slot0 = (t0 + mt) * BM;
        int elo, ehi; class_experts(cls, elo, ehi); const int half = nt / NTE, e = half ? ehi : elo; const int n0 = (nt % NTE) * 128;
        const bf16* wb = (const bf16*)(ws + OFF_WGT) + (size_t)e * (2 * DE_) * D_;
        const int* st = (const int*)(ws + OFF_STOK) + (size_t)cls * T_; const float* sw = (const float*)(ws + OFF_SW) + (size_t)cls * T_ * 2;
        GemmSrc g{(const bf16*)(ws + OFF_TN), (size_t)D_, st, wb, wb, 1 << 30, (size_t)D_, D_};
        f32x4 acc[4][4]; zero_acc(acc);
        float wt4[4], rs4[4];
        { const unsigned ncl = (unsigned)ctab[cls];
#pragma unroll
          for (int mf = 0; mf < 4; ++mf) { const int rk = mt * BM + 64 * wm + 16 * mf + c; const bool vr = (unsigned)rk < ncl; rs4[mf] = __builtin_bit_cast(float, vr ? st[rk] : -1); wt4[mf] = vr ? sw[2 * rk + half] : 0.f; } }
        gemm_mainloop<true>(acc, g, mt * BM, n0, smem, [&]() {
#pragma unroll
            for (int mf = 0; mf < 4; ++mf) { const int tok = __builtin_bit_cast(int, rs4[mf]); rs4[mf] = tok >= 0 ? ((const float*)(ws + OFF_RS))[tok] : 0.f; } });
        if (pend && threadIdx.x == 0) (void)__hip_atomic_fetch_add(pend, 1u, __ATOMIC_RELAXED, __HIP_MEMORY_SCOPE_AGENT);
        pend = (unsigned*)(ws + OFF_CTL) + CTL_HIDDONE + 4 * (t0 + mt);
        const int j0 = ((n0 + 64 * wn) / 64) * 32;
#pragma unroll
        for (int mf = 0; mf < 4; ++mf) { const int slot = slot0 + 64 * wm + 16 * mf + c; const float wt = wt4[mf], rsr = rs4[mf]; bf16* drow = HID + (size_t)slot * (2 * DE_) + half * DE_ + j0 + 4 * q;
            u32x2 hk[2];
#pragma unroll
            for (int nf = 0; nf < 2; ++nf) { const f32x4 gv = acc[nf][mf], uv = acc[nf + 2][mf]; f32x4 h;
#pragma unroll
                for (int r = 0; r < 4; ++r) { const float gs = gv[r] * rsr; h[r] = wt * (gs * sigmoidf_(gs)) * (uv[r] * rsr); }
                hk[nf] = (u32x2){pk_bf16(h[0], h[1]), pk_bf16(h[2], h[3])}; }
            st_dev16(drow + ((q & 1) ? 12 : 0), widen_pair(hk[0], hk[1])); }
    }
    if (pend) dep_post(pend, false);
}
DEV void bphase_moe_down(const Params& p, unsigned char* smem) {
    unsigned char* ws = p.ws; const int lane = threadIdx.x & 63, w = threadIdx.x >> 6, wn = w / (NW / 2), wm = w % (NW / 2), q = lane >> 4, c = lane & 15;
    const unsigned* cnt = (const unsigned*)(ws + OFF_CTL) + CTL_CNT;
    constexpr int NTN = D_ / 128;
    const int* ctab = (const int*)(smem + 65536);
    int tot = 0;
    for (int k = 0; k < NCLS; ++k) tot += (ctab[k] + (BM - 1)) / BM;
    unsigned* ctl = (unsigned*)(ws + OFF_CTL); int* slot = (int*)(smem + LDS_BYTES - 16); const unsigned x = xb_xcc_id() & 7u;
    for (unsigned s8 = 0; s8 < 8; ++s8) { const unsigned xq = (x + s8) & 7u;
      for (;;) {
        if (threadIdx.x == 0) slot[0] = (int)atomicAdd(ctl + CTL_MDQ + 64 * xq, 1u);
        __syncthreads();
        const int nq = slot[0];
        __syncthreads();
        const int lin = ((nq >> 6) * 8 + (int)xq) * 64 + (nq & 63);
        if ((lin & ~63) >= tot * NTN) break;
        if (lin >= tot * NTN) continue;
        int cls = -1, t0 = 0, ntc = 0, acc_t = 0;
        for (int k = 0; k < NCLS; ++k) { const int n = (ctab[k] + (BM - 1)) / BM; if (cls < 0 && lin < (acc_t + n) * NTN) { cls = k; t0 = acc_t; ntc = n; } acc_t += n; }
        const int idin = lin - t0 * NTN, nt = idin / ntc, mt = idin % ntc; const int slot0 = (t0 + mt) * BM, n0 = nt * 128;
        int elo, ehi; class_experts(cls, elo, ehi);
        GemmSrc g{(const bf16*)(ws + OFF_HID), (size_t)(2 * DE_), nullptr, (const bf16*)(ws + OFF_WDT) + (size_t)elo * D_ * DE_, (const bf16*)(ws + OFF_WDT) + (size_t)ehi * D_ * DE_, DE_, (size_t)DE_, 2 * DE_};
        f32x4 acc[4][4]; zero_acc(acc);
        const int n0w = n0 + 64 * wn; const unsigned ncl = (unsigned)ctab[cls];
        u32x2 xv[4][4]; int tk[4];
#pragma unroll
        for (int mf = 0; mf < 4; ++mf) { const int rk = mt * BM + 64 * wm + 16 * mf + c; tk[mf] = (unsigned)rk < ncl ? ((const int*)(ws + OFF_STOK))[(size_t)cls * T_ + rk] : -1; }
        f32x4 rg[4];
#pragma unroll
        for (int nf = 0; nf < 4; ++nf) { const f32x4 gg = *(const f32x4*)(p.norm_ffn_g + n0w + 16 * nf + 4 * q); rg[nf] = (f32x4){__builtin_amdgcn_rcpf(gg[0]), __builtin_amdgcn_rcpf(gg[1]), __builtin_amdgcn_rcpf(gg[2]), __builtin_amdgcn_rcpf(gg[3])}; }
        { unsigned* hd = ctl + CTL_HIDDONE + 4 * (t0 + mt); unsigned* br = ctl + CTL_BAR;
          gemm_mainloop<true>(acc, g, slot0, n0, smem, [&]() { dep_wait(hd, 16u, br, false);
#pragma unroll
              for (int mf = 0; mf < 4; ++mf) { const bf16* trow = (const bf16*)(ws + OFF_TN) + (size_t)(tk[mf] < 0 ? 0 : tk[mf]) * D_ + n0w + 4 * q;
#pragma unroll
                  for (int nf = 0; nf < 4; ++nf) xv[mf][nf] = *(const u32x2*)(trow + 16 * nf); } }); }
#pragma unroll
        for (int mf = 0; mf < 4; ++mf) { if (tk[mf] < 0) continue; float* orow = p.out + (size_t)tk[mf] * D_ + n0w + 4 * q;
#pragma unroll
            for (int nf = 0; nf < 4; ++nf) { const u32x2 tv = xv[mf][nf]; *(f32x4*)(orow + 16 * nf) = (f32x4){u2f(tv.x << 16), u2f(tv.x & 0xffff0000u), u2f(tv.y << 16), u2f(tv.y & 0xffff0000u)} * rg[nf] + acc[nf][mf]; } }
      }
    }
}

typedef float f32x16 __attribute__((ext_vector_type(16)));
typedef short s16x4 __attribute__((ext_vector_type(4)));
constexpr int AT_K = 0, AT_V = 8192, AT_B = 16384, AT_STAGE = 16384 + (NW > 4 ? NW : 4) * 256;
constexpr float NEG_BIG = -INFINITY;
constexpr float SM_THR = 8.0f;
DEV float xhalf_max(float v) { auto rr = __builtin_amdgcn_permlane32_swap(f2u(v), f2u(v), false, false); return fmaxf(u2f(rr[0]), u2f(rr[1])); }
DEV float xhalf_sum(float v) { auto rr = __builtin_amdgcn_permlane32_swap(f2u(v), f2u(v), false, false); return u2f(rr[0]) + u2f(rr[1]); }
DEV bf16x8 pack8(const f32x16& p, int b) {
    u32x4 w = {pk_bf16(p[b + 0], p[b + 1]), pk_bf16(p[b + 2], p[b + 3]), pk_bf16(p[b + 4], p[b + 5]), pk_bf16(p[b + 6], p[b + 7])};
    return __builtin_bit_cast(bf16x8, w);
}
struct AttnLane {
    int kofs[4];
    int vofs;
};
DEV AttnLane attn_lane_setup(int lane) {
    AttnLane a; const int r = lane & 31, hh = lane >> 5, sw = (r >> 1) & 7;
#pragma unroll
    for (int s = 0; s < 4; ++s) a.kofs[s] = r * 128 + (((2 * s + hh) ^ sw) << 4);
    const int qq = (lane & 15) >> 2, pp = lane & 3, blk = (lane >> 4) & 1; const int cb = (2 * blk + (pp >> 1)) ^ (((qq >> 1) & 1) << 2);
    a.vofs = (4 * hh + qq) * 128 + (cb << 4) + 8 * (pp & 1);
    return a;
}
DEV void attn_qk(f32x16& sA, f32x16& sB, const unsigned char* kt, const AttnLane& a, const bf16x8 (&qf)[4]) {
    const unsigned kb_ = (unsigned)(size_t)(LDS3 const unsigned char*)kt;
    bf16x8 ka[4], kb[4];
#pragma unroll
    for (int s = 0; s < 4; ++s) { asm volatile("ds_read_b128 %0, %1" : "=&v"(ka[s]) : "v"(kb_ + (unsigned)a.kofs[s]) : "memory"); asm volatile("ds_read_b128 %0, %1 offset:4096" : "=&v"(kb[s]) : "v"(kb_ + (unsigned)a.kofs[s]) : "memory"); }
    asm volatile("s_waitcnt lgkmcnt(6)" ::: "memory"); __builtin_amdgcn_sched_barrier(0);
    sA = __builtin_amdgcn_mfma_f32_32x32x16_bf16(ka[0], qf[0], sA, 0, 0, 0); sB = __builtin_amdgcn_mfma_f32_32x32x16_bf16(kb[0], qf[0], sB, 0, 0, 0);
    __builtin_amdgcn_sched_barrier(0); asm volatile("s_waitcnt lgkmcnt(4)" ::: "memory"); __builtin_amdgcn_sched_barrier(0);
    sA = __builtin_amdgcn_mfma_f32_32x32x16_bf16(ka[1], qf[1], sA, 0, 0, 0); sB = __builtin_amdgcn_mfma_f32_32x32x16_bf16(kb[1], qf[1], sB, 0, 0, 0);
    __builtin_amdgcn_sched_barrier(0); asm volatile("s_waitcnt lgkmcnt(2)" ::: "memory"); __builtin_amdgcn_sched_barrier(0);
    sA = __builtin_amdgcn_mfma_f32_32x32x16_bf16(ka[2], qf[2], sA, 0, 0, 0); sB = __builtin_amdgcn_mfma_f32_32x32x16_bf16(kb[2], qf[2], sB, 0, 0, 0);
    __builtin_amdgcn_sched_barrier(0); asm volatile("s_waitcnt lgkmcnt(0)" ::: "memory"); __builtin_amdgcn_sched_barrier(0);
    sA = __builtin_amdgcn_mfma_f32_32x32x16_bf16(ka[3], qf[3], sA, 0, 0, 0); sB = __builtin_amdgcn_mfma_f32_32x32x16_bf16(kb[3], qf[3], sB, 0, 0, 0);
}
DEV void attn_bias_init(f32x16& sA, f32x16& sB, const float* bl, int hh) {
#pragma unroll
    for (int g = 0; g < 4; ++g) { const f32x4 va = *(const f32x4*)(bl + 8 * g + 4 * hh); const f32x4 vb = *(const f32x4*)(bl + 32 + 8 * g + 4 * hh);
#pragma unroll
        for (int r = 0; r < 4; ++r) { sA[4 * g + r] = va[r]; sB[4 * g + r] = vb[r]; } }
}
DEV void attn_bias_init_rank2(f32x16& sA, f32x16& sB, const float* bl  , int lane, float bop  ) {
    const float v0 = bl[lane & 31], v1 = bl[32 + (lane & 31)]; const float a0 = lane < 32 ? v0 : 1.0f, a1 = lane < 32 ? v1 : 1.0f;
    const f32x16 z = {0.f, 0.f, 0.f, 0.f, 0.f, 0.f, 0.f, 0.f, 0.f, 0.f, 0.f, 0.f, 0.f, 0.f, 0.f, 0.f};
    sA = __builtin_amdgcn_mfma_f32_32x32x2f32(a0, bop, z, 0, 0, 0); sB = __builtin_amdgcn_mfma_f32_32x32x2f32(a1, bop, z, 0, 0, 0);
}
DEV void attn_softmax(f32x16& sA, f32x16& sB, float& m, float& l, f32x16& o0, f32x16& o1, bf16x8 (&pa)[4]) {
    float mx = sA[0];
#pragma unroll
    for (int i = 1; i < 16; ++i) mx = fmaxf(mx, sA[i]);
#pragma unroll
    for (int i = 0; i < 16; ++i) mx = fmaxf(mx, sB[i]);
    mx = xhalf_max(mx);
    float ms = m == NEG_BIG ? 0.f : m, alpha = 1.0f;
    if (__builtin_amdgcn_ballot_w64(mx > m + SM_THR)) {
        const float mn = fmaxf(m, mx); ms = mn == NEG_BIG ? 0.f : mn;
        alpha = __builtin_amdgcn_exp2f(m - ms); m = mn;
        o0 = o0 * alpha; o1 = o1 * alpha;
    }
    float ps = 0.f;
#pragma unroll
    for (int i = 0; i < 16; ++i) { sA[i] = __builtin_amdgcn_exp2f(sA[i] - ms); ps += sA[i]; }
#pragma unroll
    for (int i = 0; i < 16; ++i) { sB[i] = __builtin_amdgcn_exp2f(sB[i] - ms); ps += sB[i]; }
    l = l * alpha + ps;
    pa[0] = pack8(sA, 0); pa[1] = pack8(sA, 8); pa[2] = pack8(sB, 0); pa[3] = pack8(sB, 8);
}
template <int OFF> DEV s16x4 tr_read(unsigned addr) { s16x4 r; asm volatile("ds_read_b64_tr_b16 %0, %1 offset:%2" : "=&v"(r) : "v"(addr), "i"(OFF) : "memory"); return r; }
DEV void attn_pv(f32x16& o0, f32x16& o1, const unsigned char* vt, const AttnLane& a, const bf16x8 (&pa)[4]) {
    const unsigned vb = (unsigned)(size_t)(LDS3 const unsigned char*)vt + (unsigned)a.vofs;
#pragma unroll
    for (int dt = 0; dt < 2; ++dt) {
        const unsigned vd = vb ^ (unsigned)(dt << 6);
        const s16x4 l0 = tr_read<0>(vd), h0 = tr_read<1024>(vd), l1 = tr_read<2048>(vd), h1 = tr_read<3072>(vd), l2 = tr_read<4096>(vd), h2 = tr_read<5120>(vd), l3 = tr_read<6144>(vd), h3 = tr_read<7168>(vd);
        asm volatile("s_waitcnt lgkmcnt(0)" ::: "memory"); __builtin_amdgcn_sched_barrier(0);
#define PKV(L, H) (bf16x8){L[0], L[1], L[2], L[3], H[0], H[1], H[2], H[3]}
        f32x16& o = dt ? o1 : o0;
        o = __builtin_amdgcn_mfma_f32_32x32x16_bf16(PKV(l0, h0), pa[0], o, 0, 0, 0);
        o = __builtin_amdgcn_mfma_f32_32x32x16_bf16(PKV(l1, h1), pa[1], o, 0, 0, 0);
        o = __builtin_amdgcn_mfma_f32_32x32x16_bf16(PKV(l2, h2), pa[2], o, 0, 0, 0);
        o = __builtin_amdgcn_mfma_f32_32x32x16_bf16(PKV(l3, h3), pa[3], o, 0, 0, 0);
    }
}
DEV void attn_softmax_pv(f32x16& sA, f32x16& sB, float& m, float& l, f32x16& o0, f32x16& o1, const unsigned char* vt, const AttnLane& a) {
    float mx = sA[0];
#pragma unroll
    for (int i = 1; i < 16; ++i) mx = fmaxf(mx, sA[i]);
#pragma unroll
    for (int i = 0; i < 16; ++i) mx = fmaxf(mx, sB[i]);
    mx = xhalf_max(mx);
    float ms = m == NEG_BIG ? 0.f : m, alpha = 1.0f;
    if (__builtin_amdgcn_ballot_w64(mx > m + SM_THR)) {
        const float mn = fmaxf(m, mx); ms = mn == NEG_BIG ? 0.f : mn;
        alpha = __builtin_amdgcn_exp2f(m - ms); m = mn;
        o0 = o0 * alpha; o1 = o1 * alpha;
    }
    __builtin_amdgcn_sched_barrier(0);
    const unsigned vb = (unsigned)(size_t)(LDS3 const unsigned char*)vt + (unsigned)a.vofs, vd1 = vb ^ 64u;
    const s16x4 l0 = tr_read<0>(vb), h0 = tr_read<1024>(vb), l1 = tr_read<2048>(vb), h1 = tr_read<3072>(vb), l2 = tr_read<4096>(vb), h2 = tr_read<5120>(vb), l3 = tr_read<6144>(vb), h3 = tr_read<7168>(vb);
    __builtin_amdgcn_sched_barrier(0);
    float ps = 0.f;
#pragma unroll
    for (int i = 0; i < 16; ++i) { sA[i] = __builtin_amdgcn_exp2f(sA[i] - ms); ps += sA[i]; }
#pragma unroll
    for (int i = 0; i < 16; ++i) { sB[i] = __builtin_amdgcn_exp2f(sB[i] - ms); ps += sB[i]; }
    l = l * alpha + ps;
    const bf16x8 pa0 = pack8(sA, 0), pa1 = pack8(sA, 8), pa2 = pack8(sB, 0), pa3 = pack8(sB, 8);
    asm volatile("s_waitcnt lgkmcnt(0)" ::: "memory"); __builtin_amdgcn_sched_barrier(0);
    o0 = __builtin_amdgcn_mfma_f32_32x32x16_bf16(PKV(l0, h0), pa0, o0, 0, 0, 0);
    o0 = __builtin_amdgcn_mfma_f32_32x32x16_bf16(PKV(l1, h1), pa1, o0, 0, 0, 0);
    o0 = __builtin_amdgcn_mfma_f32_32x32x16_bf16(PKV(l2, h2), pa2, o0, 0, 0, 0);
    o0 = __builtin_amdgcn_mfma_f32_32x32x16_bf16(PKV(l3, h3), pa3, o0, 0, 0, 0);
    __builtin_amdgcn_sched_barrier(0);
    const s16x4 m0 = tr_read<0>(vd1), n0 = tr_read<1024>(vd1), m1 = tr_read<2048>(vd1), n1 = tr_read<3072>(vd1), m2 = tr_read<4096>(vd1), n2 = tr_read<5120>(vd1), m3 = tr_read<6144>(vd1), n3 = tr_read<7168>(vd1);
    asm volatile("s_waitcnt lgkmcnt(0)" ::: "memory"); __builtin_amdgcn_sched_barrier(0);
    o1 = __builtin_amdgcn_mfma_f32_32x32x16_bf16(PKV(m0, n0), pa0, o1, 0, 0, 0);
    o1 = __builtin_amdgcn_mfma_f32_32x32x16_bf16(PKV(m1, n1), pa1, o1, 0, 0, 0);
    o1 = __builtin_amdgcn_mfma_f32_32x32x16_bf16(PKV(m2, n2), pa2, o1, 0, 0, 0);
    o1 = __builtin_amdgcn_mfma_f32_32x32x16_bf16(PKV(m3, n3), pa3, o1, 0, 0, 0);
#undef PKV
}
DEV void attn_softmax_pv_fixed(f32x16& sA, f32x16& sB, float& l, f32x16& o0, f32x16& o1, const unsigned char* vt, const AttnLane& a) {
#define PKV(L, H) (bf16x8){L[0], L[1], L[2], L[3], H[0], H[1], H[2], H[3]}
    __builtin_amdgcn_sched_barrier(0);
    const unsigned vb = (unsigned)(size_t)(LDS3 const unsigned char*)vt + (unsigned)a.vofs, vd1 = vb ^ 64u;
    const s16x4 l0 = tr_read<0>(vb), h0 = tr_read<1024>(vb), l1 = tr_read<2048>(vb), h1 = tr_read<3072>(vb), l2 = tr_read<4096>(vb), h2 = tr_read<5120>(vb), l3 = tr_read<6144>(vb), h3 = tr_read<7168>(vb);
    __builtin_amdgcn_sched_barrier(0);
    float ps = 0.f;
#pragma unroll
    for (int i = 0; i < 16; ++i) { sA[i] = __builtin_amdgcn_exp2f(sA[i]); ps += sA[i]; }
#pragma unroll
    for (int i = 0; i < 16; ++i) { sB[i] = __builtin_amdgcn_exp2f(sB[i]); ps += sB[i]; }
    l += ps;
    const bf16x8 pa0 = pack8(sA, 0), pa1 = pack8(sA, 8), pa2 = pack8(sB, 0), pa3 = pack8(sB, 8);
    asm volatile("s_waitcnt lgkmcnt(0)" ::: "memory"); __builtin_amdgcn_sched_barrier(0);
    o0 = __builtin_amdgcn_mfma_f32_32x32x16_bf16(PKV(l0, h0), pa0, o0, 0, 0, 0);
    o0 = __builtin_amdgcn_mfma_f32_32x32x16_bf16(PKV(l1, h1), pa1, o0, 0, 0, 0);
    o0 = __builtin_amdgcn_mfma_f32_32x32x16_bf16(PKV(l2, h2), pa2, o0, 0, 0, 0);
    o0 = __builtin_amdgcn_mfma_f32_32x32x16_bf16(PKV(l3, h3), pa3, o0, 0, 0, 0);
    __builtin_amdgcn_sched_barrier(0);
    const s16x4 m0 = tr_read<0>(vd1), n0 = tr_read<1024>(vd1), m1 = tr_read<2048>(vd1), n1 = tr_read<3072>(vd1), m2 = tr_read<4096>(vd1), n2 = tr_read<5120>(vd1), m3 = tr_read<6144>(vd1), n3 = tr_read<7168>(vd1);
    asm volatile("s_waitcnt lgkmcnt(0)" ::: "memory"); __builtin_amdgcn_sched_barrier(0);
    o1 = __builtin_amdgcn_mfma_f32_32x32x16_bf16(PKV(m0, n0), pa0, o1, 0, 0, 0);
    o1 = __builtin_amdgcn_mfma_f32_32x32x16_bf16(PKV(m1, n1), pa1, o1, 0, 0, 0);
    o1 = __builtin_amdgcn_mfma_f32_32x32x16_bf16(PKV(m2, n2), pa2, o1, 0, 0, 0);
    o1 = __builtin_amdgcn_mfma_f32_32x32x16_bf16(PKV(m3, n3), pa3, o1, 0, 0, 0);
#undef PKV
}
DEV void glds16(const void* g, unsigned lds) { lds = __builtin_amdgcn_readfirstlane(lds); asm volatile("s_mov_b32 m0, %1\n\ts_nop 0\n\tglobal_load_lds_dwordx4 %0, off" :: "v"(g), "s"(lds) : "memory"); }
DEV void glds4(const void* g, unsigned lds) { lds = __builtin_amdgcn_readfirstlane(lds); asm volatile("s_mov_b32 m0, %1\n\ts_nop 0\n\tglobal_load_lds_dword %0, off" :: "v"(g), "s"(lds) : "memory"); }
DEV void kv_issue(const bf16* Kg, const bf16* Vg, int key0, unsigned sb  ) {
    const int t = threadIdx.x, lane = t & 63, w = __builtin_amdgcn_readfirstlane(t >> 6), row = 8 * w + (lane >> 3), p = lane & 7;
    const int ck = (p ^ ((row >> 1) & 7)) * 8, cv = (p ^ (((row >> 1) & 1) << 2)) * 8;
#pragma unroll
    for (int i = 0; i < 8 / NW + (8 % NW != 0); ++i) { if (NW > 8 && w >= 8) break; const size_t ro = (size_t)(key0 + row + 8 * NW * i) * 64;
        glds16(Kg + ro + ck, sb + AT_K + (w + NW * i) * 1024);
        glds16(Vg + ro + cv, sb + AT_V + (w + NW * i) * 1024); }
}
constexpr int KV_NVM = 2 * (8 / NW);
static_assert(8 % NW == 0, "K/V staging assumes the wave count divides 8");
template <int GB  , class KeyF, class BiasF, class NeedF, class ConsF, class BopF>
DEV void stream_tiles(unsigned char* smem, const bf16* Kg, const bf16* Vg, const float* gbias, int ntiles, KeyF key0_of, BiasF bias_of, int brow, const AttnLane& al, const bf16x8 (&qf)[4], int hh, NeedF need, ConsF cons, BopF bop_of) {
    if (ntiles <= 0) return;
    const int t = threadIdx.x, lane = t & 63, w = __builtin_amdgcn_readfirstlane(t >> 6);
    auto issue = [&](int i) {
        const int k0 = key0_of(i); unsigned char* sb = smem + (i % 3) * AT_STAGE; const unsigned sba = (unsigned)(size_t)(LDS3 unsigned char*)smem + (unsigned)((i % 3) * AT_STAGE);
        kv_issue(Kg, Vg, k0, sba);
        if (GB == 1) glds4(gbias + k0 + lane, sba + AT_B + w * 256);
        else if (t < (GB == 2 ? 64 : 256)) ((float*)(sb + AT_B))[t] = bias_of(k0, t);
    };
    auto qk = [&](int i, f32x16& sA, f32x16& sB) {
        if (need(i)) { const unsigned char* sb = smem + (i % 3) * AT_STAGE; if (GB) attn_bias_init_rank2(sA, sB, (const float*)(sb + AT_B) + brow, lane, bop_of(i)); else attn_bias_init(sA, sB, (const float*)(sb + AT_B) + brow, hh); attn_qk(sA, sB, sb + AT_K, al, qf); }
        __builtin_amdgcn_sched_barrier(0);
    };
    auto sync_next = [&](int i) {
        asm volatile("s_waitcnt vmcnt(0)" ::: "memory"); asm volatile("s_waitcnt lgkmcnt(0)" ::: "memory");
        __builtin_amdgcn_s_barrier(); asm volatile("" ::: "memory");
        if (i + 2 < ntiles) issue(i + 2);
    };
    issue(0); if (ntiles > 1) issue(1);
    if (ntiles > 1) asm volatile("s_waitcnt vmcnt(%0)" :: "n"(KV_NVM + (GB == 1 ? 1 : 0)) : "memory"); else asm volatile("s_waitcnt vmcnt(0)" ::: "memory");
    asm volatile("s_waitcnt lgkmcnt(0)" ::: "memory");
    __builtin_amdgcn_s_barrier(); asm volatile("" ::: "memory");
    f32x16 a0, b0, a1, b1;
    qk(0, a0, b0);
    for (int i = 0; i < ntiles; i += 2) {
        if (i + 1 < ntiles) { sync_next(i); qk(i + 1, a1, b1); }
        if (need(i)) cons(i, smem + (i % 3) * AT_STAGE, a0, b0);
        if (i + 1 < ntiles) {
            if (i + 2 < ntiles) { sync_next(i + 1); qk(i + 2, a0, b0); }
            if (need(i + 1)) cons(i + 1, smem + ((i + 1) % 3) * AT_STAGE, a1, b1);
        }
    }
    asm volatile("s_waitcnt lgkmcnt(0)" ::: "memory");
    __builtin_amdgcn_s_barrier();
    asm volatile("" ::: "memory");
}
DEV int fx_nch(int qb) { return ((FX_ROWS / 64) * (qb + 1) + FX_CH - 1) / FX_CH; }
DEV int fx_part_index(int bh, int qb, int c) {
    const int off = qb < 2 * FX_QQ ? (qb - FX_QQ) * 2 : (qb < 3 * FX_QQ ? 2 * FX_QQ + (qb - 2 * FX_QQ) * 3 : 5 * FX_QQ + (qb - 3 * FX_QQ) * 4);
    return bh * FX_PART_PER_BH + off + c;
}
DEV unsigned char* fx_part_ptr(const Params& p, int pi) { return (size_t)pi < FX_P1 ? (unsigned char*)p.out + (size_t)T_ * 1024 * 2 + (size_t)pi * FX_PART_BYTES : p.ws + OFF_FXPART + ((size_t)pi - FX_P1) * FX_PART_BYTES; }
DEV void fox_unit(const Params& p, unsigned char* smem, int bh, int qb, int c) {
    unsigned char* ws = p.ws; int t = threadIdx.x; asm volatile("" : "+v"(t)); asm volatile("" : "+v"(ws));
    const int lane = t & 63, w = t >> 6, r = lane & 31, hh = lane >> 5;
    const bf16* Kg = (const bf16*)(ws + OFF_FK) + (size_t)bh * S_ * 64; const bf16* Vg = (const bf16*)(ws + OFF_FV) + (size_t)bh * S_ * 64; const float* cum = (const float*)(ws + OFF_CUM) + (size_t)bh * S_;
    const int q0 = qb * FX_ROWS, qw0 = q0 + 32 * w, q = qw0 + r;
    const int ntiles = (q0 + FX_ROWS) / 64;
    int* kts = (int*)(smem + LDS_TILE_BYTES + 16);
    if (t == 0) kts[0] = ntiles - 1;
    __syncthreads();
    { const float cref = cum[q0], thr = -(160.0f + 2.0f * ((const float*)(ws + OFF_CTL))[CTL_QKB]); if (t < ntiles && cum[t * 64 + 63] - cref >= thr) atomicMin(kts, t); }
    __syncthreads();
    const int kt0 = kts[0], cfirst = kt0 / FX_CH, nch = fx_nch(qb);
    const int lo = c * FX_CH > kt0 ? c * FX_CH : kt0, hi = (c + 1) * FX_CH < ntiles ? (c + 1) * FX_CH : ntiles;
    if (c == nch - 1 && t == 0) st_dev((float*)(ws + OFF_FXINFO) + bh * FX_NQB + qb, __builtin_bit_cast(float, cfirst));
    if (lo >= hi) return;
    const AttnLane al = attn_lane_setup(lane);
    bf16x8 qf[4]; { const bf16* qrow = (const bf16*)(ws + OFF_FQ) + ((size_t)bh * S_ + q) * 64 + 8 * hh;
#pragma unroll
        for (int s = 0; s < 4; ++s) qf[s] = *(const bf16x8*)(qrow + 16 * s); }
    asm volatile("" :: "v"(qf[0]), "v"(qf[1]), "v"(qf[2]), "v"(qf[3]));
    f32x16 o0, o1;
#pragma unroll
    for (int i = 0; i < 16; ++i) { o0[i] = 0.f; o1[i] = 0.f; }
    float l = 0.f;
    float bop; { const float cq = cum[q]; const float bq = ((const float*)(ws + OFF_CTL))[CTL_QKB]; bop = hh ? -cq - fmaxf(0.f, bq - 100.0f) : 1.0f; }
    asm volatile("" :: "v"(bop));
    stream_tiles<1>(smem, Kg, Vg, cum, hi - lo, [&](int i) { return (lo + i) * 64; }, [&](int k0, int tt) { return 0.f; }, w * 64, al, qf, hh,
        [&](int i) { return (lo + i) * 64 <= qw0 + 31; },
        [&](int i, const unsigned char* sb, f32x16& sA, f32x16& sB) {
            const int kt = lo + i;
            if (kt * 64 + 63 > qw0) {
#pragma unroll
                for (int e = 0; e < 16; ++e) { const int key = kt * 64 + (e & 3) + 8 * (e >> 2) + 4 * hh; if (key > q) sA[e] = NEG_BIG; if (key + 32 > q) sB[e] = NEG_BIG; }
            }
            attn_softmax_pv_fixed(sA, sB, l, o0, o1, sb + AT_V, al);
        }, [&](int) { return bop; });
    const float lt = xhalf_sum(l);
    if (nch - cfirst == 1) {
        const float il = 1.0f / lt;
        bf16* orow = ao_row(p, 0, bh / 8, q) + (bh % 8) * 64 + 4 * hh;
        bf16* orw = orow - 4 * hh + 8 * hh;
#pragma unroll
        for (int g = 0; g < 4; g += 2) {
            st_dev16(orw + 8 * g, widen_half((u32x2){pk_bf16(o0[4 * g] * il, o0[4 * g + 1] * il), pk_bf16(o0[4 * g + 2] * il, o0[4 * g + 3] * il)}, (u32x2){pk_bf16(o0[4 * g + 4] * il, o0[4 * g + 5] * il), pk_bf16(o0[4 * g + 6] * il, o0[4 * g + 7] * il)}));
            st_dev16(orw + 32 + 8 * g, widen_half((u32x2){pk_bf16(o1[4 * g] * il, o1[4 * g + 1] * il), pk_bf16(o1[4 * g + 2] * il, o1[4 * g + 3] * il)}, (u32x2){pk_bf16(o1[4 * g + 4] * il, o1[4 * g + 5] * il), pk_bf16(o1[4 * g + 6] * il, o1[4 * g + 7] * il)})); }
    } else {
        unsigned char* pp = fx_part_ptr(p, fx_part_index(bh, qb, c)); bf16* orow = (bf16*)pp + (size_t)(32 * w + r) * 64 + 4 * hh;
        bf16* orw = orow - 4 * hh + 8 * hh;
#pragma unroll
        for (int g = 0; g < 4; g += 2) {
            st_dev16(orw + 8 * g, widen_half((u32x2){pk_bf16(o0[4 * g], o0[4 * g + 1]), pk_bf16(o0[4 * g + 2], o0[4 * g + 3])}, (u32x2){pk_bf16(o0[4 * g + 4], o0[4 * g + 5]), pk_bf16(o0[4 * g + 6], o0[4 * g + 7])}));
            st_dev16(orw + 32 + 8 * g, widen_half((u32x2){pk_bf16(o1[4 * g], o1[4 * g + 1]), pk_bf16(o1[4 * g + 2], o1[4 * g + 3])}, (u32x2){pk_bf16(o1[4 * g + 4], o1[4 * g + 5]), pk_bf16(o1[4 * g + 6], o1[4 * g + 7])})); }
        if (hh == 0) { float* ml = (float*)(pp + FX_ROWS * 64 * 2); st_dev(ml + 32 * w + r, 0.f); st_dev(ml + FX_ROWS + 32 * w + r, lt); }
    }
}
DEV void fox_merge(const Params& p, int bh, int qb) {
    unsigned char* ws = p.ws; asm volatile("" : "+v"(ws)); const int t = threadIdx.x, row = t >> 1, half = t & 1;
    const int cfirst = ((const int*)(ws + OFF_FXINFO))[bh * FX_NQB + qb], nch = fx_nch(qb);
    if (nch - cfirst < 2) return;
    float mt = NEG_BIG;
    for (int c = cfirst; c < nch; ++c) mt = fmaxf(mt, ((const float*)(fx_part_ptr(p, fx_part_index(bh, qb, c)) + FX_ROWS * 64 * 2))[row]);
    float acc[32], lt = 0.f;
#pragma unroll
    for (int i = 0; i < 32; ++i) acc[i] = 0.f;
    for (int c = cfirst; c < nch; ++c) {
        const unsigned char* pp = fx_part_ptr(p, fx_part_index(bh, qb, c)); const float* ml = (const float*)(pp + FX_ROWS * 64 * 2);
        const float mc = ml[row]; if (mc == NEG_BIG) continue;
        const float sc = __builtin_amdgcn_exp2f(mc - mt); lt += sc * ml[FX_ROWS + row];
        const u32x4* src = (const u32x4*)((const bf16*)pp + (size_t)row * 64 + 32 * half);
#pragma unroll
        for (int k = 0; k < 4; ++k) { const u32x4 v = __builtin_nontemporal_load(src + k);
            acc[8 * k + 0] += sc * u2f(v.x << 16); acc[8 * k + 1] += sc * u2f(v.x & 0xffff0000u); acc[8 * k + 2] += sc * u2f(v.y << 16); acc[8 * k + 3] += sc * u2f(v.y & 0xffff0000u);
            acc[8 * k + 4] += sc * u2f(v.z << 16); acc[8 * k + 5] += sc * u2f(v.z & 0xffff0000u); acc[8 * k + 6] += sc * u2f(v.w << 16); acc[8 * k + 7] += sc * u2f(v.w & 0xffff0000u); }
    }
    const float il = 1.0f / lt;
    bf16* orow = ao_row(p, 0, bh / 8, qb * FX_ROWS + row) + (bh % 8) * 64 + 32 * half;
#pragma unroll
    for (int k = 0; k < 4; ++k) st_dev16(orow + 8 * k, (u32x4){pk_bf16(acc[8 * k] * il, acc[8 * k + 1] * il), pk_bf16(acc[8 * k + 2] * il, acc[8 * k + 3] * il), pk_bf16(acc[8 * k + 4] * il, acc[8 * k + 5] * il), pk_bf16(acc[8 * k + 6] * il, acc[8 * k + 7] * il)});
}
constexpr int NSQ = 8 * NW;
constexpr int NS_IMP = 3 * AT_STAGE, NS_SEL = NS_IMP + NSQ * 128 * 4, NS_UNI = NS_SEL + NSQ * 16, NS_WUNI = NS_UNI + 16, NS_CNT = NS_WUNI + NW * 16, NS_LIST = NS_CNT + 16, NS_END = NS_LIST + 128;
static_assert(NS_END <= LDS_TILE_BYTES && NSLC <= 128, "NSA LDS map");
DEV void nsa_item(const Params& p, unsigned char* smem, int bg, int qb) {
    unsigned char* ws = p.ws; int t = threadIdx.x; asm volatile("" : "+v"(t)); asm volatile("" : "+v"(ws));
    const int lane = t & 63, w = t >> 6, r = lane & 31, hh = lane >> 5;
    const int b = bg / 2, g = bg % 2, q0 = qb * NSQ, hl = r >> 3, head = g * 4 + hl, qi = 8 * w + (r & 7), qpos = q0 + qi, qblk = qpos >> 6;
    const AttnLane al = attn_lane_setup(lane);
    bf16x8 qf[4]; { const bf16* qrow = (const bf16*)(ws + OFF_NQ) + (((size_t)b * 8 + head) * S_ + qpos) * 64 + 8 * hh;
#pragma unroll
        for (int s = 0; s < 4; ++s) qf[s] = *(const bf16x8*)(qrow + 16 * s); }
    asm volatile("" :: "v"(qf[0]), "v"(qf[1]), "v"(qf[2]), "v"(qf[3]));
    float* imp = (float*)(smem + NS_IMP); unsigned* selw = (unsigned*)(smem + NS_SEL); unsigned* uni = (unsigned*)(smem + NS_UNI); unsigned* wuni = (unsigned*)(smem + NS_WUNI);
    int* lcnt = (int*)(smem + NS_CNT); unsigned char* blist = smem + NS_LIST;
    for (int i = t; i < NSQ * 128; i += NTHREADS) imp[i] = 0.f;
    if (t < 4) uni[t] = 0u; if (t < 4 * NW) wuni[t] = 0u;
    __syncthreads();
    float gate[3]; { const float* gp = (const float*)(ws + OFF_GATE) + ((size_t)b * S_ + qpos) * 24 + head * 3; gate[0] = gp[0]; gate[1] = gp[1]; gate[2] = gp[2]; }
    asm volatile("" :: "v"(gate[0]), "v"(gate[1]), "v"(gate[2]));
    const float sl_lane = alibi_slope2(g * 4 + hl);
    const float mrefn = fmaxf(0.f, ((const float*)(ws + OFF_CTL))[CTL_QKB + 1] - 100.0f);
    int dead_dist; { const float dd = (160.0f + 2.0f * ((const float*)(ws + OFF_CTL))[CTL_QKB + 1]) / alibi_slope2(g * 4 + 3); dead_dist = dd < (float)S_ ? (int)dd + 1 : S_; }
    f32x16 tot0, tot1, o0, o1;
#pragma unroll
    for (int i = 0; i < 16; ++i) { tot0[i] = 0.f; tot1[i] = 0.f; o0[i] = 0.f; o1[i] = 0.f; }
    {
        const bf16* Kg = (const bf16*)(ws + OFF_KCMP) + (size_t)bg * NCMPP * 64; const bf16* Vg = (const bf16*)(ws + OFF_VCMP) + (size_t)bg * NCMPP * 64;
        const int ncmp = (q0 + NSQ - 32) / 16 + 1, ntl_all = (ncmp + 63) / 64;
        const int tc0 = dead_dist >= S_ ? 0 : (((q0 - 31 - dead_dist - 16) / 16 + 1) > 0 ? ((q0 - 31 - dead_dist - 16) / 16 + 1) / 64 : 0);
        const int ntl = ntl_all - tc0;
        auto key0_of = [&](int i) { return (tc0 + i) * 64; };
        auto bias_of = [&](int k0, int tt) { return (float)(16 * (k0 + tt) + 31 - q0); };
        const float bopc = hh ? -mrefn : sl_lane; auto bop_of = [&](int) { return bopc; };
        float l = 0.f;
        auto cmask = [&](int i, f32x16& sA, f32x16& sB) {
            if (16 * ((tc0 + i) * 64 + 63) + 31 <= q0 + 8 * w) return;
#pragma unroll
            for (int e = 0; e < 16; ++e) { const int n = (tc0 + i) * 64 + (e & 3) + 8 * (e >> 2) + 4 * hh; if (16 * n + 31 > qpos) sA[e] = NEG_BIG; if (16 * (n + 32) + 31 > qpos) sB[e] = NEG_BIG; }
        };
        auto always = [&](int) { return true; };
        stream_tiles<2>(smem, Kg, Vg, nullptr, ntl, key0_of, bias_of, 0, al, qf, hh, always, [&](int i, const unsigned char* sb, f32x16& sA, f32x16& sB) {
            cmask(i, sA, sB);
            float ps = 0.f;
#pragma unroll
            for (int e = 0; e < 16; ++e) ps += __builtin_amdgcn_exp2f(sA[e]);
#pragma unroll
            for (int e = 0; e < 16; ++e) ps += __builtin_amdgcn_exp2f(sB[e]);
            l += ps;
        }, bop_of);
        const float lt = xhalf_sum(l);
        const float bopn = hh ? (lt > 0.f ? -__builtin_amdgcn_logf(lt) : NEG_BIG) - mrefn : sl_lane; auto bop_n = [&](int) { return bopn; };
        stream_tiles<2>(smem, Kg, Vg, nullptr, ntl, key0_of, bias_of, 0, al, qf, hh, always, [&](int i, const unsigned char* sb, f32x16& sA, f32x16& sB) {
            cmask(i, sA, sB);
#pragma unroll
            for (int e = 0; e < 16; ++e) { sA[e] = __builtin_amdgcn_exp2f(sA[e]); sB[e] = __builtin_amdgcn_exp2f(sB[e]); }
            bf16x8 pa[4] = {pack8(sA, 0), pack8(sA, 8), pack8(sB, 0), pack8(sB, 8)};
            __builtin_amdgcn_sched_barrier(0);
            attn_pv(o0, o1, sb + AT_V, al, pa);
            __builtin_amdgcn_sched_barrier(0);
#pragma unroll
            for (int blk = 0; blk < 2; ++blk)
#pragma unroll
                for (int gq = 0; gq < 4; ++gq) {
                    const f32x16& sp = blk ? sB : sA;
                    float sp3 = 0.5f * sp[4 * gq + 3], mainv = (sp[4 * gq] + sp[4 * gq + 1]) + (sp[4 * gq + 2] + sp3);
                    mainv += __shfl_xor(mainv, 8); mainv += __shfl_xor(mainv, 16); sp3 += __shfl_xor(sp3, 8); sp3 += __shfl_xor(sp3, 16);
                    const int j = (tc0 + i) * 16 + 8 * blk + 2 * gq + hh;
                    if (hl == 0 && j < NSLC) { atomicAdd(imp + qi * 128 + j, mainv); if (j + 1 < NSLC) atomicAdd(imp + qi * 128 + j + 1, sp3); }
                }
        }, bop_n);
        const float g0 = gate[0];
        tot0 = o0 * g0; tot1 = o1 * g0;
    }
    {
        const int part = lane & 7, ql = lane >> 3, qp = q0 + 8 * w + ql, qb64 = qp >> 6; const float* irow = imp + (8 * w + ql) * 128 + part * 16;
        float v[16];
#pragma unroll
        for (int e = 0; e < 16; ++e) { const int j = part * 16 + e; v[e] = (j >= NSLC || j > qb64) ? -1.0f : ((j == 0 || j == qb64 || j == qb64 - 1) ? 1e4f : irow[e]); }
        unsigned mk[4] = {0u, 0u, 0u, 0u};
        if (__builtin_amdgcn_ballot_w64(qb64 >= TOPN)) {
            for (int it = 0; it < TOPN; ++it) {
                float bv = v[0]; int bj = part * 16;
#pragma unroll
                for (int e = 1; e < 16; ++e) if (v[e] > bv) { bv = v[e]; bj = part * 16 + e; }
#pragma unroll
                for (int off = 1; off < 8; off <<= 1) { const float ov = __shfl_xor(bv, off); const int oj = __shfl_xor(bj, off); if (ov > bv || (ov == bv && oj < bj)) { bv = ov; bj = oj; } }
#pragma unroll
                for (int e = 0; e < 16; ++e) if (part * 16 + e == bj) v[e] = -2.0f;
                if (bj <= qb64) {
#pragma unroll
                    for (int k = 0; k < 4; ++k) mk[k] |= (bj >> 5) == k ? (1u << (bj & 31)) : 0u; }
            }
        } else {
#pragma unroll
            for (int k = 0; k < 4; ++k) { const int hi = qb64 - 32 * k; mk[k] = hi >= 31 ? 0xffffffffu : (hi < 0 ? 0u : ((2u << hi) - 1u)); }
        }
        if (part == 0) {
#pragma unroll
            for (int k = 0; k < 4; ++k) { selw[(8 * w + ql) * 4 + k] = mk[k]; atomicOr(uni + k, mk[k]); atomicOr(wuni + w * 4 + k, mk[k]); } }
    }
    unsigned char* park = smem + NS_IMP + w * 4096 + r * 128 + 8 * hh;
#pragma unroll
    for (int gq = 0; gq < 4; ++gq) {
        *(u32x2*)(park + 16 * gq) = (u32x2){pk_bf16(tot0[4 * gq], tot0[4 * gq + 1]), pk_bf16(tot0[4 * gq + 2], tot0[4 * gq + 3])};
        *(u32x2*)(park + 64 + 16 * gq) = (u32x2){pk_bf16(tot1[4 * gq], tot1[4 * gq + 1]), pk_bf16(tot1[4 * gq + 2], tot1[4 * gq + 3])}; }
    __syncthreads();
    {
        bool on = false; int below = 0; int* wcnt = lcnt + 1;
        if (t < 128) {
            const bool live = q0 - (64 * t + 63) <= dead_dist;
            on = t < NSLC && live && ((uni[t >> 5] >> (t & 31)) & 1u); const unsigned long long bal = __builtin_amdgcn_ballot_w64(on);
            below = __builtin_popcountll(bal & ((1ull << lane) - 1ull)); if (lane == 0) wcnt[t >> 6] = __builtin_popcountll(bal);
        }
        __syncthreads();
        if (on) blist[(t >= 64 ? wcnt[0] : 0) + below] = (unsigned char)t;
        if (t == 0) lcnt[0] = wcnt[0] + wcnt[1];
    }
    __syncthreads();
    {
        const bf16* Kg = (const bf16*)(ws + OFF_KS) + (size_t)bg * S_ * 64; const bf16* Vg = (const bf16*)(ws + OFF_VS) + (size_t)bg * S_ * 64;
        const int ntl = lcnt[0];
#pragma unroll
        for (int i = 0; i < 16; ++i) { o0[i] = 0.f; o1[i] = 0.f; }
        float l = 0.f;
        stream_tiles<2>(smem, Kg, Vg, nullptr, ntl, [&](int i) { return (int)blist[i] * 64; }, [&](int k0, int tt) { return (float)(k0 + tt - q0); }, 0, al, qf, hh,
            [&](int i) { const int jb = blist[i]; return (bool)((wuni[w * 4 + (jb >> 5)] >> (jb & 31)) & 1u); },
            [&](int i, const unsigned char* sb, f32x16& sA, f32x16& sB) {
                const int jb = blist[i];
                if (jb * 64 + 63 > q0 + 8 * w) {
#pragma unroll
                    for (int e = 0; e < 16; ++e) { const int kp = jb * 64 + (e & 3) + 8 * (e >> 2) + 4 * hh; if (kp > qpos) sA[e] = NEG_BIG; if (kp + 32 > qpos) sB[e] = NEG_BIG; }
                }
                attn_softmax_pv_fixed(sA, sB, l, o0, o1, sb + AT_V, al);
            },
            [&](int i) { const int jb = blist[i]; const bool mine = (selw[qi * 4 + (jb >> 5)] >> (jb & 31)) & 1u; return hh ? (mine ? -mrefn : NEG_BIG) : sl_lane; });
        const float gl = gate[1] / xhalf_sum(l);
#pragma unroll
        for (int gq = 0; gq < 4; ++gq) {
            const u32x2 a = *(const u32x2*)(park + 16 * gq), bq = *(const u32x2*)(park + 64 + 16 * gq);
            *(u32x2*)(park + 16 * gq) = (u32x2){pk_bf16(u2f(a.x << 16) + o0[4 * gq] * gl, u2f(a.x & 0xffff0000u) + o0[4 * gq + 1] * gl), pk_bf16(u2f(a.y << 16) + o0[4 * gq + 2] * gl, u2f(a.y & 0xffff0000u) + o0[4 * gq + 3] * gl)};
            *(u32x2*)(park + 64 + 16 * gq) = (u32x2){pk_bf16(u2f(bq.x << 16) + o1[4 * gq] * gl, u2f(bq.x & 0xffff0000u) + o1[4 * gq + 1] * gl), pk_bf16(u2f(bq.y << 16) + o1[4 * gq + 2] * gl, u2f(bq.y & 0xffff0000u) + o1[4 * gq + 3] * gl)}; }
    }
    {
        const bf16* Kg = (const bf16*)(ws + OFF_KW) + (size_t)bg * S_ * 64; const bf16* Vg = (const bf16*)(ws + OFF_VW) + (size_t)bg * S_ * 64;
        const int klo = q0 - 511 > 0 ? q0 - 511 : 0, t_lo = klo / 64, t_hi = (q0 + NSQ - 1) / 64;
#pragma unroll
        for (int i = 0; i < 16; ++i) { o0[i] = 0.f; o1[i] = 0.f; }
        float l = 0.f;
        stream_tiles<2>(smem, Kg, Vg, nullptr, t_hi - t_lo + 1, [&](int i) { return (t_lo + i) * 64; }, [&](int k0, int tt) { return (float)(k0 + tt - q0); }, 0, al, qf, hh,
            [&](int) { return true; },
            [&](int i, const unsigned char* sb, f32x16& sA, f32x16& sB) {
                const int k0 = (t_lo + i) * 64;
                if (k0 + 63 > q0 + 8 * w || k0 < q0 + 8 * w + 7 - 511) {
#pragma unroll
                    for (int e = 0; e < 16; ++e) { const int kp = k0 + (e & 3) + 8 * (e >> 2) + 4 * hh; if (kp > qpos || kp < qpos - 511) sA[e] = NEG_BIG; if (kp + 32 > qpos || kp + 32 < qpos - 511) sB[e] = NEG_BIG; }
                }
                attn_softmax_pv_fixed(sA, sB, l, o0, o1, sb + AT_V, al);
            },
            [&](int) { return hh ? -mrefn : sl_lane; });
        const float gl = gate[2] / xhalf_sum(l);
        int qpos2 = qpos; asm volatile("" : "+v"(qpos2));
        bf16* orow = ao_row(p, 1, b, qpos2) + head * 64 + 8 * hh;
        u32x2 pk0[4], pk1[4];
#pragma unroll
        for (int gq = 0; gq < 4; ++gq) {
            const u32x2 a = *(const u32x2*)(park + 16 * gq), bq = *(const u32x2*)(park + 64 + 16 * gq);
            pk0[gq] = (u32x2){pk_bf16(u2f(a.x << 16) + o0[4 * gq] * gl, u2f(a.x & 0xffff0000u) + o0[4 * gq + 1] * gl), pk_bf16(u2f(a.y << 16) + o0[4 * gq + 2] * gl, u2f(a.y & 0xffff0000u) + o0[4 * gq + 3] * gl)};
            pk1[gq] = (u32x2){pk_bf16(u2f(bq.x << 16) + o1[4 * gq] * gl, u2f(bq.x & 0xffff0000u) + o1[4 * gq + 1] * gl), pk_bf16(u2f(bq.y << 16) + o1[4 * gq + 2] * gl, u2f(bq.y & 0xffff0000u) + o1[4 * gq + 3] * gl)}; }
#pragma unroll
        for (int gq = 0; gq < 4; gq += 2) { st_dev16(orow + 8 * gq, widen_half(pk0[gq], pk0[gq + 1])); st_dev16(orow + 32 + 8 * gq, widen_half(pk1[gq], pk1[gq + 1])); }
    }
}
#define XB_TMO      128
#define XB_XCNT(j)  (256  + 64 * (j))
#define XB_XSUB(j)  (1280 + 64 * (j))
#define XB_XGEN(j)  (2304 + 64 * (j))
#define XB_TOP      3328
#define XB_TOPGEN   3392
#define XB_SPIN_CAP (1u << 20)
DEV unsigned xb_ld(unsigned* p) { return __hip_atomic_load(p, __ATOMIC_RELAXED, __HIP_MEMORY_SCOPE_AGENT); }
DEV unsigned xb_add(unsigned* p, unsigned v) { return __hip_atomic_fetch_add(p, v, __ATOMIC_RELAXED, __HIP_MEMORY_SCOPE_AGENT); }
DEV unsigned xb_xcc_id() { return (unsigned)__builtin_amdgcn_s_getreg((3 << 11) | 20) & 0xFu; }
#define XB_SPIN(cond, bar) do { unsigned _sp = 0; while (cond) { __builtin_amdgcn_s_sleep(1); \
    if ((++_sp & 255u) == 0u) { if (xb_ld(&(bar)[XB_TMO])) break; if (_sp > XB_SPIN_CAP) { atomicAdd(&(bar)[XB_TMO], 1u); break; } } } } while (0)
struct XcdBarrier { unsigned* bar; unsigned x; volatile unsigned* st; };
DEV XcdBarrier xcd_barrier_post(unsigned* bar, volatile unsigned* st) { XcdBarrier b; b.bar = bar; b.x = xb_xcc_id(); b.st = st; if (threadIdx.x == 0) (void)xb_add(&bar[XB_XCNT(b.x)], 1u); return b; }
DEV void xcd_barrier_complete(unsigned* bar, unsigned x, unsigned& nloc, unsigned& nx) {
    const unsigned G = gridDim.x; unsigned sum, cnt, mine, sp = 0u;
    for (;;) {
        sum = 0u; cnt = 0u; mine = 0u;
#pragma unroll
        for (unsigned j = 0; j < 16; ++j) { const unsigned c = xb_ld(&bar[XB_XCNT(j)]); sum += c; cnt += (c > 0u) ? 1u : 0u; mine = (j == x) ? c : mine; }
        if (sum == G) break;
        __builtin_amdgcn_s_sleep(1);
        if ((++sp & 255u) == 0u) { if (xb_ld(&bar[XB_TMO])) break; if (sp > XB_SPIN_CAP) { atomicAdd(&bar[XB_TMO], 1u); break; } }
    }
    nloc = mine > 0u ? mine : 1u; nx = cnt > 0u ? cnt : 1u;
}
DEV void xcd_barrier(const XcdBarrier& b) {
    asm volatile("s_waitcnt vmcnt(0)" ::: "memory");
    __syncthreads();
    if (threadIdx.x == 0) {
        unsigned* bar = b.bar;
        __builtin_amdgcn_s_waitcnt(0);
        unsigned nloc = b.st[0], nx = b.st[1];
        if (nloc == 0u) { xcd_barrier_complete(bar, b.x, nloc, nx); b.st[0] = nloc; b.st[1] = nx; }
        const unsigned old = xb_add(&bar[XB_XSUB(b.x)], 1u);
        const unsigned gen = old / nloc;
        if (old + 1u == (gen + 1u) * nloc) {
            __builtin_amdgcn_fence(__ATOMIC_RELEASE, "agent");
            asm volatile("s_waitcnt vmcnt(0)" ::: "memory");
            const unsigned og = xb_add(&bar[XB_TOP], 1u);
            const unsigned tg = og / nx;
            if (og + 1u == (tg + 1u) * nx) xb_add(&bar[XB_TOPGEN], 1u);
            else XB_SPIN(xb_ld(&bar[XB_TOPGEN]) == tg, bar);
            __builtin_amdgcn_fence(__ATOMIC_ACQUIRE, "agent");
            xb_add(&bar[XB_XGEN(b.x)], 1u);
            asm volatile("s_waitcnt vmcnt(0)" ::: "memory");
        } else {
            XB_SPIN(xb_ld(&bar[XB_XGEN(b.x)]) == gen, bar);
            __builtin_amdgcn_fence(__ATOMIC_ACQUIRE, "agent");
            asm volatile("s_waitcnt vmcnt(0)" ::: "memory");
        }
    }
    __syncthreads();
}

constexpr int CTL_DEP = 320;
DEV void dep_post(unsigned* ctr, bool wb) {
    asm volatile("s_waitcnt vmcnt(0)" ::: "memory"); __syncthreads();
    if (threadIdx.x == 0) { if (wb) { __builtin_amdgcn_fence(__ATOMIC_RELEASE, "agent"); asm volatile("s_waitcnt vmcnt(0)" ::: "memory"); } (void)xb_add(ctr, 1u); }
}
DEV bool dep_post_last(unsigned* ctr, unsigned target, int* slot) {
    asm volatile("s_waitcnt vmcnt(0)" ::: "memory"); __syncthreads();
    if (threadIdx.x == 0) slot[1] = (xb_add(ctr, 1u) + 1u == target) ? 1 : 0;
    __syncthreads();
    return slot[1] != 0;
}
DEV void dep_wait(unsigned* ctr, unsigned target, unsigned* bar, bool acq) {
    if (threadIdx.x == 0) { XB_SPIN(xb_ld(ctr) < target, bar); if (acq) __builtin_amdgcn_fence(__ATOMIC_ACQUIRE, "agent"); asm volatile("s_waitcnt vmcnt(0)" ::: "memory"); }
    __syncthreads();
}
constexpr int CTL_UPQ = 4608, CTL_ROWDONE = 11264, CTL_UPDONE = 13312, CTL_OUTDONE = 5120, RDST = 16, NCPI = (NJOB2 + NW - 1) / NW, NCPA = NCPI / 2, CTL_CPT = 896;
constexpr int NCPI_UNUSED_ = 0;
DEV void bphase_attn(const Params& p, unsigned char* smem) {
    constexpr int NBH = B_ * 8, QQ = FX_QQ, NU = NBH * QQ * (4 + 3 + 2 + 1), NQB = S_ / (8 * NW), NITEM = B_ * 2 * NQB, NMERGE = B_ * 8 * (FX_NQB - FX_QQ), NH1 = NITEM / 2;
    static_assert(NSQ * 4 == BM && B_ == 2 && (S_ / BM) * B_ == 128, "row-block bookkeeping");
    unsigned* ctl = (unsigned*)(p.ws + OFF_CTL); unsigned* head = ctl + CTL_FOXQ; int* slot = (int*)(smem + LDS_BYTES - 16);
    int stage = 0;
    dep_wait(ctl + CTL_DEP + 192, B_ * 8, ctl + CTL_BAR, true);
    for (;;) {
        if (threadIdx.x == 0) slot[0] = (int)atomicAdd(head, 1u);
        __syncthreads();
        const int idx = slot[0];
        __syncthreads();
        if (idx >= NU && stage == 0) { dep_post(ctl + CTL_DEP + 64, false); dep_wait(ctl + CTL_DEP, gridDim.x, ctl + CTL_BAR, true); stage = 1; }
        if (idx >= NU + NITEM + NMERGE + NCPA) break;
        if (idx < NU) {
            int u = idx, grp = 0; while (u >= NBH * QQ * (4 - grp)) { u -= NBH * QQ * (4 - grp); ++grp; }
            const int nc = 4 - grp, per = NBH * nc, qb = (3 - grp) * QQ + QQ - 1 - u / per, rr = u % per, c = rr / NBH, j = rr % NBH, h = 7 - j / B_, b = j % B_;
            fox_unit(p, smem, b * 8 + h, qb, c);
            continue;
        }
        const int a = idx - NU;
        if (a >= NH1 + NMERGE && a < NH1 + NMERGE + NCPA) {
            const int jj = (a - NH1 - NMERGE) * NW + (int)(threadIdx.x >> 6);
            if (jj < NJOB2) prep_job(p, 2, __builtin_amdgcn_readfirstlane(jj));
        } else if (a >= NH1 && a < NH1 + NMERGE) {
            if (stage == 1) { dep_wait(ctl + CTL_DEP + 64, gridDim.x, ctl + CTL_BAR, true); stage = 2; }
            const int im = a - NH1;
            fox_merge(p, im % (B_ * 8), FX_QQ + im / (B_ * 8));
            dep_post(ctl + CTL_DEP + 128, false);
        } else {
            const int it = a < NH1 ? a : a - NMERGE - NCPA, bg = it % (B_ * 2), qb = NQB - 1 - it / (B_ * 2);
            nsa_item(p, smem, bg, qb);
            { unsigned* c2 = ctl; asm volatile("" : "+v"(c2)); dep_post(c2 + CTL_ROWDONE + RDST * ((bg / 2) * (S_ / BM) + qb / 4), false); }
        }
    }
    const unsigned x = xb_xcc_id() & 7u; bool first = true, first2 = true;
    for (unsigned s8 = 0; s8 < 8; ++s8) {
        unsigned* c3 = ctl; asm volatile("" : "+v"(c3)); const unsigned xq = (x + s8) & 7u; unsigned* qh = c3 + CTL_UPQ + 64 * xq;
        for (;;) {
            if (threadIdx.x == 0) slot[0] = (int)atomicAdd(qh, 1u);
            __syncthreads();
            const int n = slot[0];
            __syncthreads();
            if (n >= 256) break;
            unsigned* c4 = ctl; asm volatile("" : "+v"(c4));
            const int j = ((n & 127) >> 3) * 8 + (int)xq, R = (j & 1) * (S_ / BM) + (S_ / BM - 1 - (j >> 1));
            if (n < 128) {
                if (first) { dep_wait(c4 + CTL_DEP + 256, gridDim.x, c4 + CTL_BAR, false); dep_wait(c4 + CTL_DEP + 64, gridDim.x, c4 + CTL_BAR, false); dep_wait(c4 + CTL_DEP + 128, NMERGE, c4 + CTL_BAR, false); }
                { unsigned* rc = c4 + CTL_ROWDONE + RDST * R; unsigned* br = c4 + CTL_BAR; const bool fa = first; first = false;
                  up_tile(p, smem, R, n & 7, [&]() { dep_wait(rc, 8, br, fa); }); }
                dep_post(c4 + CTL_UPDONE + RDST * R, false);
            } else {
                { unsigned* rc = c4 + CTL_UPDONE + RDST * R; unsigned* br = c4 + CTL_BAR; const bool fa = first2; first2 = false;
                  out_tile(p, smem, R, n & 7, [&]() { dep_wait(rc, 8, br, fa); }); }
                if (dep_post_last(c4 + CTL_OUTDONE + RDST * R, 8u, slot)) route_item(p, smem, R);
            }
        }
    }
    for (;;) {
        if (threadIdx.x == 0) slot[0] = (int)atomicAdd(ctl + CTL_CPT, 1u);
        __syncthreads();
        const int it = slot[0];
        __syncthreads();
        if (it >= NCPI - NCPA) break;
        const int jj = (NCPA + it) * NW + (int)(threadIdx.x >> 6);
        if (jj < NJOB2) prep_job(p, 2, __builtin_amdgcn_readfirstlane(jj));
    }
}

DEV void bphase_prep(const Params& p, unsigned char* smem, int stage, int skip) {
    unsigned char* ws = p.ws; const int t = threadIdx.x, lane = t & 63, w = t >> 6;
    const int G = gridDim.x, nj = stage ? NJOB1 : NJOB0, first = stage ? (vblock() + G - (skip % G)) % G : (int)blockIdx.x;
    for (int it = first * NW + w; it < nj; it += G * NW) prep_job(p, stage, __builtin_amdgcn_readfirstlane(it));
    if (stage) return;
    for (int i = blockIdx.x * NTHREADS + t; i < D_ * 20; i += gridDim.x * NTHREADS) { const int k = i / 20, j = i % 20; ((float*)(ws + OFF_BW))[i] = p.norm_ffn_g[k] * (j < 16 ? p.w_router[(size_t)k * 16 + j] : p.w_group[(size_t)k * 4 + (j - 16)]); }
    for (int i = blockIdx.x * NTHREADS + t; i < 2 * 64 * 256 / 8; i += gridDim.x * NTHREADS) { const int kv = i / (64 * 256 / 8), rr = i % (64 * 256 / 8); *(u32x4*)((bf16*)(ws + OFF_W2T) + (size_t)kv * 128 * 256 + 64 * 256 + rr * 8) = (u32x4){0u, 0u, 0u, 0u}; }
    if (blockIdx.x == 8 && t < 2) {
        const float* gq = t ? p.nsa_q_g : p.fox_q_g; const float* gk = t ? p.nsa_k_g : p.fox_k_g; float a = 0.f, bq = 0.f;
        for (int i = 0; i < 64; ++i) { a = fmaxf(a, fabsf(gq[i])); bq = fmaxf(bq, fabsf(gk[i])); }
        ((float*)(ws + OFF_CTL))[CTL_QKB + t] = 64.0f * a * bq * QSCALE * 1.01f; }
    bf16* H = (bf16*)((unsigned char*)p.out + DO_H);
    {
        constexpr int NV = D_ / 256; const int rstep = gridDim.x * NW; int row = blockIdx.x * NW + w;
        f32x4 v[NV], vn[NV];
        if (row < T_) {
#pragma unroll
            for (int i = 0; i < NV; ++i) v[i] = __builtin_nontemporal_load((const f32x4*)(p.x + (size_t)row * D_ + 256 * i + 4 * lane)); }
        for (; row < T_; row += rstep) {
            const int nrow = row + rstep;
            if (nrow < T_) {
#pragma unroll
                for (int i = 0; i < NV; ++i) vn[i] = __builtin_nontemporal_load((const f32x4*)(p.x + (size_t)nrow * D_ + 256 * i + 4 * lane)); }
            float ss = 0.f;
#pragma unroll
            for (int i = 0; i < NV; ++i) ss += (v[i][0] * v[i][0] + v[i][1] * v[i][1]) + (v[i][2] * v[i][2] + v[i][3] * v[i][3]);
#pragma unroll
            for (int o = 1; o < 64; o <<= 1) ss += __shfl_xor(ss, o);
            const float rs = 1.0f / sqrtf(ss / D_ + RMS_EPS);
#pragma unroll
            for (int i = 0; i < NV; ++i) { const f32x4 gv = *(const f32x4*)(p.norm_mix_g + 256 * i + 4 * lane); const f32x4 tv = v[i] * gv * rs;
                *(u32x2*)(H + (size_t)row * D_ + 256 * i + 4 * lane) = (u32x2){pk_bf16(tv[0], tv[1]), pk_bf16(tv[2], tv[3])}; }
#pragma unroll
            for (int i = 0; i < NV; ++i) v[i] = vn[i];
        }
    }
}
DEV void bphase_scan_cmp1(const Params& p, unsigned char* smem) {
    unsigned char* ws = p.ws; const int t = threadIdx.x, lane = t & 63, w = t >> 6, wn = w / (NW / 2), wm = w % (NW / 2), q = lane >> 4, c = lane & 15;
    constexpr int MT = NCMPP / BM, NTILE = 2 * 2 * B_ * 2 * MT * 2, NSEQ = B_ * 8;
    constexpr int NBIAS = 2 * 4 * 8;
    for (int it = vblock(); it < NTILE + NSEQ + NBIAS; it += gridDim.x) {
        if (it >= NTILE + NSEQ) {
            const int r = it - NTILE - NSEQ, ks = r & 7, jg = (r >> 3) & 3, kv = r >> 5, jq = t >> 6; constexpr int KS = 256 / NW;
            const float* w1 = (kv ? p.cmp_v_w1 : p.cmp_k_w1) + jg * 64 + lane; const float* pos = kv ? p.cmp_v_pos : p.cmp_k_pos;
            float sacc = 0.f;
#pragma unroll 16
            for (int k = ks * 256 + jq * KS; k < ks * 256 + (jq + 1) * KS; ++k) sacc += pos[k] * w1[(size_t)k * 256];
            float* red = (float*)smem; red[t] = sacc; __syncthreads();
            if (t < 64) { float tot = 0.f; for (int k2 = 0; k2 < NW; ++k2) tot += red[64 * k2 + t]; st_dev((float*)(ws + OFF_BIAS1P) + (ks * 2 + kv) * 256 + jg * 64 + t, tot); }
            __syncthreads();
            continue;
        }
        if (it < NTILE) {
            const int kh = it & 1, nt = (it >> 1) & 1; int r = it >> 2; const int mt = r % MT; r /= MT; const int bg = r % (B_ * 2), kv = r / (B_ * 2);
            const bf16* Wb = (const bf16*)(ws + OFF_W1T) + (size_t)kv * 256 * 2048 + kh * 1024;
            GemmSrc g{(const bf16*)(ws + (kv ? OFF_VCR : OFF_KCR)) + (size_t)bg * S_ * 64 + kh * 1024, 1024, nullptr, Wb, Wb, 1 << 30, 2048, 1024};
            f32x4 acc[4][4]; zero_acc(acc);
            gemm_mainloop(acc, g, mt * BM, nt * 128, smem);
            const int n0w = nt * 128 + 64 * wn, m0w = mt * BM + 64 * wm;
            float* dst = (float*)(ws + OFF_CPART) + (((size_t)(kh * 2 + kv) * B_ * 2 + bg) * NCMPP + m0w + c) * 256 + n0w + 4 * q;
#pragma unroll
            for (int nf = 0; nf < 4; ++nf)
#pragma unroll
                for (int mf = 0; mf < 4; ++mf) { float* d = dst + (size_t)(16 * mf) * 256 + 16 * nf; const f32x4 v = acc[nf][mf]; st_dev16(d, (u32x4){f2u(v[0]), f2u(v[1]), f2u(v[2]), f2u(v[3])}); }
        } else {
            const int seq = it - NTILE; constexpr int PER = S_ / NTHREADS; const float* lf = (const float*)(ws + OFF_LOGF) + (size_t)seq * S_ + t * PER; float* cum = (float*)(ws + OFF_CUM) + (size_t)seq * S_ + t * PER;
            float v[PER]; float run = 0.f;
#pragma unroll
            for (int i = 0; i < PER; ++i) { run += lf[i]; v[i] = run; }
            float inc = run;
#pragma unroll
            for (int o = 1; o < 64; o <<= 1) { const float u = __shfl_up(inc, o); if (lane >= o) inc += u; }
            float* wt = (float*)smem; if (lane == 63) wt[w] = inc;
            __syncthreads();
            float base = inc - run; for (int k = 0; k < w; ++k) base += wt[k];
#pragma unroll
            for (int i = 0; i < PER; i += 4) st_dev16(cum + i, (u32x4){f2u(-(v[i] + base) * LOG2E), f2u(-(v[i + 1] + base) * LOG2E), f2u(-(v[i + 2] + base) * LOG2E), f2u(-(v[i + 3] + base) * LOG2E)});
            dep_post((unsigned*)(ws + OFF_CTL) + CTL_DEP + 192, false);
        }
    }
}
DEV void bphase_cmp2(const Params& p, unsigned char* smem) {
    unsigned char* ws = p.ws; const int lane = threadIdx.x & 63, w = threadIdx.x >> 6, wn = w / (NW / 2), wm = w % (NW / 2), q = lane >> 4, c = lane & 15;
    constexpr int MT = (B_ * 2 * NCMPP) / BM;
    if (vblock() < 2 * MT) dep_wait((unsigned*)(ws + OFF_CTL) + CTL_DEP + 256, gridDim.x, (unsigned*)(ws + OFF_CTL) + CTL_BAR, true);
    for (int it = vblock(); it < 2 * MT; it += gridDim.x) {
        const int kv = it / MT, mt = it % MT; const bf16* Wb = (const bf16*)(ws + OFF_W2T) + (size_t)kv * 128 * 256;
        {
            const float* p0 = (const float*)(ws + OFF_CPART) + ((size_t)(0 * 2 + kv) * B_ * 2 * NCMPP + (size_t)mt * BM) * 256; const float* p1 = p0 + (size_t)2 * B_ * 2 * NCMPP * 256;
            bf16* hd = (bf16*)(ws + OFF_CHID) + ((size_t)kv * B_ * 2 * NCMPP + (size_t)mt * BM) * 256; f32x4 bv = {0.f, 0.f, 0.f, 0.f}; static_assert((4 * NTHREADS) % 256 == 0, "a thread keeps its 4 columns");
            for (int ks = 0; ks < 8; ++ks) bv = bv + *(const f32x4*)((const float*)(ws + OFF_BIAS1P) + (ks * 2 + kv) * 256 + (4 * threadIdx.x) % 256);
            for (int i = threadIdx.x; i < BM * 256 / 4; i += NTHREADS) { f32x4 v = __builtin_nontemporal_load((const f32x4*)(p0 + 4 * (size_t)i)) + __builtin_nontemporal_load((const f32x4*)(p1 + 4 * (size_t)i)) + bv;
#pragma unroll
                for (int r2 = 0; r2 < 4; ++r2) { const float u = v[r2]; v[r2] = u * sigmoidf_(1.5957691216057308f * (u + 0.044715f * u * u * u)); }
                *(u32x2*)(hd + 4 * (size_t)i) = (u32x2){pk_bf16(v[0], v[1]), pk_bf16(v[2], v[3])}; }
            asm volatile("s_waitcnt vmcnt(0)" ::: "memory"); __syncthreads();
        }
        GemmSrc g{(const bf16*)(ws + OFF_CHID) + (size_t)kv * B_ * 2 * NCMPP * 256, 256, nullptr, Wb, Wb, 1 << 30, 256, 256};
        f32x4 acc[4][4]; zero_acc(acc);
        gemm_mainloop(acc, g, mt * BM, 0, smem);
        if (wn == 0) {
            f32x4 g4[4];
#pragma unroll
            for (int nf = 0; nf < 4; ++nf) g4[nf] = kv == 0 ? *(const f32x4*)(p.nsa_k_g + 16 * nf + 4 * q) : (f32x4){1.f, 1.f, 1.f, 1.f};
#pragma unroll
            for (int mf = 0; mf < 4; ++mf) { const int row = mt * BM + 64 * wm + 16 * mf + c; float rs = 1.f;
                if (kv == 0) { float ss = 0.f;
#pragma unroll
                    for (int nf = 0; nf < 4; ++nf) { const f32x4 v = acc[nf][mf]; ss += (v[0] * v[0] + v[1] * v[1]) + (v[2] * v[2] + v[3] * v[3]); }
                    rs = 1.0f / sqrtf(rsum16(ss) * (1.0f / 64) + RMS_EPS); }
                if ((row % NCMPP) >= NCMP) rs = 0.f;
                bf16* drow = (bf16*)(ws + (kv ? OFF_VCMP : OFF_KCMP)) + (size_t)row * 64 + 4 * q + ((q & 1) ? 12 : 0);
#pragma unroll
                for (int nf = 0; nf < 4; nf += 2) { const f32x4 v = acc[nf][mf] * rs * g4[nf], v2 = acc[nf + 1][mf] * rs * g4[nf + 1]; st_dev16(drow + 16 * nf, widen_pair((u32x2){pk_bf16(v[0], v[1]), pk_bf16(v[2], v[3])}, (u32x2){pk_bf16(v2[0], v2[1]), pk_bf16(v2[2], v2[3])})); } }
        }
    }
}
#endif

#ifndef CPU_EMU
__global__ void __launch_bounds__(NTHREADS, 2) fwd_megakernel(Params p) {
    __shared__ __attribute__((aligned(16))) unsigned char smem[LDS_BYTES];
    cg::grid_group grid = cg::this_grid();
    volatile unsigned* bst = (volatile unsigned*)(smem + LDS_BYTES - 32);
    if (threadIdx.x < 2) bst[threadIdx.x] = 0u;
    __syncthreads();
    XcdBarrier bar = xcd_barrier_post((unsigned*)(p.ws + OFF_CTL) + CTL_BAR, bst);
    bphase_prep(p, smem, 0, 0);      xcd_barrier(bar);
    if (p.ws == nullptr) grid.sync();
    bphase_inproj(p, smem);          xcd_barrier(bar);
    bphase_scan_cmp1(p, smem);
    bphase_prep(p, smem, 1, 2 * 2 * B_ * 2 * (NCMPP / BM) * 2 + B_ * 8 + 64);     dep_post((unsigned*)(p.ws + OFF_CTL) + CTL_DEP + 256, false);
    bphase_cmp2(p, smem);            dep_post((unsigned*)(p.ws + OFF_CTL) + CTL_DEP, false);
    bphase_attn(p, smem);            xcd_barrier(bar);
    bphase_moe_up(p, smem);
    bphase_moe_down(p, smem);
}

extern "C" void kernel_launch(void* const* d_in, const int* in_sizes, int n_in, void* d_out, int out_size, void* d_ws, size_t ws_size, hipStream_t stream) {
    static int grid_blocks = 0;
    if (!grid_blocks) {
        if (n_in != 25 || out_size != T_ * D_ || ws_size < WS_END) { fprintf(stderr, "kernel_launch: unexpected shapes (n_in %d out %d ws %zu need %zu)\n", n_in, out_size, ws_size, (size_t)WS_END); grid_blocks = -1; return; }
        int dev = 0, cus = 0, per_cu = 0;
        hipGetDevice(&dev); hipDeviceGetAttribute(&cus, hipDeviceAttributeMultiprocessorCount, dev);
        hipOccupancyMaxActiveBlocksPerMultiprocessor(&per_cu, fwd_megakernel, NTHREADS, 0);
        if (per_cu < 1) { fprintf(stderr, "kernel_launch: occupancy query says %d blocks per CU\n", per_cu); grid_blocks = -1; return; }
        if (per_cu > 2) per_cu = 2;
        if (NW >= 8) per_cu = 1;
        grid_blocks = cus * per_cu;
    }
    if (grid_blocks < 0) return;
    Params p{};
    const float** f = (const float**)&p;
    for (int i = 0; i < 25; ++i) f[i] = (const float*)d_in[i];
    p.out = (float*)d_out; p.ws = (unsigned char*)d_ws;
    void* args[] = {&p};
    if (hipMemsetAsync((char*)d_ws + OFF_CTL, 0, 65536, stream) != hipSuccess) { fprintf(stderr, "kernel_launch: memset of the control words failed\n"); return; }
    hipError_t e = hipLaunchCooperativeKernel((void*)fwd_megakernel, dim3(grid_blocks), dim3(NTHREADS), args, 0, stream);
    if (e != hipSuccess) fprintf(stderr, "cooperative launch failed: %s (grid %d)\n", hipGetErrorString(e), grid_blocks);
}
#endif
```
